# Optimizing an MI355X kernel written in HIP

```python
import math
import jax, jax.numpy as jnp
from jax import lax
import numpy as np

D_MODEL = 2048
BATCH = 8
SEQ = 4096
DEPTH = 4
DEC_BATCH = 4
DEC_SEQ = 8192
PAST_LEN = 128

PLE_DIM = 256
GRID_W = 64
N_MIXERS = 3
Q_BLOCK = 128
EPS = 1e-6
D_FF = 4 * D_MODEL

A_HEADS = 16
A_KV_HEADS = 4
A_HEAD_DIM = D_MODEL // A_HEADS
A_GROUP = A_HEADS // A_KV_HEADS
A_ROPE_THETA = 10000.0

B_HEADS = 16
B_Q_RANK = 512
B_KV_RANK = 512
B_NOPE_DIM = 128
B_ROPE_DIM = 64
B_V_DIM = D_MODEL // B_HEADS
B_QK_DIM = B_NOPE_DIM + B_ROPE_DIM
B_ROPE_THETA = 10000.0

C_PAIRS = ((128, 1), (512, 4), (2048, 16))
C_GROUPS = len(C_PAIRS)
C_HEADS = 8
C_HEAD_DIM = 128
C_ROPE_DIM = C_HEAD_DIM // 4
C_ROPE_THETA = 500000.0

N_A = len(range(0, DEPTH, N_MIXERS))
N_B = len(range(1, DEPTH, N_MIXERS))
N_C = len(range(2, DEPTH, N_MIXERS))

kernel_name = 'hybrid_gqa_mla_dilated_encoder'


def rmsnorm(x, g):
    xf = x.astype(jnp.float32)
    y = xf * lax.rsqrt(jnp.mean(xf * xf, axis=-1, keepdims=True) + EPS)
    return (y * g.astype(jnp.float32)).astype(x.dtype)


def rope_tables(pos, dim, theta):
    inv_freq = theta ** (-jnp.arange(0, dim, 2, dtype=jnp.float32) / dim)
    ang = pos.astype(jnp.float32)[:, None] * inv_freq[None, :]
    return jnp.cos(ang), jnp.sin(ang)


def apply_rope(x, cos, sin):
    shape = (cos.shape[0],) + (1,) * (x.ndim - 3) + (cos.shape[1],)
    c = cos.reshape(shape)
    s = sin.reshape(shape)
    xf = x.astype(jnp.float32)
    x1, x2 = jnp.split(xf, 2, axis=-1)
    return jnp.concatenate([x1 * c - x2 * s, x2 * c + x1 * s], axis=-1).astype(x.dtype)


def dense_attention_blocked(q, k, v, scale):
    b, s = q.shape[:2]
    nb = s // Q_BLOCK
    qb = jnp.swapaxes(q.reshape((b, nb, Q_BLOCK) + q.shape[2:]), 0, 1)

    def one_block(q_blk):
        sc = jnp.einsum('bqkgd,bskd->bkgqs', q_blk, k,
                        preferred_element_type=jnp.float32) * scale
        pr = jax.nn.softmax(sc, axis=-1)
        return jnp.einsum('bkgqs,bskd->bqkgd', pr.astype(v.dtype), v)

    o = lax.map(one_block, qb)
    return jnp.swapaxes(o, 0, 1).reshape((b, s) + o.shape[3:])


def dilated_window_attention(q, k, v, window, dilation):
    b, s, h, dh = q.shape
    d = dilation
    L = s // d
    R = window // (2 * d)
    qb_len = math.gcd(L, Q_BLOCK)
    nb = L // qb_len
    kw = qb_len + 2 * R

    def to_sub(a):
        rest = a.shape[2:]
        a = a.reshape((b, L, d) + rest)
        return jnp.swapaxes(a, 1, 2).reshape((b * d, L) + rest)

    def from_sub(a):
        rest = a.shape[2:]
        a = a.reshape((b, d, L) + rest)
        return jnp.swapaxes(a, 1, 2).reshape((b, s) + rest)

    qs, ks, vs = to_sub(q), to_sub(k), to_sub(v)
    pad = ((0, 0), (R, R), (0, 0), (0, 0))
    kp = jnp.pad(ks, pad)
    vp = jnp.pad(vs, pad)
    key_idx = np.arange(nb)[:, None] * qb_len + np.arange(kw)[None, :]
    kb = kp[:, key_idx]
    vb = vp[:, key_idx]
    qb = qs.reshape((b * d, nb, qb_len, h, dh))

    r_loc = np.arange(qb_len)[:, None]
    c_loc = np.arange(kw)[None, :]
    band = np.abs(c_loc - R - r_loc) <= R
    key_pos = np.arange(nb)[:, None, None] * qb_len + c_loc[None] - R
    valid = jnp.asarray(band[None] & (key_pos >= 0) & (key_pos < L))

    sc = jnp.einsum('nbqhd,nbkhd->nbhqk', qb, kb,
                    preferred_element_type=jnp.float32) * (dh ** -0.5)
    sc = jnp.where(valid[None, :, None], sc, -jnp.inf)
    m = jnp.max(sc, axis=-1, keepdims=True)
    e = jnp.exp(sc - m)
    den = jnp.sum(e, axis=-1, keepdims=True)
    o = jnp.einsum('nbhqk,nbkhd->nbqhd', (e / den).astype(v.dtype), vb)
    lse = jnp.swapaxes((m + jnp.log(den))[..., 0], 2, 3)
    o = o.reshape((b * d, L, h, dh))
    lse = lse.reshape((b * d, L, h))
    return from_sub(o), from_sub(lse)


def mixer_a(h, w_qkv, q_g, k_g, w_o):
    b, s, _ = h.shape
    rows = s // GRID_W
    row = jnp.repeat(jnp.arange(rows), GRID_W)
    col = jnp.tile(jnp.arange(GRID_W), rows)
    half = A_HEAD_DIM // 2
    cr, sr = rope_tables(row, half, A_ROPE_THETA)
    cc, scol = rope_tables(col, half, A_ROPE_THETA)

    def axial(t):
        return jnp.concatenate([apply_rope(t[..., :half], cr, sr),
                                apply_rope(t[..., half:], cc, scol)], axis=-1)

    qkv = h @ w_qkv
    q, k, v = jnp.split(qkv, [A_HEADS * A_HEAD_DIM, (A_HEADS + A_KV_HEADS) * A_HEAD_DIM], axis=-1)
    q = axial(rmsnorm(q.reshape(b, s, A_HEADS, A_HEAD_DIM), q_g))
    k = axial(rmsnorm(k.reshape(b, s, A_KV_HEADS, A_HEAD_DIM), k_g))
    v = v.reshape(b, s, A_KV_HEADS, A_HEAD_DIM)
    o = dense_attention_blocked(q.reshape(b, s, A_KV_HEADS, A_GROUP, A_HEAD_DIM), k, v,
                                A_HEAD_DIM ** -0.5)
    return o.reshape(b, s, A_HEADS * A_HEAD_DIM) @ w_o


def mixer_b(h, w_dqkv, cq_g, ckv_g, w_uq, w_ukv, q_g, k_g, w_o):
    b, s, _ = h.shape
    lat = h @ w_dqkv
    cq, ckv, k_rope = jnp.split(lat, [B_Q_RANK, B_Q_RANK + B_KV_RANK], axis=-1)
    q = (rmsnorm(cq, cq_g) @ w_uq).reshape(b, s, B_HEADS, B_QK_DIM)
    kv = (rmsnorm(ckv, ckv_g) @ w_ukv).reshape(b, s, B_HEADS, B_NOPE_DIM + B_V_DIM)
    k_nope, v = jnp.split(kv, [B_NOPE_DIM], axis=-1)
    k = jnp.concatenate(
        [k_nope, jnp.broadcast_to(k_rope[:, :, None, :], (b, s, B_HEADS, B_ROPE_DIM))], axis=-1)
    q = rmsnorm(q, q_g)
    k = rmsnorm(k, k_g)
    cos, sin = rope_tables(jnp.arange(s), B_ROPE_DIM, B_ROPE_THETA)
    q = jnp.concatenate([q[..., :B_NOPE_DIM], apply_rope(q[..., B_NOPE_DIM:], cos, sin)], axis=-1)
    k = jnp.concatenate([k[..., :B_NOPE_DIM], apply_rope(k[..., B_NOPE_DIM:], cos, sin)], axis=-1)
    o = dense_attention_blocked(q[:, :, :, None, :], k, v, B_QK_DIM ** -0.5)
    return o.reshape(b, s, B_HEADS * B_V_DIM) @ w_o


def mixer_c(h, w_qkv, q_g, k_g, w_o):
    b, s, _ = h.shape
    qkv = (h @ w_qkv).reshape(b, s, 3, C_GROUPS, C_HEADS, C_HEAD_DIM)
    q = rmsnorm(qkv[:, :, 0], q_g)
    k = rmsnorm(qkv[:, :, 1], k_g)
    v = qkv[:, :, 2]
    cos, sin = rope_tables(jnp.arange(s), C_ROPE_DIM, C_ROPE_THETA)
    q = jnp.concatenate([apply_rope(q[..., :C_ROPE_DIM], cos, sin), q[..., C_ROPE_DIM:]], axis=-1)
    k = jnp.concatenate([apply_rope(k[..., :C_ROPE_DIM], cos, sin), k[..., C_ROPE_DIM:]], axis=-1)
    outs, lses = [], []
    for g, (window, dilation) in enumerate(C_PAIRS):
        o_g, lse_g = dilated_window_attention(q[:, :, g], k[:, :, g], v[:, :, g], window, dilation)
        outs.append(o_g)
        lses.append(lse_g)
    o = jnp.stack(outs, axis=0)
    wts = jax.nn.softmax(jnp.stack(lses, axis=0), axis=0)
    merged = jnp.sum(wts[..., None] * o.astype(jnp.float32), axis=0).astype(h.dtype)
    return merged.reshape(b, s, C_HEADS * C_HEAD_DIM) @ w_o


def squared_relu_mlp(h, w_in, w_out):
    return jnp.square(jax.nn.relu(h @ w_in)) @ w_out


def layer_stack(x, p, weights):
    (norm_mix_g, norm_mlp_g, w_mlp_in, w_mlp_out, w_ple, ple_norm_g, ple_gate_norm_g, w_ple_gate,
     a_w_qkv, a_q_norm_g, a_k_norm_g, a_w_o,
     b_w_dqkv, b_cq_norm_g, b_ckv_norm_g, b_w_uq, b_w_ukv, b_q_norm_g, b_k_norm_g, b_w_o,
     c_w_qkv, c_q_norm_g, c_k_norm_g, c_w_o) = weights
    for i in range(DEPTH):
        kind, j = i % N_MIXERS, i // N_MIXERS
        h = rmsnorm(x, norm_mix_g[i])
        if kind == 0:
            y = mixer_a(h, a_w_qkv[j], a_q_norm_g[j], a_k_norm_g[j], a_w_o[j])
        elif kind == 1:
            y = mixer_b(h, b_w_dqkv[j], b_cq_norm_g[j], b_ckv_norm_g[j], b_w_uq[j], b_w_ukv[j],
                        b_q_norm_g[j], b_k_norm_g[j], b_w_o[j])
        else:
            y = mixer_c(h, c_w_qkv[j], c_q_norm_g[j], c_k_norm_g[j], c_w_o[j])
        x = x + y
        x = x + squared_relu_mlp(rmsnorm(x, norm_mlp_g[i]), w_mlp_in[i], w_mlp_out[i])
        e = rmsnorm(p[i] @ w_ple[i], ple_norm_g[i])
        gate = jax.nn.sigmoid(rmsnorm(x, ple_gate_norm_g[i]) @ w_ple_gate[i])
        x = x + gate * e
    return x


def setup_inputs(seed: int = 0) -> dict:
    key = jax.random.key(seed)
    ks = iter([jax.random.fold_in(key, i) for i in range(32)])

    def normal(shape, scale):
        return jax.random.normal(next(ks), shape, jnp.float32) * scale

    def gain(shape):
        return 1.0 + normal(shape, 0.02)

    res = (2.0 * DEPTH) ** -0.5
    a_qkv_w = (A_HEADS + 2 * A_KV_HEADS) * A_HEAD_DIM
    return {
        'x_prompt': normal((BATCH, SEQ, D_MODEL), 1.0),
        'x_sample': normal((DEC_BATCH, DEC_SEQ, D_MODEL), 1.0),
        'p_prompt': normal((DEPTH, BATCH, SEQ, PLE_DIM), 1.0),
        'p_sample': normal((DEPTH, DEC_BATCH, DEC_SEQ, PLE_DIM), 1.0),
        'norm_mix_g': gain((DEPTH, D_MODEL)),
        'norm_mlp_g': gain((DEPTH, D_MODEL)),
        'w_mlp_in': normal((DEPTH, D_MODEL, D_FF), D_MODEL ** -0.5),
        'w_mlp_out': normal((DEPTH, D_FF, D_MODEL), res * D_FF ** -0.5),
        'w_ple': normal((DEPTH, PLE_DIM, D_MODEL), PLE_DIM ** -0.5),
        'ple_norm_g': gain((DEPTH, D_MODEL)),
        'ple_gate_norm_g': gain((DEPTH, D_MODEL)),
        'w_ple_gate': normal((DEPTH, D_MODEL, D_MODEL), D_MODEL ** -0.5),
        'a_w_qkv': normal((N_A, D_MODEL, a_qkv_w), D_MODEL ** -0.5),
        'a_q_norm_g': gain((N_A, A_HEAD_DIM)),
        'a_k_norm_g': gain((N_A, A_HEAD_DIM)),
        'a_w_o': normal((N_A, A_HEADS * A_HEAD_DIM, D_MODEL), res * (A_HEADS * A_HEAD_DIM) ** -0.5),
        'b_w_dqkv': normal((N_B, D_MODEL, B_Q_RANK + B_KV_RANK + B_ROPE_DIM), D_MODEL ** -0.5),
        'b_cq_norm_g': gain((N_B, B_Q_RANK)),
        'b_ckv_norm_g': gain((N_B, B_KV_RANK)),
        'b_w_uq': normal((N_B, B_Q_RANK, B_HEADS * B_QK_DIM), B_Q_RANK ** -0.5),
        'b_w_ukv': normal((N_B, B_KV_RANK, B_HEADS * (B_NOPE_DIM + B_V_DIM)), B_KV_RANK ** -0.5),
        'b_q_norm_g': gain((N_B, B_QK_DIM)),
        'b_k_norm_g': gain((N_B, B_QK_DIM)),
        'b_w_o': normal((N_B, B_HEADS * B_V_DIM, D_MODEL), res * (B_HEADS * B_V_DIM) ** -0.5),
        'c_w_qkv': normal((N_C, D_MODEL, 3 * C_GROUPS * C_HEADS * C_HEAD_DIM), D_MODEL ** -0.5),
        'c_q_norm_g': gain((N_C, C_HEAD_DIM)),
        'c_k_norm_g': gain((N_C, C_HEAD_DIM)),
        'c_w_o': normal((N_C, C_HEADS * C_HEAD_DIM, D_MODEL), res * (C_HEADS * C_HEAD_DIM) ** -0.5),
    }


def reference(x_prompt, x_sample, p_prompt, p_sample,
              norm_mix_g, norm_mlp_g, w_mlp_in, w_mlp_out, w_ple, ple_norm_g, ple_gate_norm_g,
              w_ple_gate,
              a_w_qkv, a_q_norm_g, a_k_norm_g, a_w_o,
              b_w_dqkv, b_cq_norm_g, b_ckv_norm_g, b_w_uq, b_w_ukv, b_q_norm_g, b_k_norm_g, b_w_o,
              c_w_qkv, c_q_norm_g, c_k_norm_g, c_w_o):
    weights = (norm_mix_g, norm_mlp_g, w_mlp_in, w_mlp_out, w_ple, ple_norm_g, ple_gate_norm_g,
               w_ple_gate,
               a_w_qkv, a_q_norm_g, a_k_norm_g, a_w_o,
               b_w_dqkv, b_cq_norm_g, b_ckv_norm_g, b_w_uq, b_w_ukv, b_q_norm_g, b_k_norm_g, b_w_o,
               c_w_qkv, c_q_norm_g, c_k_norm_g, c_w_o)
    y_prompt = layer_stack(x_prompt, p_prompt, weights)
    y_sample = layer_stack(x_sample, p_sample, weights)
    return (y_prompt, y_sample)
```

```cpp
#include <hip/hip_runtime.h>
#include <cstdio>
#include <cstdint>
namespace pg8 {
#define PG8_LAS __attribute__((address_space(3)))
typedef unsigned short bf16_t;
typedef short bf16x8 __attribute__((ext_vector_type(8)));
typedef float f32x4 __attribute__((ext_vector_type(4)));
typedef unsigned u32x4 __attribute__((ext_vector_type(4)));
constexpr int BM = 256, BK = 64, HALF = 128, HTB = HALF * BK * 2  , STAGE_BYTES = 8 * HTB, NXCD = 8, WGM = 8;

__host__ __device__ __forceinline__ int lds_byte(int r, int c) { const int st = (r >> 4) * 2 + (c >> 5), rr = r & 15, cc = c & 31, ob = rr * 64 + cc * 2; return st * 1024 + (ob ^ (((ob >> 9) & 1) << 5)); }
__host__ __device__ __forceinline__ void stage_rc(int b, int& R, int& C) { const int st = b / 1024, sb = b % 1024, swz = sb ^ (((sb >> 9) & 1) << 5); R = (st >> 1) * 16 + swz / 64; C = (st & 1) * 32 + (swz % 64) / 2; }
__host__ __device__ __forceinline__ int perm32(int rho) { const int n = rho >> 4, i = rho & 15; return 8 * (i >> 2) + 4 * n + (i & 3); }

struct Unit { int pm, pn; };
struct Gemm { const bf16_t* A; const bf16_t* Bt; int M, N, K; };

struct StaticOrder {
    int nM, nN, nwg, G, c;
    __host__ __device__ void init(int M, int N, int G_, int c_) { nM = M / BM; nN = N / BM; nwg = nM * nN; G = G_; c = c_; }
    __host__ __device__ bool next(int i, Unit& u) const {
        const long L = (long)i * G + c; if (L >= nwg) return false;
        int wgid = (int)L; { const int q = nwg / NXCD, r = nwg % NXCD, xcd = wgid % NXCD, off = wgid / NXCD; wgid = (xcd < r ? xcd * (q + 1) : r * (q + 1) + (xcd - r) * q) + off; }
        const int nig = WGM * nN, gid = wgid / nig, fm = gid * WGM, gsz = (nM - fm) < WGM ? (nM - fm) : WGM;
        u.pm = fm + ((wgid % nig) % gsz); u.pn = (wgid % nig) / gsz; return true;
    }
    __device__ __forceinline__ void a_ready(const Unit&) const {}
    __device__ __forceinline__ void done(const Unit&) const {}
};

__device__ __forceinline__ unsigned cvt_pk_bf16(float lo, float hi) { unsigned r; asm volatile("v_cvt_pk_bf16_f32 %0, %1, %2" : "=v"(r) : "v"(lo), "v"(hi)); return r; }
typedef float f32x2 __attribute__((ext_vector_type(2)));
typedef unsigned u32x2 __attribute__((ext_vector_type(2)));
template <int ACT> struct EpiBf16 {
    static constexpr bool PERM = true, AFTER_DRAIN = false;
    bf16_t* O; int ldc;
    __device__ __forceinline__ void operator()(const f32x4 (&acc)[2][2][4][2], const Unit& u, int wr, int wc, int fr, int fq) const {
        const int row0 = u.pm * BM + wr * 64 + fr; const int col0 = u.pn * BM + wc * 32 + 8 * fq;
#pragma unroll
        for (int ai = 0; ai < 2; ++ai)
#pragma unroll
            for (int m = 0; m < 4; ++m) { bf16_t* rowp = O + (size_t)(row0 + ai * HALF + m * 16) * ldc + col0;
#pragma unroll
                for (int bj = 0; bj < 2; ++bj) { f32x4 v0 = acc[ai][bj][m][0], v1 = acc[ai][bj][m][1];
                    if (ACT == 1) {
#pragma unroll
                        for (int j = 0; j < 4; ++j) { const float a = fmaxf(v0[j], 0.f), b = fmaxf(v1[j], 0.f); v0[j] = a * a; v1[j] = b * b; } }
                    u32x4 w; w.x = cvt_pk_bf16(v0[0], v0[1]); w.y = cvt_pk_bf16(v0[2], v0[3]); w.z = cvt_pk_bf16(v1[0], v1[1]); w.w = cvt_pk_bf16(v1[2], v1[3]);
                    *(u32x4*)(rowp + bj * HALF) = w; } }
    }
};
struct EpiResid {
    static constexpr bool PERM = false, AFTER_DRAIN = false;
    const float* base; float* out; int ldc;
    __device__ __forceinline__ void operator()(const f32x4 (&acc)[2][2][4][2], const Unit& u, int wr, int wc, int fr, int fq) const {
        const int row0 = u.pm * BM + wr * 64 + fr, col0 = u.pn * BM + wc * 32 + 4 * fq;
#pragma unroll
        for (int ai = 0; ai < 2; ++ai)
#pragma unroll
            for (int m = 0; m < 4; ++m) { const size_t off = (size_t)(row0 + ai * HALF + m * 16) * ldc + col0;
#pragma unroll
                for (int bj = 0; bj < 2; ++bj)
#pragma unroll
                    for (int n = 0; n < 2; ++n) { const f32x4 b = *(const f32x4*)(base + off + bj * HALF + n * 16); *(f32x4*)(out + off + bj * HALF + n * 16) = b + acc[ai][bj][m][n]; }
                asm volatile("" ::: "memory"); }
    }
};
struct EpiGate {
    static constexpr bool PERM = false, AFTER_DRAIN = false;
    const float* base; float* out; int ldc; const bf16_t* e0; const float* rstd; const float* g;
    __device__ __forceinline__ void operator()(const f32x4 (&acc)[2][2][4][2], const Unit& u, int wr, int wc, int fr, int fq) const {
        const int row0 = u.pm * BM + wr * 64 + fr, col0 = u.pn * BM + wc * 32 + 4 * fq;
        f32x4 gv[2][2];
#pragma unroll
        for (int bj = 0; bj < 2; ++bj)
#pragma unroll
            for (int n = 0; n < 2; ++n) gv[bj][n] = *(const f32x4*)(g + col0 + bj * HALF + n * 16);
#pragma unroll
        for (int ai = 0; ai < 2; ++ai)
#pragma unroll
            for (int m = 0; m < 4; ++m) { const int row = row0 + ai * HALF + m * 16; const size_t off = (size_t)row * ldc + col0; const float rs = rstd[row];
#pragma unroll
                for (int bj = 0; bj < 2; ++bj)
#pragma unroll
                    for (int n = 0; n < 2; ++n) { const f32x4 b = *(const f32x4*)(base + off + bj * HALF + n * 16); const u32x2 ew = *(const u32x2*)(e0 + off + bj * HALF + n * 16);
                        f32x4 e; e[0] = __uint_as_float(ew.x << 16); e[1] = __uint_as_float(ew.x & 0xffff0000u); e[2] = __uint_as_float(ew.y << 16); e[3] = __uint_as_float(ew.y & 0xffff0000u);
                        const f32x4 a = acc[ai][bj][m][n]; f32x4 s;
#pragma unroll
                        for (int j = 0; j < 4; ++j) s[j] = __builtin_amdgcn_rcpf(1.0f + __builtin_amdgcn_exp2f(a[j] * -1.4426950408889634f));
                        *(f32x4*)(out + off + bj * HALF + n * 16) = b + s * (e * rs * gv[bj][n]); }
                asm volatile("" ::: "memory"); }
    }
};
template <class Epi, class Sched, bool ALIGN_EPI = false, bool SP2 = false>
__device__ __forceinline__ void gemm_phase(PG8_LAS unsigned char* lds, const Gemm g, const Sched& S, const Epi& E, const int tid) {
    const int wid = __builtin_amdgcn_readfirstlane(tid >> 6), lane = tid & 63, wr = wid >> 2, wc = wid & 3, fr = lane & 15, fq = lane >> 4;
    const int K = g.K, nt = K / BK;
    unsigned voffA[2], voffB[2];
#pragma unroll
    for (int i = 0; i < 2; ++i) { int R, C; stage_rc(tid * 16 + i * 8192, R, C); const int Rb = Epi::PERM ? ((R & ~31) + perm32(R & 31)) : R;
        voffA[i] = (unsigned)(R * K + C) * 2u; voffB[i] = (unsigned)(Rb * K + C) * 2u; }
    const size_t kstep = (size_t)(BK * 2);
    const size_t hstep = (size_t)HALF * K * 2;
    const size_t tstep = 2 * hstep;
    const unsigned ldsw = (unsigned)wid * 1024u;
    const int aoff = lds_byte(wr * 64 + fr, fq * 8), boff = lds_byte(wc * 32 + fr, fq * 8);
#define PG8_SA(b, h) (((b) * 2 + (h)) * HTB)
#define PG8_SB(b, h) ((4 + (b) * 2 + (h)) * HTB)
#define PG8_STAGE(bufoff, gbase, voff) do { _Pragma("unroll") for (int _i = 0; _i < 2; ++_i) \
        __builtin_amdgcn_global_load_lds((const unsigned*)((const char*)(gbase) + (voff)[_i]), (PG8_LAS unsigned*)(lds + (bufoff) + ldsw + _i * 8192), 16, 0, 0); } while (0)
#define PG8_LDA(dst, b, h) do { _Pragma("unroll") for (int m = 0; m < 4; ++m) _Pragma("unroll") for (int k = 0; k < 2; ++k) dst[m][k] = *(const PG8_LAS bf16x8*)(lds + PG8_SA(b, h) + aoff + m * 2048 + k * 1024); } while (0)
#define PG8_LDB(dst, b, h) do { _Pragma("unroll") for (int n = 0; n < 2; ++n) _Pragma("unroll") for (int k = 0; k < 2; ++k) dst[n][k] = *(const PG8_LAS bf16x8*)(lds + PG8_SB(b, h) + boff + n * 2048 + k * 1024); } while (0)
#define PG8_MMA(ai, bj, At, Bt) do { __builtin_amdgcn_s_setprio(1); _Pragma("unroll") for (int m = 0; m < 4; ++m) _Pragma("unroll") for (int n = 0; n < 2; ++n) _Pragma("unroll") for (int k = 0; k < 2; ++k) \
        acc[ai][bj][m][n] = __builtin_amdgcn_mfma_f32_16x16x32_bf16(Bt[n][k], At[m][k], acc[ai][bj][m][n], 0, 0, 0); __builtin_amdgcn_s_setprio(0); } while (0)
#define PG8_WAIT_V(n) asm volatile("s_waitcnt vmcnt(" #n ")" ::: "memory")
#define PG8_WAIT_L(n) asm volatile("s_waitcnt lgkmcnt(" #n ")" ::: "memory")
#define PG8_BAR __builtin_amdgcn_s_barrier()
#define PG8_SCHED __builtin_amdgcn_sched_barrier(0)
    Unit cur, nxt; int ui = 0;
    if (!S.next(0, cur)) return;
    f32x4 acc[2][2][4][2];
#pragma unroll
    for (int a = 0; a < 2; ++a)
#pragma unroll
        for (int b = 0; b < 2; ++b)
#pragma unroll
            for (int m = 0; m < 4; ++m)
#pragma unroll
                for (int n = 0; n < 2; ++n) acc[a][b][m][n] = (f32x4){0.f, 0.f, 0.f, 0.f};
    bf16x8 At[4][2], B0[2][2], B1[2][2];
    const char* cA = (const char*)g.A + (size_t)cur.pm * tstep; const char* cB = (const char*)g.Bt + (size_t)cur.pn * tstep;
    S.a_ready(cur);
    if constexpr (SP2) {
        PG8_STAGE(PG8_SB(0, 0), cB, voffB); PG8_STAGE(PG8_SB(0, 1), cB + hstep, voffB); PG8_STAGE(PG8_SA(0, 0), cA, voffA); PG8_STAGE(PG8_SA(0, 1), cA + hstep, voffA);
        if (wr == 1) PG8_BAR;
        PG8_WAIT_V(2); PG8_BAR;
        PG8_STAGE(PG8_SB(1, 0), cB + kstep, voffB); PG8_STAGE(PG8_SA(1, 0), cA + kstep, voffA); PG8_STAGE(PG8_SB(1, 1), cB + hstep + kstep, voffB);
        PG8_WAIT_V(6); PG8_BAR;
    } else {
        PG8_STAGE(PG8_SB(0, 0), cB, voffB); PG8_STAGE(PG8_SA(0, 0), cA, voffA); PG8_STAGE(PG8_SB(0, 1), cB + hstep, voffB); PG8_STAGE(PG8_SA(0, 1), cA + hstep, voffA);
        if (wr == 1) PG8_BAR;
        PG8_WAIT_V(4); PG8_BAR;
        PG8_STAGE(PG8_SB(1, 0), cB + kstep, voffB); PG8_STAGE(PG8_SA(1, 0), cA + kstep, voffA); PG8_STAGE(PG8_SB(1, 1), cB + hstep + kstep, voffB);
        PG8_WAIT_V(6); PG8_BAR;
    }
    for (;;) {
        const bool has_next = S.next(ui + 1, nxt);
        const char* nA = has_next ? (const char*)g.A + (size_t)nxt.pm * tstep : cA; const char* nB = has_next ? (const char*)g.Bt + (size_t)nxt.pn * tstep : cB;
        for (int t = 0; t < nt; t += 2) {
            const bool last = (t == nt - 2);
            const char* a1 = cA + (size_t)(t + 1) * kstep;
            const char* a2 = last ? nA : cA + (size_t)(t + 2) * kstep; const char* b2 = last ? nB : cB + (size_t)(t + 2) * kstep;
            const char* a3 = a2 + kstep; const char* b3 = b2 + kstep;
            if (last && has_next) S.a_ready(nxt);
            if constexpr (SP2) {
            PG8_LDB(B0, 0, 0); PG8_LDB(B1, 0, 1); PG8_SCHED; PG8_LDA(At, 0, 0); PG8_STAGE(PG8_SA(1, 1), a1 + hstep, voffA);
            PG8_WAIT_V(8); PG8_WAIT_L(0); PG8_BAR; PG8_MMA(0, 0, At, B0); PG8_MMA(0, 1, At, B1); PG8_BAR; PG8_SCHED;
            PG8_LDA(At, 0, 1); PG8_STAGE(PG8_SB(0, 0), b2, voffB); PG8_STAGE(PG8_SB(0, 1), b2 + hstep, voffB); PG8_STAGE(PG8_SA(0, 0), a2, voffA);
            PG8_WAIT_V(8); PG8_WAIT_L(0); PG8_BAR; PG8_MMA(1, 0, At, B0); PG8_MMA(1, 1, At, B1); PG8_BAR; PG8_SCHED;
            PG8_LDB(B0, 1, 0); PG8_LDB(B1, 1, 1); PG8_SCHED; PG8_LDA(At, 1, 0); PG8_STAGE(PG8_SA(0, 1), a2 + hstep, voffA);
            PG8_WAIT_V(8); PG8_WAIT_L(0); PG8_BAR; PG8_MMA(0, 0, At, B0); PG8_MMA(0, 1, At, B1); PG8_BAR; PG8_SCHED;
            PG8_LDA(At, 1, 1); PG8_STAGE(PG8_SB(1, 0), b3, voffB); PG8_STAGE(PG8_SB(1, 1), b3 + hstep, voffB); PG8_STAGE(PG8_SA(1, 0), a3, voffA);
            PG8_WAIT_V(8); PG8_WAIT_L(0); PG8_BAR; PG8_MMA(1, 0, At, B0); PG8_MMA(1, 1, At, B1); PG8_BAR; PG8_SCHED;
            } else {
            PG8_LDB(B0, 0, 0); PG8_SCHED; PG8_LDA(At, 0, 0); PG8_STAGE(PG8_SA(1, 1), a1 + hstep, voffA);
            PG8_WAIT_L(8); PG8_BAR; PG8_WAIT_L(0); PG8_MMA(0, 0, At, B0); PG8_BAR; PG8_SCHED;
            PG8_LDB(B1, 0, 1); PG8_STAGE(PG8_SB(0, 0), b2, voffB);
            PG8_BAR; PG8_WAIT_L(0); PG8_MMA(0, 1, At, B1); PG8_BAR;
            PG8_LDA(At, 0, 1); PG8_STAGE(PG8_SA(0, 0), a2, voffA);
            PG8_BAR; PG8_WAIT_L(0); PG8_MMA(1, 0, At, B0); PG8_BAR; PG8_SCHED;
            PG8_STAGE(PG8_SB(0, 1), b2 + hstep, voffB);
            PG8_WAIT_V(6); PG8_BAR; PG8_MMA(1, 1, At, B1); PG8_BAR;
            PG8_LDB(B0, 1, 0); PG8_SCHED; PG8_LDA(At, 1, 0); PG8_STAGE(PG8_SA(0, 1), a2 + hstep, voffA);
            PG8_WAIT_L(8); PG8_BAR; PG8_WAIT_L(0); PG8_MMA(0, 0, At, B0); PG8_BAR; PG8_SCHED;
            PG8_LDB(B1, 1, 1); PG8_STAGE(PG8_SB(1, 0), b3, voffB);
            PG8_BAR; PG8_WAIT_L(0); PG8_MMA(0, 1, At, B1); PG8_BAR;
            PG8_LDA(At, 1, 1); PG8_STAGE(PG8_SA(1, 0), a3, voffA);
            PG8_BAR; PG8_WAIT_L(0); PG8_MMA(1, 0, At, B0); PG8_BAR; PG8_SCHED;
            PG8_STAGE(PG8_SB(1, 1), b3 + hstep, voffB);
            PG8_WAIT_V(6); PG8_BAR; PG8_MMA(1, 1, At, B1); PG8_BAR;
            }
        }
        if constexpr (ALIGN_EPI) { if (wr == 0) PG8_BAR; }
        if constexpr (!Epi::AFTER_DRAIN) { E(acc, cur, wr, wc, fr, fq); S.done(cur); }
        if (!has_next) break;
#pragma unroll
        for (int a = 0; a < 2; ++a)
#pragma unroll
            for (int b = 0; b < 2; ++b)
#pragma unroll
                for (int m = 0; m < 4; ++m)
#pragma unroll
                    for (int n = 0; n < 2; ++n) acc[a][b][m][n] = (f32x4){0.f, 0.f, 0.f, 0.f};
        cur = nxt; cA = nA; cB = nB; ++ui;
        if constexpr (ALIGN_EPI) { if (wr == 1) PG8_BAR; }
    }
    PG8_WAIT_V(0);
    if constexpr (!ALIGN_EPI) { if (wr == 0) PG8_BAR; }
    PG8_BAR;
    if constexpr (Epi::AFTER_DRAIN) { E.fused(acc, cur, wr, wc, fr, fq, lds, wid, lane); S.done(cur); }
#undef PG8_SA
#undef PG8_SB
#undef PG8_STAGE
#undef PG8_LDA
#undef PG8_LDB
#undef PG8_MMA
#undef PG8_WAIT_V
#undef PG8_WAIT_L
#undef PG8_BAR
#undef PG8_SCHED
}
}
namespace att {
typedef unsigned short bf16_t;
using bf16x8 = __attribute__((ext_vector_type(8))) short;
using s16x4  = __attribute__((ext_vector_type(4))) short;
using f32x16 = __attribute__((ext_vector_type(16))) float;
using u32x4  = __attribute__((ext_vector_type(4))) unsigned;
constexpr int QBLK = 32, KVBLK = 64, NW = 8;
constexpr float THR = 8.f;
#define ATT_SBAR() __builtin_amdgcn_sched_barrier(0)
#define ATT_SYNC() __syncthreads()
__device__ __forceinline__ int crow(int r, int hi) { return (r & 3) + 8 * (r >> 2) + 4 * hi; }
__device__ __forceinline__ unsigned cvtpk(float lo, float hi) { unsigned r; asm volatile("v_cvt_pk_bf16_f32 %0, %1, %2" : "=v"(r) : "v"(lo), "v"(hi)); return r; }
__device__ __forceinline__ bf16x8 ld8(const bf16_t* p) { return *reinterpret_cast<const bf16x8*>(p); }

template <int DQK_, int SDEPTH_, int SCALE_ID> struct Cfg {
    static constexpr int DQK = DQK_, SDEPTH = SDEPTH_, ND0 = DQK_ / 16, KPITCH = DQK_ * 2;
    static constexpr float SCALE = SCALE_ID == 0 ? 0.088388347648318440f   : 0.072168783648703220f  ;
    static constexpr int SHM_V = KVBLK * 128 * 2, SHM_K = KVBLK * DQK_ * 2;
    static constexpr int OST_PITCH = 272, OST_WAVE = 32 * OST_PITCH, OST_BYTES = NW * OST_WAVE;
    static constexpr int KV_BYTES = 2 * SHM_V + 2 * SHM_K;
    static constexpr int QX_OFF = KV_BYTES > OST_BYTES ? KV_BYTES : OST_BYTES;
    static constexpr int WS_OFF = QX_OFF + (DQK_ > 128 ? NW * 4096 : 0);
    static constexpr int LDS_BYTES = WS_OFF + NW * 64 * 4;
};

template <class CF> __device__ __forceinline__ void partialSM(f32x16& p0, f32x16& p1, float& m_reg, float& mn, float& alpha) {
  constexpr float C = CF::SCALE * 1.4426950408889634f;
  float pmax = p0[0];
#pragma unroll
  for (int r = 1; r < 16; ++r) pmax = fmaxf(pmax, p0[r]);
#pragma unroll
  for (int r = 0; r < 16; ++r) pmax = fmaxf(pmax, p1[r]);
  { auto rr = __builtin_amdgcn_permlane32_swap(__float_as_uint(pmax), __float_as_uint(pmax), false, false);
    pmax = fmaxf(__uint_as_float(rr[0]), __uint_as_float(rr[1])); }
  if (__builtin_expect(__all(pmax - m_reg <= THR / CF::SCALE), 1)) { mn = m_reg; alpha = 1.f; }
  else { mn = fmaxf(m_reg, pmax); alpha = __builtin_amdgcn_exp2f((m_reg - mn) * C); m_reg = mn; }
  float mnC = -mn * C;
#pragma unroll
  for (int r = 0; r < 16; ++r) p0[r] = fmaf(p0[r], C, mnC);
#pragma unroll
  for (int r = 0; r < 16; ++r) p1[r] = fmaf(p1[r], C, mnC);
#pragma unroll
  for (int r = 0; r < 16; ++r) p0[r] = __builtin_amdgcn_exp2f(p0[r]);
}
__device__ __forceinline__ void finishSM(f32x16& p0, f32x16& p1, float alpha, float& l_reg, bf16x8& pa0, bf16x8& pa1, bf16x8& pa2, bf16x8& pa3) {
#pragma unroll
  for (int r = 0; r < 16; ++r) p1[r] = __builtin_amdgcn_exp2f(p1[r]);
  float ps = 0;
#pragma unroll
  for (int r = 0; r < 16; ++r) ps += p0[r];
#pragma unroll
  for (int r = 0; r < 16; ++r) ps += p1[r];
  { auto rr = __builtin_amdgcn_permlane32_swap(__float_as_uint(ps), __float_as_uint(ps), false, false);
    ps = __uint_as_float(rr[0]) + __uint_as_float(rr[1]); }
  l_reg = l_reg * alpha + ps;
#define ATT_PK4(P, BASE, OUT) do { unsigned a0 = cvtpk(P[BASE + 0], P[BASE + 1]), a1 = cvtpk(P[BASE + 2], P[BASE + 3]);   \
    unsigned b0 = cvtpk(P[BASE + 4], P[BASE + 5]), b1 = cvtpk(P[BASE + 6], P[BASE + 7]);                              \
    auto r0 = __builtin_amdgcn_permlane32_swap(a0, b0, false, false); auto r1 = __builtin_amdgcn_permlane32_swap(a1, b1, false, false); \
    u32x4 w = {r0[0], r1[0], r0[1], r1[1]}; OUT = *reinterpret_cast<bf16x8*>(&w); } while (0)
  ATT_PK4(p0, 0, pa0); ATT_PK4(p0, 8, pa1); ATT_PK4(p1, 0, pa2); ATT_PK4(p1, 8, pa3);
#undef ATT_PK4
}
template <class CF> __device__ __forceinline__ void qkt(f32x16& p0, f32x16& p1, const char* Ks, const bf16x8* qr, const char* qx, int r32, int hi) {
  p0 = f32x16{}; p1 = f32x16{};
#pragma unroll
  for (int d0 = 0; d0 < CF::ND0; ++d0) { const int cb = (d0 * 16 + hi * 8) * 2;
    bf16x8 b0 = *reinterpret_cast<const bf16x8*>(Ks + (r32) * CF::KPITCH + (cb ^ ((r32 & 7) << 4)));
    bf16x8 b1 = *reinterpret_cast<const bf16x8*>(Ks + (32 + r32) * CF::KPITCH + (cb ^ ((r32 & 7) << 4)));
    bf16x8 q; if (d0 < 8) q = qr[d0]; else q = *reinterpret_cast<const bf16x8*>(qx + (d0 - 8) * 1024);
    p0 = __builtin_amdgcn_mfma_f32_32x32x16_bf16(b0, q, p0, 0, 0, 0);
    p1 = __builtin_amdgcn_mfma_f32_32x32x16_bf16(b1, q, p1, 0, 0, 0); }
}
__device__ __forceinline__ void bandmask(f32x16& p0, f32x16& p1, int kb, int qi, int hi) {
  const float ninf = -__builtin_inff();
  int dq = kb - qi + 4 * hi + 64; asm volatile("" : "+v"(dq));
#pragma unroll
  for (int r = 0; r < 16; ++r) { const int c = (r & 3) + 8 * (r >> 2); if ((unsigned)(dq + c) > 128u) p0[r] = ninf; if ((unsigned)(dq + c + 32) > 128u) p1[r] = ninf; }
}
__device__ __forceinline__ int v_st(int k, int c) { const int kk = (k & ~0xC) | ((k & 4) << 1) | ((k & 8) >> 1); return ((kk >> 3) * 4 + (c >> 5)) * 512 + ((kk & 7) * 32 + (c & 31)) * 2; }
__device__ __forceinline__ int v_rd_base(int lane) { return ((lane & 3) << 3) | (((lane >> 2) & 3) << 6) | (((lane >> 4) & 1) << 5) | (((lane >> 5) & 1) << 8); }
constexpr int v_rd_off(int d0, int ks, int half) { return d0 * 512 + ks * 4096 + half * 2048; }
template <int OFF> __device__ __forceinline__ s16x4 tr_read(int vb) {
  s16x4 r; asm volatile("ds_read_b64_tr_b16 %0, %1 offset:%2" : "=&v"(r) : "v"(vb), "i"(OFF) : "memory"); return r;
}
template <int D0> __device__ __forceinline__ void pv_one(f32x16& od, int vb, bf16x8 pa0, bf16x8 pa1, bf16x8 pa2, bf16x8 pa3) {
  const s16x4 l0 = tr_read<v_rd_off(D0, 0, 0)>(vb), h0 = tr_read<v_rd_off(D0, 0, 1)>(vb), l1 = tr_read<v_rd_off(D0, 1, 0)>(vb), h1 = tr_read<v_rd_off(D0, 1, 1)>(vb);
  const s16x4 l2 = tr_read<v_rd_off(D0, 2, 0)>(vb), h2 = tr_read<v_rd_off(D0, 2, 1)>(vb), l3 = tr_read<v_rd_off(D0, 3, 0)>(vb), h3 = tr_read<v_rd_off(D0, 3, 1)>(vb);
  asm volatile("s_waitcnt lgkmcnt(0)" ::: "memory"); ATT_SBAR();
#define ATT_PK(L, H) (bf16x8){L[0], L[1], L[2], L[3], H[0], H[1], H[2], H[3]}
  od = __builtin_amdgcn_mfma_f32_32x32x16_bf16(pa0, ATT_PK(l0, h0), od, 0, 0, 0);
  od = __builtin_amdgcn_mfma_f32_32x32x16_bf16(pa1, ATT_PK(l1, h1), od, 0, 0, 0);
  od = __builtin_amdgcn_mfma_f32_32x32x16_bf16(pa2, ATT_PK(l2, h2), od, 0, 0, 0);
  od = __builtin_amdgcn_mfma_f32_32x32x16_bf16(pa3, ATT_PK(l3, h3), od, 0, 0, 0);
#undef ATT_PK
}
__device__ __forceinline__ void pv_d0(f32x16* o, int vb, bf16x8 pa0, bf16x8 pa1, bf16x8 pa2, bf16x8 pa3) {
  pv_one<0>(o[0], vb, pa0, pa1, pa2, pa3); pv_one<1>(o[1], vb, pa0, pa1, pa2, pa3); pv_one<2>(o[2], vb, pa0, pa1, pa2, pa3); pv_one<3>(o[3], vb, pa0, pa1, pa2, pa3);
}

struct Unit {
  const bf16_t* Q;
  const bf16_t* K;
  const bf16_t* V;
  bf16_t* O;
  float* LSE;
  int ldq, ldk, ldv, ldo, ldl;
  int nt;
  int qoff;
};

template <class CF, bool MASK, bool WLSE, int LDQ_ = 0, int LDK_ = 0, int LDV_ = 0, int LDO_ = 0>
__device__ __forceinline__ void attn_unit(const Unit& a, char* lds, const int tid) {
  const int ldq = LDQ_ ? LDQ_ : a.ldq, ldk = LDK_ ? LDK_ : a.ldk, ldv = LDV_ ? LDV_ : a.ldv, ldo = LDO_ ? LDO_ : a.ldo;
  constexpr int SDEPTH = CF::SDEPTH, ND0 = CF::ND0, SHM_V = CF::SHM_V, SHM_K = CF::SHM_K;
  const int wid = tid >> 6, lane = tid & 63, r32 = lane & 31, hi = lane >> 5;
  char* V_lds = lds; char* K_lds = lds + 2 * SHM_V;
  float* ws = (float*)(lds + CF::WS_OFF) + wid * 64; float* li_l = ws; float* al_l = ws + 32;
  float m_reg = -1e30f, l_reg = 0; f32x16 o[4] = {}; bf16x8 qr[8];
  const bf16_t* Qw = a.Q + (long)(wid * QBLK + r32) * ldq + hi * 8;
#pragma unroll
  for (int d0 = 0; d0 < 8; ++d0) qr[d0] = ld8(Qw + d0 * 16);
  char* const qx = lds + CF::QX_OFF + wid * 4096 + lane * 16;
  if constexpr (ND0 > 8) {
#pragma unroll
    for (int d0 = 8; d0 < ND0; ++d0) *(bf16x8*)(qx + (d0 - 8) * 1024) = ld8(Qw + d0 * 16);
  }
  const int sr = tid >> 4, sc = (tid & 15) * 8, vst0 = v_st(sr, sc), vst1 = v_st(32 + sr, sc);
  const int kst0 = sr * CF::KPITCH + ((sc * 2) ^ ((sr & 7) << 4)), kst1 = kst0 + 32 * CF::KPITCH;
  const int kr2 = tid >> 3, kst2 = kr2 * CF::KPITCH + ((256 + (tid & 7) * 16) ^ ((kr2 & 7) << 4));
  const bf16_t* const Vg = a.V; const bf16_t* const Kg = a.K;
  const int voff0 = sr * ldv + sc, koff0 = sr * ldk + sc, koff2 = kr2 * ldk + 128 + (tid & 7) * 8;
  const int vb0 = (int)(uintptr_t)V_lds + v_rd_base(lane);
  struct { bf16x8 vs0, vs1, ks0, ks1, ks2; } sr_[SDEPTH];
#define ATT_SLOAD(i, k0) do { const bf16_t* vt_ = Vg + (long)(k0) * ldv; const bf16_t* kt_ = Kg + (long)(k0) * ldk; \
    sr_[i].vs0 = ld8(vt_ + voff0); sr_[i].vs1 = ld8(vt_ + 32 * ldv + voff0); \
    sr_[i].ks0 = ld8(kt_ + koff0); sr_[i].ks1 = ld8(kt_ + 32 * ldk + koff0); if constexpr (ND0 == 12) sr_[i].ks2 = ld8(kt_ + koff2); } while (0)
#define ATT_SWRITE(b, i) do { *(bf16x8*)(V_lds + (b) * SHM_V + vst0) = sr_[i].vs0; *(bf16x8*)(V_lds + (b) * SHM_V + vst1) = sr_[i].vs1; \
    *(bf16x8*)(K_lds + (b) * SHM_K + kst0) = sr_[i].ks0; *(bf16x8*)(K_lds + (b) * SHM_K + kst1) = sr_[i].ks1; if constexpr (ND0 == 12) *(bf16x8*)(K_lds + (b) * SHM_K + kst2) = sr_[i].ks2; } while (0)
#define ATT_SWAIT() do { if constexpr (SDEPTH == 2) { if constexpr (ND0 == 12) asm volatile("s_waitcnt vmcnt(5)" ::: "memory"); else asm volatile("s_waitcnt vmcnt(4)" ::: "memory"); } else asm volatile("s_waitcnt vmcnt(0)" ::: "memory"); } while (0)
#define ATT_RESC(al) do { if (__any((al) < 1.f)) { if (hi == 0) al_l[r32] = (al); asm volatile("s_waitcnt lgkmcnt(0)" ::: "memory"); \
    _Pragma("unroll") for (int d = 0; d < 4; ++d) _Pragma("unroll") for (int r = 0; r < 16; ++r) o[d][r] *= al_l[crow(r, hi)]; } } while (0)
  f32x16 pA0, pA1, pB0, pB1; float mnA, mnB, alA, alB; bf16x8 pa0, pa1, pa2, pa3; const int NT = a.nt;
  const int qi = a.qoff + wid * QBLK + r32;
  constexpr int SE = 0, SO = SDEPTH - 1;
  ATT_SLOAD(SE, 0); asm volatile("s_waitcnt vmcnt(0)" ::: "memory"); ATT_SWRITE(0, SE); ATT_SYNC();
  qkt<CF>(pA0, pA1, K_lds, qr, qx, r32, hi); if constexpr (MASK) bandmask(pA0, pA1, 0, qi, hi); partialSM<CF>(pA0, pA1, m_reg, mnA, alA);
  ATT_SLOAD(SO, KVBLK); if constexpr (SDEPTH == 2) { if (2 < NT) ATT_SLOAD(SE, 2 * KVBLK); }
  ATT_SWAIT(); ATT_SWRITE(1, SO); ATT_SYNC();
  for (int j = 1; j + 1 < NT; j += 2) {
    ATT_SBAR(); qkt<CF>(pB0, pB1, K_lds + SHM_K, qr, qx, r32, hi); if constexpr (MASK) bandmask(pB0, pB1, j * KVBLK, qi, hi);
    finishSM(pA0, pA1, alA, l_reg, pa0, pa1, pa2, pa3); ATT_SBAR();
    ATT_SLOAD(SO, (j + SDEPTH) * KVBLK); ATT_SBAR();
    pv_d0(o, vb0, pa0, pa1, pa2, pa3); partialSM<CF>(pB0, pB1, m_reg, mnB, alB);
    ATT_SYNC(); ATT_SWAIT(); ATT_SWRITE(0, SE);
    ATT_RESC(alB); ATT_SYNC();
    ATT_SBAR(); qkt<CF>(pA0, pA1, K_lds, qr, qx, r32, hi); if constexpr (MASK) bandmask(pA0, pA1, (j + 1) * KVBLK, qi, hi);
    finishSM(pB0, pB1, alB, l_reg, pa0, pa1, pa2, pa3); ATT_SBAR();
    if (SDEPTH == 1 || j + 3 < NT) ATT_SLOAD(SE, (j + 1 + SDEPTH) * KVBLK); ATT_SBAR();
    pv_d0(o, vb0 + SHM_V, pa0, pa1, pa2, pa3); partialSM<CF>(pA0, pA1, m_reg, mnA, alA);
    ATT_SYNC(); ATT_SWAIT(); ATT_SWRITE(1, SO);
    ATT_RESC(alA); ATT_SYNC();
  }
  ATT_SBAR(); qkt<CF>(pB0, pB1, K_lds + SHM_K, qr, qx, r32, hi); if constexpr (MASK) bandmask(pB0, pB1, (NT - 1) * KVBLK, qi, hi);
  finishSM(pA0, pA1, alA, l_reg, pa0, pa1, pa2, pa3); ATT_SBAR();
  pv_d0(o, vb0, pa0, pa1, pa2, pa3); partialSM<CF>(pB0, pB1, m_reg, mnB, alB);
  ATT_SYNC(); ATT_RESC(alB);
  finishSM(pB0, pB1, alB, l_reg, pa0, pa1, pa2, pa3); ATT_SBAR();
  pv_d0(o, vb0 + SHM_V, pa0, pa1, pa2, pa3);
  if (hi == 0) li_l[r32] = l_reg; asm volatile("s_waitcnt lgkmcnt(0)" ::: "memory");
  float rli[16];
#pragma unroll
  for (int r = 0; r < 16; ++r) rli[r] = __builtin_amdgcn_rcpf(li_l[crow(r, hi)]);
  if constexpr (WLSE) { if (hi == 0) a.LSE[(long)(wid * QBLK + r32) * a.ldl] = m_reg * CF::SCALE + __logf(l_reg); }
#ifdef ATT_EPI_DIRECT
  { bf16_t* Ow = a.O + (long)(wid * QBLK) * ldo;
#pragma unroll
  for (int r = 0; r < 16; ++r) { const int orow = crow(r, hi);
#pragma unroll
    for (int d0 = 0; d0 < 4; ++d0) Ow[(long)orow * ldo + d0 * 32 + r32] = (unsigned short)cvtpk(o[d0][r] * rli[r], 0.f); } }
  ATT_SYNC();
#else
  ATT_SYNC();
  char* Ost = lds + wid * CF::OST_WAVE;
#pragma unroll
  for (int r = 0; r < 16; ++r) { const int orow = crow(r, hi);
#pragma unroll
    for (int d0 = 0; d0 < 4; ++d0) { const float v = o[d0][r] * rli[r]; *(unsigned short*)(Ost + orow * CF::OST_PITCH + (d0 * 32 + r32) * 2) = (unsigned short)cvtpk(v, v); } }
  asm volatile("s_waitcnt lgkmcnt(0)" ::: "memory");
  bf16_t* Ow = a.O + (long)(wid * QBLK) * ldo;
#pragma unroll
  for (int i = 0; i < 8; ++i) { const int c = lane + 64 * i, row = c >> 4, ch = c & 15;
    const u32x4 v = *(const u32x4*)(Ost + row * CF::OST_PITCH + ch * 16); *(u32x4*)(Ow + (long)row * ldo + ch * 8) = v; }
  asm volatile("s_waitcnt lgkmcnt(0)" ::: "memory");
  ATT_SYNC();
#endif
#undef ATT_SLOAD
#undef ATT_SWRITE
#undef ATT_SWAIT
#undef ATT_RESC
}
}
__device__ const float RF64_HI[32] = {1.591549367e-01f, 1.193493679e-01f, 8.949939907e-02f, 6.711508334e-02f, 5.032921210e-02f, 3.774158657e-02f, 2.830219641e-02f, 2.122365311e-02f, 1.591549441e-02f, 1.193493698e-02f, 8.949940093e-03f, 6.711508147e-03f, 5.032921210e-03f, 3.774158424e-03f, 2.830219688e-03f, 2.122365171e-03f, 1.591549488e-03f, 1.193493721e-03f, 8.949940093e-04f, 6.711508031e-04f, 5.032921326e-04f, 3.774158540e-04f, 2.830219455e-04f, 2.122365258e-04f, 1.591549371e-04f, 1.193493736e-04f, 8.949940093e-05f, 6.711508468e-05f, 5.032921035e-05f, 3.774158540e-05f, 2.830219637e-05f, 2.122365186e-05f};
__device__ const float RF64_LO[32] = {6.420638243e-09f, 2.294664903e-09f, 2.542919653e-09f, -3.316028840e-10f, 5.173299289e-12f, -1.848551645e-09f, -5.826552019e-10f, -3.431038786e-10f, -1.029942243e-10f, 4.320196978e-11f, 6.802745173e-11f, 1.531042237e-10f, 5.173301024e-13f, 4.797548470e-11f, -1.048316434e-10f, 1.053879969e-10f, -5.686555046e-11f, -1.896286773e-11f, 6.802744999e-12f, 2.695195456e-11f, -1.158979943e-11f, -6.843983713e-12f, 1.279990003e-11f, 1.807650600e-12f, 5.954976963e-12f, -3.351478166e-12f, 6.802745216e-13f, -1.670379113e-12f, 1.751403167e-12f, -6.843983930e-13f, -5.389994549e-13f, 9.083608431e-13f};
__device__ const float RF32_HI[16] = {1.591549367e-01f, 7.008652389e-02f, 3.086376376e-02f, 1.359137055e-02f, 5.985185504e-03f, 2.635675948e-03f, 1.160663669e-03f, 5.111175124e-04f, 2.250790858e-04f, 9.911730740e-05f, 4.364795313e-05f, 1.922110096e-05f, 8.464330676e-06f, 3.727408512e-06f, 1.641426252e-06f, 7.228293271e-07f};
__device__ const float RF32_LO[16] = {6.420638243e-09f, -2.302696700e-09f, -3.597993847e-10f, 9.086624508e-11f, 2.087540557e-10f, -4.944578774e-11f, -2.775752544e-11f, -7.822671330e-12f, -6.755001072e-12f, 1.969154007e-12f, -3.416928741e-13f, -2.712567042e-13f, 1.318804142e-13f, 9.029300745e-14f, 1.098673646e-14f, -2.017673985e-14f};
constexpr int DM = 2048, DFF = 8192, DEPTH = 4, PLED = 256;
constexpr int NTOK = 65536, NPROMPT = 32768, SEQ_P = 4096, SEQ_S = 8192;
constexpr int CT = 16384, NCH = NTOK / CT;
constexpr float EPS = 1e-6f;
constexpr int NWAVES = 8;
enum { I_XP = 0, I_XS, I_PP, I_PS, I_NMIX, I_NMLP, I_WIN, I_WOUT, I_WPLE, I_PLEG, I_GATEG, I_WGATE,
       I_AQKV, I_AQG, I_AKG, I_AO, I_BDQ, I_BCQG, I_BCKVG, I_BUQ, I_BUKV, I_BQG, I_BKG, I_BO, I_CQKV, I_CQG, I_CKG, I_CO, N_IN };
constexpr size_t SZ_IN = (size_t)DFF * DM, SZ_OUT = (size_t)DM * DFF, SZ_PLE = (size_t)DM * PLED, SZ_GATE = (size_t)DM * DM;
constexpr size_t SZ_AQKV = (size_t)3072 * DM, SZ_AO = (size_t)DM * DM;
constexpr size_t SZ_BDQ = (size_t)1280 * DM, SZ_BUQ = (size_t)3072 * 512, SZ_BUKV = (size_t)4096 * 512, SZ_BO = (size_t)DM * DM;
constexpr size_t SZ_CQKV = (size_t)9216 * DM, SZ_CO = (size_t)DM * 1024;
constexpr size_t OFF_IN = 0, OFF_OUT = OFF_IN + 4 * SZ_IN, OFF_PLE = OFF_OUT + 4 * SZ_OUT, OFF_GATE = OFF_PLE + 4 * SZ_PLE;
constexpr size_t OFF_AQKV = OFF_GATE + 4 * SZ_GATE, OFF_AO = OFF_AQKV + 2 * SZ_AQKV;
constexpr size_t OFF_BDQ = OFF_AO + 2 * SZ_AO, OFF_BUQ = OFF_BDQ + SZ_BDQ, OFF_BUKV = OFF_BUQ + SZ_BUQ, OFF_BO = OFF_BUKV + SZ_BUKV;
constexpr size_t OFF_CQKV = OFF_BO + SZ_BO, OFF_CO = OFF_CQKV + SZ_CQKV, WT_TOTAL = OFF_CO + SZ_CO;
constexpr size_t MiB = 1u << 20;
constexpr size_t WS_CTL = 0, CTL_ZERO_BYTES = 1 * MiB;
constexpr size_t WS_T64 = 1 * MiB;
constexpr size_t WS_T32 = 3 * MiB;
constexpr size_t WS_RSTD = 4 * MiB;
constexpr size_t WS_LSE = 5 * MiB;
constexpr size_t WS_WT = 8 * MiB;
constexpr size_t WS_H = WS_WT + ((WT_TOTAL * 2 + MiB - 1) / MiB) * MiB;
constexpr size_t WS_PB = WS_H + (size_t)CT * DM * 2;
constexpr size_t WS_E0 = WS_PB + (size_t)CT * PLED * 2;
constexpr size_t WS_BIG = WS_E0 + (size_t)CT * DM * 2;
constexpr size_t CTB = (size_t)CT * 2;
constexpr size_t B_HID = 0;
constexpr size_t A_QKV = 0, A_O = A_QKV + CTB * 3072;
constexpr size_t BB_LAT = 0, BB_CQ = BB_LAT + CTB * 1280, BB_CKV = BB_CQ + CTB * 512, BB_QB = BB_CKV + CTB * 512, BB_KVB = BB_QB + CTB * 3072, BB_KF = BB_KVB + CTB * 4096, BB_O = BB_KF + CTB * 3072, BB_END = BB_O + CTB * 2048;
constexpr size_t C_QKV = 0, C_OG = C_QKV + CTB * 9216, C_MRG = C_OG + 3 * CTB * 1024, C_END = C_MRG + CTB * 1024;
constexpr size_t BIG_BYTES = BB_END > CTB * 8192 ? (BB_END > C_END ? BB_END : C_END) : (CTB * 8192 > C_END ? CTB * 8192 : C_END);
constexpr size_t WS_END = WS_BIG + BIG_BYTES;
constexpr int CW_BAR = 4096;
constexpr int RING_BYTES = 131072, LDSCTL_OFF = RING_BYTES, MISC_OFF = LDSCTL_OFF + 320, LDS_BYTES = 147456;

#define GAS __attribute__((address_space(1)))
#define LAS __attribute__((address_space(3)))
typedef unsigned short bf16;
typedef unsigned v4u __attribute__((ext_vector_type(4)));
typedef unsigned v2u __attribute__((ext_vector_type(2)));
typedef float f32x4 __attribute__((ext_vector_type(4)));
typedef float f32x2 __attribute__((ext_vector_type(2)));
#define LDS_WAIT() asm volatile("s_waitcnt lgkmcnt(0)" ::: "memory")
#define VM_WAIT() asm volatile("s_waitcnt vmcnt(0)" ::: "memory")
__device__ __forceinline__ unsigned pk2(float lo, float hi) { unsigned r; asm volatile("v_cvt_pk_bf16_f32 %0, %1, %2" : "=v"(r) : "v"(lo), "v"(hi)); return r; }
__device__ __forceinline__ float bflo(unsigned w) { return __uint_as_float(w << 16); }
__device__ __forceinline__ float bfhi(unsigned w) { return __uint_as_float(w & 0xffff0000u); }

#define XB_TMO      128
#define XB_XCNT(j)  (256  + 64 * (j))
#define XB_XSUB(j)  (1280 + 64 * (j))
#define XB_XGEN(j)  (2304 + 64 * (j))
#define XB_TOP      3328
#define XB_TOPGEN   3392
#define XCD_BAR_WORDS 3456
#define XB_SPIN_CAP (1u << 18)
__device__ __forceinline__ unsigned xb_ld(unsigned* p)              { return __hip_atomic_load(p, __ATOMIC_RELAXED, __HIP_MEMORY_SCOPE_AGENT); }
__device__ __forceinline__ unsigned xb_add(unsigned* p, unsigned v) { return __hip_atomic_fetch_add(p, v, __ATOMIC_RELAXED, __HIP_MEMORY_SCOPE_AGENT); }
__device__ __forceinline__ unsigned xb_xcc_id() { return (unsigned)__builtin_amdgcn_s_getreg((3 << 11) | 20) & 0xFu; }
#define XB_SPIN(cond, bar) do { unsigned _sp = 0; while (cond) { __builtin_amdgcn_s_sleep(1); \
    if ((++_sp & 255u) == 0u) { if (xb_ld(&(bar)[XB_TMO])) break; if (_sp > XB_SPIN_CAP) { atomicAdd(&(bar)[XB_TMO], 1u); break; } } } } while (0)
struct XcdBarrier { unsigned* bar; unsigned x; volatile LAS unsigned* st; };
__device__ __forceinline__ XcdBarrier xcd_barrier_post(unsigned* bar, volatile LAS unsigned* st) {
    XcdBarrier b; b.bar = bar; b.x = xb_xcc_id(); b.st = st;
    if (threadIdx.x == 0) (void)xb_add(&bar[XB_XCNT(b.x)], 1u);
    return b;
}
__device__ __forceinline__ void xcd_barrier_complete(unsigned* bar, unsigned x, unsigned& nloc, unsigned& nx) {
    const unsigned G = gridDim.x * gridDim.y * gridDim.z;
    unsigned sum, cnt, mine, sp = 0u;
    for (;;) {
        sum = 0u; cnt = 0u; mine = 0u;
#pragma unroll
        for (unsigned j = 0; j < 16; ++j) { const unsigned c = xb_ld(&bar[XB_XCNT(j)]); sum += c; cnt += (c > 0u) ? 1u : 0u; mine = (j == x) ? c : mine; }
        if (sum == G) break;
        __builtin_amdgcn_s_sleep(1);
        if ((++sp & 255u) == 0u) { if (xb_ld(&bar[XB_TMO])) break; if (sp > XB_SPIN_CAP) { atomicAdd(&bar[XB_TMO], 1u); break; } }
    }
    nloc = mine > 0u ? mine : 1u; nx = cnt > 0u ? cnt : 1u;
}
__device__ __forceinline__ void xcd_barrier(const XcdBarrier& b) {
    asm volatile("s_waitcnt vmcnt(0)" ::: "memory");
    __syncthreads();
    if (threadIdx.x == 0) {
        unsigned* bar = b.bar; asm volatile("" : "+s"(bar));
        __builtin_amdgcn_s_waitcnt(0);
        unsigned bx_ = xb_xcc_id(); asm volatile("" : "+s"(bx_));
        unsigned nloc = b.st[0], nx = b.st[1];
        if (nloc == 0u) { xcd_barrier_complete(bar, bx_, nloc, nx); b.st[0] = nloc; b.st[1] = nx; }
        const unsigned old = xb_add(&bar[XB_XSUB(bx_)], 1u);
        const unsigned gen = old / nloc;
        if (old + 1u == (gen + 1u) * nloc) {
            __builtin_amdgcn_fence(__ATOMIC_RELEASE, "agent");
            asm volatile("s_waitcnt vmcnt(0)" ::: "memory");
            const unsigned og = xb_add(&bar[XB_TOP], 1u);
            const unsigned tg = og / nx;
            if (og + 1u == (tg + 1u) * nx) xb_add(&bar[XB_TOPGEN], 1u);
            else XB_SPIN(xb_ld(&bar[XB_TOPGEN]) == tg, bar);
            __builtin_amdgcn_fence(__ATOMIC_ACQUIRE, "agent");
            xb_add(&bar[XB_XGEN(bx_)], 1u);
            asm volatile("s_waitcnt vmcnt(0)" ::: "memory");
        } else {
            XB_SPIN(xb_ld(&bar[XB_XGEN(bx_)]) == gen, bar);
            __builtin_amdgcn_fence(__ATOMIC_ACQUIRE, "agent");
            asm volatile("s_waitcnt vmcnt(0)" ::: "memory");
        }
    }
    __syncthreads();
}

__device__ __forceinline__ float shx(float v, int lane, int o) { return __int_as_float(__builtin_amdgcn_ds_bpermute((lane ^ o) << 2, __float_as_int(v))); }
__device__ __forceinline__ float wave_sum(float v, int lane) {
#pragma unroll
    for (int o = 1; o < 64; o <<= 1) v += shx(v, lane, o);
    return v;
}
__device__ __forceinline__ float sum16(float v, int lane) {
#pragma unroll
    for (int o = 1; o < 16; o <<= 1) v += shx(v, lane, o);
    return v;
}
__device__ __forceinline__ void unpack8(const v4u w, float (&f)[8]) { f[0] = bflo(w.x); f[1] = bfhi(w.x); f[2] = bflo(w.y); f[3] = bfhi(w.y); f[4] = bflo(w.z); f[5] = bfhi(w.z); f[6] = bflo(w.w); f[7] = bfhi(w.w); }
__device__ __forceinline__ v4u pack8(const float (&f)[8]) { v4u w; w.x = pk2(f[0], f[1]); w.y = pk2(f[2], f[3]); w.z = pk2(f[4], f[5]); w.w = pk2(f[6], f[7]); return w; }

__device__ __forceinline__ void p0_transpose_item(const float* W, int K, int N, bf16* WT, LAS float* scr, int item, int lane) {
    const int nblk = N / 32, kb = item / nblk, nb = item % nblk, k0 = 64 * kb, n0 = 32 * nb;
#pragma unroll 8
    for (int i = 0; i < 32; ++i) { const int kk = 2 * i + (lane >> 5); scr[kk * 33 + (lane & 31)] = W[(size_t)(k0 + kk) * N + n0 + (lane & 31)]; }
    LDS_WAIT(); asm volatile("" ::: "memory");
    const int c = lane & 7;
#pragma unroll
    for (int j = 0; j < 4; ++j) { const int n = (lane >> 3) + 8 * j; const LAS float* s = scr + (8 * c) * 33 + n;
        v4u o; o.x = pk2(s[0 * 33], s[1 * 33]); o.y = pk2(s[2 * 33], s[3 * 33]); o.z = pk2(s[4 * 33], s[5 * 33]); o.w = pk2(s[6 * 33], s[7 * 33]);
        *(GAS v4u*)(WT + (size_t)(n0 + n) * K + k0 + 8 * c) = o; }
    LDS_WAIT(); asm volatile("" ::: "memory");
}

__device__ __forceinline__ void norm_rows(const float* __restrict__ src, float* __restrict__ cpy, bf16* __restrict__ H, const float* __restrict__ g,
                                          const bf16* __restrict__ e0, float* __restrict__ rs_out, int nrows, int gw, int NGW, int lane) {
    f32x4 gv[8];
#pragma unroll
    for (int j = 0; j < 8; ++j) gv[j] = ((const f32x4*)g)[lane + 64 * j];
    for (int m = gw; m < nrows; m += NGW) {
        const f32x4* xr = (const f32x4*)(src + (size_t)m * DM) + lane;
        f32x4 v[8]; float s = 0.f;
#pragma unroll
        for (int j = 0; j < 8; ++j) { v[j] = xr[64 * j]; s += (v[j].x * v[j].x + v[j].y * v[j].y) + (v[j].z * v[j].z + v[j].w * v[j].w); }
        if (cpy) { f32x4* cr = (f32x4*)(cpy + (size_t)m * DM) + lane;
#pragma unroll
            for (int j = 0; j < 8; ++j) cr[64 * j] = v[j]; }
        const float rstd = __builtin_amdgcn_rsqf(wave_sum(s, lane) * (1.f / DM) + EPS);
        v2u* o8 = (v2u*)(H + (size_t)m * DM) + lane;
#pragma unroll
        for (int j = 0; j < 8; ++j) { const f32x4 y = v[j] * rstd * gv[j]; v2u w; w.x = pk2(y.x, y.y); w.y = pk2(y.z, y.w); o8[64 * j] = w; }
        if (e0) {
            const v4u* er = (const v4u*)(e0 + (size_t)m * DM) + lane; float q = 0.f;
#pragma unroll
            for (int j = 0; j < 4; ++j) { float f[8]; unpack8(er[64 * j], f);
#pragma unroll
                for (int t = 0; t < 8; ++t) q += f[t] * f[t]; }
            q = wave_sum(q, lane);
            if (lane == 0) rs_out[m] = __builtin_amdgcn_rsqf(q * (1.f / DM) + EPS);
        }
    }
}

__device__ __forceinline__ void a_qknorm_rope(bf16* __restrict__ qkv, const float* __restrict__ qg, const float* __restrict__ kg, const f32x2* __restrict__ T64, int seqmask, int gw, int NGW, int lane) {
    const int q16 = lane & 15, sub = lane >> 4;
    for (int it = gw; it < CT * 5; it += NGW) {
        const int tl = it / 5, quad = it % 5, hv = quad * 4 + sub;
        bf16* p = qkv + (size_t)tl * 3072 + (hv < 16 ? hv * 128 : 2048 + (hv - 16) * 128) + q16 * 8;
        const float* g = (hv < 16 ? qg : kg) + q16 * 8;
        float f[8]; unpack8(*(const v4u*)p, f);
        float s = 0.f;
#pragma unroll
        for (int t = 0; t < 8; ++t) s += f[t] * f[t];
        const float rstd = __builtin_amdgcn_rsqf(sum16(s, lane) * (1.f / 128.f) + EPS);
        const f32x4 g0 = *(const f32x4*)g, g1 = *(const f32x4*)(g + 4);
        float y[8];
#pragma unroll
        for (int t = 0; t < 4; ++t) { y[t] = f[t] * rstd * g0[t]; y[4 + t] = f[4 + t] * rstd * g1[t]; }
        const int t = tl & seqmask, pos = (q16 < 8) ? (t >> 6) : (t & 63);
        const f32x2* cs = T64 + (size_t)pos * 32 + (q16 & 3) * 8;
        const bool first = (q16 & 4) == 0;
        float o[8];
#pragma unroll
        for (int e = 0; e < 8; ++e) { const float other = shx(y[e], lane, 4); const f32x2 c = cs[e];
            o[e] = first ? (y[e] * c.x - other * c.y) : (y[e] * c.x + other * c.y); }
        *(v4u*)p = pack8(o);
    }
}
__device__ __forceinline__ void b_latnorm(const bf16* __restrict__ lat, bf16* __restrict__ cq, bf16* __restrict__ ckv, const float* __restrict__ cqg, const float* __restrict__ ckvg, int gw, int NGW, int lane) {
    for (int it = gw; it < CT * 2; it += NGW) {
        const int tl = it >> 1, which = it & 1;
        float f[8]; unpack8(*(const v4u*)(lat + (size_t)tl * 1280 + which * 512 + lane * 8), f);
        float s = 0.f;
#pragma unroll
        for (int t = 0; t < 8; ++t) s += f[t] * f[t];
        const float rstd = __builtin_amdgcn_rsqf(wave_sum(s, lane) * (1.f / 512.f) + EPS);
        const float* g = (which ? ckvg : cqg) + lane * 8; const f32x4 g0 = *(const f32x4*)g, g1 = *(const f32x4*)(g + 4);
        float y[8];
#pragma unroll
        for (int t = 0; t < 4; ++t) { y[t] = f[t] * rstd * g0[t]; y[4 + t] = f[4 + t] * rstd * g1[t]; }
        *(v4u*)((which ? ckv : cq) + (size_t)tl * 512 + lane * 8) = pack8(y);
    }
}
__device__ __forceinline__ void b_qknorm_rope(bf16* __restrict__ qb, const bf16* __restrict__ kvb, const bf16* __restrict__ lat, bf16* __restrict__ kf, const float* __restrict__ qg, const float* __restrict__ kg,
                                              const f32x2* __restrict__ T64, int seqmask, int gw, int NGW, int lane) {
    const int q16 = lane & 15, sub = lane >> 4;
    for (int it = gw; it < CT * 8; it += NGW) {
        const int tl = it >> 3, isk = (it >> 2) & 1, h = (it & 3) * 4 + sub;
        const bf16* pn = isk ? (kvb + (size_t)tl * 4096 + h * 256 + q16 * 8) : (qb + (size_t)tl * 3072 + h * 192 + q16 * 8);
        const bf16* pr = isk ? (lat + (size_t)tl * 1280 + 1024 + q16 * 4) : (qb + (size_t)tl * 3072 + h * 192 + 128 + q16 * 4);
        bf16* on = (isk ? kf : qb) + (size_t)tl * 3072 + h * 192 + q16 * 8; bf16* orp = (isk ? kf : qb) + (size_t)tl * 3072 + h * 192 + 128 + q16 * 4;
        const float* g = isk ? kg : qg;
        float f[8]; unpack8(*(const v4u*)pn, f); const v2u rw = *(const v2u*)pr; float r[4] = {bflo(rw.x), bfhi(rw.x), bflo(rw.y), bfhi(rw.y)};
        float s = 0.f;
#pragma unroll
        for (int t = 0; t < 8; ++t) s += f[t] * f[t];
#pragma unroll
        for (int t = 0; t < 4; ++t) s += r[t] * r[t];
        const float rstd = __builtin_amdgcn_rsqf(sum16(s, lane) * (1.f / 192.f) + EPS);
        const f32x4 g0 = *(const f32x4*)(g + q16 * 8), g1 = *(const f32x4*)(g + q16 * 8 + 4), g2 = *(const f32x4*)(g + 128 + q16 * 4);
        float y[8], yr[4];
#pragma unroll
        for (int t = 0; t < 4; ++t) { y[t] = f[t] * rstd * g0[t]; y[4 + t] = f[4 + t] * rstd * g1[t]; yr[t] = r[t] * rstd * g2[t]; }
        const int pos = tl & seqmask;
        const f32x2* cs = T64 + (size_t)pos * 32 + (q16 & 7) * 4;
        const bool first = (q16 & 8) == 0;
        float o[4];
#pragma unroll
        for (int e = 0; e < 4; ++e) { const float other = shx(yr[e], lane, 8); const f32x2 c = cs[e];
            o[e] = first ? (yr[e] * c.x - other * c.y) : (yr[e] * c.x + other * c.y); }
        *(v4u*)on = pack8(y); v2u ow; ow.x = pk2(o[0], o[1]); ow.y = pk2(o[2], o[3]); *(v2u*)orp = ow;
    }
}
__device__ __forceinline__ void c_qknorm_rope(bf16* __restrict__ qkv, const float* __restrict__ qg, const float* __restrict__ kg, const f32x2* __restrict__ T32, int seqmask, int gw, int NGW, int lane) {
    const int q16 = lane & 15, sub = lane >> 4;
    for (int it = gw; it < CT * 12; it += NGW) {
        const int tl = it / 12, quad = it % 12, hv = quad * 4 + sub;
        bf16* p = qkv + (size_t)tl * 9216 + hv * 128 + q16 * 8;
        const float* g = (hv < 24 ? qg : kg) + q16 * 8;
        float f[8]; unpack8(*(const v4u*)p, f);
        float s = 0.f;
#pragma unroll
        for (int t = 0; t < 8; ++t) s += f[t] * f[t];
        const float rstd = __builtin_amdgcn_rsqf(sum16(s, lane) * (1.f / 128.f) + EPS);
        const f32x4 g0 = *(const f32x4*)g, g1 = *(const f32x4*)(g + 4);
        float y[8];
#pragma unroll
        for (int t = 0; t < 4; ++t) { y[t] = f[t] * rstd * g0[t]; y[4 + t] = f[4 + t] * rstd * g1[t]; }
        const int pos = tl & seqmask;
        const f32x2* cs = T32 + (size_t)pos * 16 + (q16 & 1) * 8;
        const bool first = (q16 & 2) == 0, roped = q16 < 4;
        float o[8];
#pragma unroll
        for (int e = 0; e < 8; ++e) { const float other = shx(y[e], lane, 2); const f32x2 c = cs[e];
            const float rv = first ? (y[e] * c.x - other * c.y) : (y[e] * c.x + other * c.y); o[e] = roped ? rv : y[e]; }
        *(v4u*)p = pack8(o);
    }
}
__device__ __forceinline__ void c_merge(const bf16* __restrict__ og, const float* __restrict__ lse, bf16* __restrict__ mrg, int gw, int NGW, int lane) {
    const int q16 = lane & 15, sub = lane >> 4;
    for (int it = gw; it < CT * 2; it += NGW) {
        const int tl = it >> 1, h = (it & 1) * 4 + sub;
        const float l0 = lse[(size_t)tl * 8 + h], l1 = lse[(size_t)CT * 8 + (size_t)tl * 8 + h], l2 = lse[(size_t)2 * CT * 8 + (size_t)tl * 8 + h];
        const float mx = fmaxf(l0, fmaxf(l1, l2));
        float w0 = __expf(l0 - mx), w1 = __expf(l1 - mx), w2 = __expf(l2 - mx); const float inv = 1.f / (w0 + w1 + w2); w0 *= inv; w1 *= inv; w2 *= inv;
        const size_t off = (size_t)tl * 1024 + h * 128 + q16 * 8;
        float a[8], b[8], c[8], o[8]; unpack8(*(const v4u*)(og + off), a); unpack8(*(const v4u*)(og + (size_t)CT * 1024 + off), b); unpack8(*(const v4u*)(og + (size_t)2 * CT * 1024 + off), c);
#pragma unroll
        for (int e = 0; e < 8; ++e) o[e] = w0 * a[e] + w1 * b[e] + w2 * c[e];
        *(v4u*)(mrg + off) = pack8(o);
    }
}
#ifndef ONLY
#define ONLY -1
#endif
#define PH(k) (ONLY < 0 || ONLY == (k))
struct Args { const float* in[N_IN]; float* out; unsigned char* ws; };
typedef att::Cfg<128, 2, 0> CfgA;
typedef att::Cfg<192, 1, 1> CfgB;
typedef att::Cfg<128, 2, 0> CfgC;
static_assert(CfgA::LDS_BYTES <= RING_BYTES && CfgB::LDS_BYTES <= RING_BYTES, "attention LDS");

__device__ __forceinline__ void weight_desc(const Args& a, bf16* WT, int mi, const float*& src, int& K, int& N, bf16*& dst) {
    if (mi < 16) { const int l = mi >> 2, t = mi & 3;
        if (t == 0)      { src = a.in[I_WIN] + (size_t)l * SZ_IN;    K = DM;   N = DFF; dst = WT + OFF_IN + (size_t)l * SZ_IN; }
        else if (t == 1) { src = a.in[I_WOUT] + (size_t)l * SZ_OUT;  K = DFF;  N = DM;  dst = WT + OFF_OUT + (size_t)l * SZ_OUT; }
        else if (t == 2) { src = a.in[I_WPLE] + (size_t)l * SZ_PLE;  K = PLED; N = DM;  dst = WT + OFF_PLE + (size_t)l * SZ_PLE; }
        else             { src = a.in[I_WGATE] + (size_t)l * SZ_GATE; K = DM;  N = DM;  dst = WT + OFF_GATE + (size_t)l * SZ_GATE; }
    } else if (mi < 20) { const int j = (mi - 16) >> 1, t = mi & 1;
        if (t == 0) { src = a.in[I_AQKV] + (size_t)j * SZ_AQKV; K = DM; N = 3072; dst = WT + OFF_AQKV + (size_t)j * SZ_AQKV; }
        else        { src = a.in[I_AO] + (size_t)j * SZ_AO;     K = DM; N = DM;   dst = WT + OFF_AO + (size_t)j * SZ_AO; }
    } else if (mi == 20) { src = a.in[I_BDQ];  K = DM;   N = 1088; dst = WT + OFF_BDQ; }
    else if (mi == 21)   { src = a.in[I_BUQ];  K = 512;  N = 3072; dst = WT + OFF_BUQ; }
    else if (mi == 22)   { src = a.in[I_BUKV]; K = 512;  N = 4096; dst = WT + OFF_BUKV; }
    else if (mi == 23)   { src = a.in[I_BO];   K = DM;   N = DM;   dst = WT + OFF_BO; }
    else if (mi == 24)   { src = a.in[I_CQKV]; K = DM;   N = 9216; dst = WT + OFF_CQKV; }
    else                 { src = a.in[I_CO];   K = 1024; N = DM;   dst = WT + OFF_CO; }
}
__device__ __forceinline__ void rope_entry(float pos, float fh, float fl, f32x2* out) {
    const float hi = pos * fh, err = fmaf(pos, fh, -hi);
    const float fr = (hi - rintf(hi)) + (err + pos * fl);
    f32x2 r; r.x = __builtin_amdgcn_cosf(fr); r.y = __builtin_amdgcn_sinf(fr); *out = r;
}

#define PHASE_VARS() int tid = threadIdx.x; int zi = 0; asm volatile("" : "+v"(tid), "+s"(zi)); \
    const int lane = tid & 63, wave = __builtin_amdgcn_readfirstlane(tid >> 6); \
    const int G = (int)gridDim.x + zi, bx = (int)blockIdx.x + zi; const bool g8 = (G % 8) == 0; \
    const int x8 = g8 ? bx % 8 : 0, r8 = g8 ? bx / 8 : bx, G8 = g8 ? G / 8 : G; const int vcu = g8 ? x8 * G8 + r8 : bx; \
    const int gw = vcu * NWAVES + wave, NGW = G * NWAVES; unsigned char* const ws = args.ws + zi; \
    (void)lane; (void)gw; (void)NGW; (void)x8; (void)r8; (void)G8; (void)ws
#define INP(i) (args.in[(i) + zi])
#define GEMM_PHASE(EPI, Aptr, Wptr, Mv, Nv, Kv, ...) do { pg8::Gemm g_{(Aptr), (Wptr), (Mv), (Nv), (Kv)}; pg8::StaticOrder S_; S_.init((Mv), (Nv), G, bx); \
    EPI E_{__VA_ARGS__}; pg8::gemm_phase<EPI, pg8::StaticOrder, true, true>(lds, g_, S_, E_, tid); } while (0)

__global__ void __launch_bounds__(NWAVES * 64, 2) mk_fwd(Args args) {
    extern __shared__ __attribute__((aligned(16))) unsigned char lds_raw[];
    LAS unsigned char* const lds = (LAS unsigned char*)lds_raw;
    volatile LAS unsigned* MISC = (volatile LAS unsigned*)(lds + MISC_OFF);
    for (int u = threadIdx.x; u < (LDS_BYTES - LDSCTL_OFF) / 4; u += NWAVES * 64) ((LAS unsigned*)(lds + LDSCTL_OFF))[u] = 0u;
    __syncthreads();
    XcdBarrier bar = xcd_barrier_post((unsigned*)(args.ws + WS_CTL) + CW_BAR, MISC + 8);
#define GRID_BAR() xcd_barrier(bar)

    {
        PHASE_VARS();
        bf16* const WT = (bf16*)(ws + WS_WT); f32x2* const T64 = (f32x2*)(ws + WS_T64); f32x2* const T32 = (f32x2*)(ws + WS_T32);
        LAS float* scr = (LAS float*)(lds + wave * 16384);
        for (int mi = 0; mi < 26; ++mi) {
            const float* src; int K, N; bf16* dst; weight_desc(args, WT, mi, src, K, N, dst);
            const int items = (K / 64) * (N / 32);
            for (int it = gw; it < items; it += NGW) p0_transpose_item(src, K, N, dst, scr, it, lane);
        }
        { v4u* z = (v4u*)(WT + OFF_BDQ + (size_t)1088 * DM); const int n16 = 192 * DM * 2 / 16; const v4u zero = {0u, 0u, 0u, 0u};
          for (int i = vcu * 512 + tid; i < n16; i += G * 512) z[i] = zero; }
        for (int i = vcu * 512 + tid; i < 8192 * 32; i += G * 512) { const int pos = i >> 5, j = i & 31; rope_entry((float)pos, RF64_HI[j], RF64_LO[j], T64 + i); }
        for (int i = vcu * 512 + tid; i < 8192 * 16; i += G * 512) { const int pos = i >> 4, j = i & 15; rope_entry((float)pos, RF32_HI[j], RF32_LO[j], T32 + i); }
    }
    GRID_BAR();

    for (int layer_ = 0; layer_ < DEPTH; ++layer_) {
        for (int c_ = 0; c_ < NCH; ++c_) {
#define CHUNK_VARS() const int layer = layer_ + zi, c = c_ + zi; const int lj = layer / 3; const size_t tok0 = (size_t)c * CT; const bool prompt = tok0 < (size_t)NPROMPT; \
    const int SEQ = prompt ? SEQ_P : SEQ_S, NQB = SEQ / 256; float* const X = args.out + tok0 * DM + zi; bf16* const WT = (bf16*)(ws + WS_WT); bf16* const Hb = (bf16*)(ws + WS_H); \
    unsigned char* const BIG = ws + WS_BIG; (void)lj; (void)SEQ; (void)NQB; (void)X; (void)WT; (void)Hb; (void)BIG; (void)prompt
            {
                PHASE_VARS(); CHUNK_VARS();
                const float* src = X; float* cpy = nullptr;
                if (layer == 0) { src = prompt ? INP(I_XP) + tok0 * DM : INP(I_XS) + (tok0 - NPROMPT) * DM; cpy = X; }
                norm_rows(src, cpy, Hb, INP(I_NMIX) + layer * DM, nullptr, nullptr, CT, gw, NGW, lane);
            }
            GRID_BAR();
            const int kind = layer_ % 3;
            if (kind == 0) {
                { PHASE_VARS(); CHUNK_VARS(); GEMM_PHASE(pg8::EpiBf16<0>, Hb, WT + OFF_AQKV + (size_t)lj * SZ_AQKV, CT, 3072, DM, (bf16*)(BIG + A_QKV), 3072); }
                GRID_BAR();
                { PHASE_VARS(); CHUNK_VARS(); a_qknorm_rope((bf16*)(BIG + A_QKV), INP(I_AQG) + lj * 128, INP(I_AKG) + lj * 128, (const f32x2*)(ws + WS_T64), SEQ - 1, gw, NGW, lane); }
                GRID_BAR();
                { const int nu = ((CT / 256) * 16 + (int)gridDim.x - 1) / (int)gridDim.x;
                  for (int i = 0; i < nu; ++i) { PHASE_VARS(); CHUNK_VARS(); bf16* const QKV = (bf16*)(BIG + A_QKV); bf16* const OB = (bf16*)(BIG + A_O);
                      const int U8 = g8 ? (CT / 256) * 16 / 8 : (CT / 256) * 16, UPG = 4 * NQB; if (r8 + G8 * i >= U8) break;
                      const int u = x8 * U8 + r8 + G8 * i, grp = u / UPG, w = u % UPG, s = grp >> 2, kvh = grp & 3, h = kvh * 4 + w / NQB, qb = w % NQB;
                      const size_t t0 = (size_t)s * SEQ, tq = t0 + (size_t)qb * 256;
                      att::Unit un; un.Q = QKV + tq * 3072 + h * 128; un.K = QKV + t0 * 3072 + 2048 + kvh * 128; un.V = un.K + 512; un.O = OB + tq * DM + h * 128; un.LSE = nullptr;
                      un.ldq = 3072; un.ldk = 3072; un.ldv = 3072; un.ldo = DM; un.ldl = 0; un.nt = SEQ / 64; un.qoff = 0;
                      att::attn_unit<CfgA, false, false, 3072, 3072, 3072, DM>(un, (char*)lds_raw, tid); } }
                GRID_BAR();
                { PHASE_VARS(); CHUNK_VARS(); GEMM_PHASE(pg8::EpiResid, (bf16*)(BIG + A_O), WT + OFF_AO + (size_t)lj * SZ_AO, CT, DM, DM, X, X, DM); }
                GRID_BAR();
            } else if (kind == 1) {
                { PHASE_VARS(); CHUNK_VARS(); GEMM_PHASE(pg8::EpiBf16<0>, Hb, WT + OFF_BDQ, CT, 1280, DM, (bf16*)(BIG + BB_LAT), 1280); }
                GRID_BAR();
                { PHASE_VARS(); CHUNK_VARS(); b_latnorm((bf16*)(BIG + BB_LAT), (bf16*)(BIG + BB_CQ), (bf16*)(BIG + BB_CKV), INP(I_BCQG), INP(I_BCKVG), gw, NGW, lane); }
                GRID_BAR();
                { PHASE_VARS(); CHUNK_VARS(); GEMM_PHASE(pg8::EpiBf16<0>, (bf16*)(BIG + BB_CQ), WT + OFF_BUQ, CT, 3072, 512, (bf16*)(BIG + BB_QB), 3072); }
                { PHASE_VARS(); CHUNK_VARS(); GEMM_PHASE(pg8::EpiBf16<0>, (bf16*)(BIG + BB_CKV), WT + OFF_BUKV, CT, 4096, 512, (bf16*)(BIG + BB_KVB), 4096); }
                GRID_BAR();
                { PHASE_VARS(); CHUNK_VARS(); b_qknorm_rope((bf16*)(BIG + BB_QB), (bf16*)(BIG + BB_KVB), (bf16*)(BIG + BB_LAT), (bf16*)(BIG + BB_KF), INP(I_BQG), INP(I_BKG), (const f32x2*)(ws + WS_T64), SEQ - 1, gw, NGW, lane); }
                GRID_BAR();
                { const int nu = ((CT / 256) * 16 + (int)gridDim.x - 1) / (int)gridDim.x;
                  for (int i = 0; i < nu; ++i) { PHASE_VARS(); CHUNK_VARS(); bf16* const QB = (bf16*)(BIG + BB_QB); bf16* const KVB = (bf16*)(BIG + BB_KVB); bf16* const KF = (bf16*)(BIG + BB_KF); bf16* const OB = (bf16*)(BIG + BB_O);
                      const int U8 = g8 ? (CT / 256) * 16 / 8 : (CT / 256) * 16; if (r8 + G8 * i >= U8) break;
                      const int u = x8 * U8 + r8 + G8 * i, grp = u / NQB, qb = u % NQB, s = grp >> 4, h = grp & 15;
                      const size_t t0 = (size_t)s * SEQ, tq = t0 + (size_t)qb * 256;
                      att::Unit un; un.Q = QB + tq * 3072 + h * 192; un.K = KF + t0 * 3072 + h * 192; un.V = KVB + t0 * 4096 + h * 256 + 128; un.O = OB + tq * DM + h * 128; un.LSE = nullptr;
                      un.ldq = 3072; un.ldk = 3072; un.ldv = 4096; un.ldo = DM; un.ldl = 0; un.nt = SEQ / 64; un.qoff = 0;
                      att::attn_unit<CfgB, false, false, 3072, 3072, 4096, DM>(un, (char*)lds_raw, tid); } }
                GRID_BAR();
                { PHASE_VARS(); CHUNK_VARS(); GEMM_PHASE(pg8::EpiResid, (bf16*)(BIG + BB_O), WT + OFF_BO, CT, DM, DM, X, X, DM); }
                GRID_BAR();
            } else {
                { PHASE_VARS(); CHUNK_VARS(); GEMM_PHASE(pg8::EpiBf16<0>, Hb, WT + OFF_CQKV, CT, 9216, DM, (bf16*)(BIG + C_QKV), 9216); }
                GRID_BAR();
                { PHASE_VARS(); CHUNK_VARS(); c_qknorm_rope((bf16*)(BIG + C_QKV), INP(I_CQG), INP(I_CKG), (const f32x2*)(ws + WS_T32), SEQ - 1, gw, NGW, lane); }
                GRID_BAR();
                { const int nu = ((CT / 256) * 24 + (int)gridDim.x - 1) / (int)gridDim.x;
                  for (int i = 0; i < nu; ++i) { PHASE_VARS(); CHUNK_VARS(); bf16* const QKV = (bf16*)(BIG + C_QKV); bf16* const OG = (bf16*)(BIG + C_OG); float* const LSE = (float*)(ws + WS_LSE);
                      const int U8 = g8 ? (CT / 256) * 24 / 8 : (CT / 256) * 24; if (r8 + G8 * i >= U8) break;
                      const int u = x8 * U8 + r8 + G8 * i, grp = u / NQB, blk = u % NQB, s = grp / 24, gh = grp % 24, gi = gh >> 3, h = gh & 7;
                      const int dsh = 2 * gi, d = 1 << dsh, L = SEQ >> dsh, NB = L / 256, res = blk / NB, l0 = (blk % NB) * 256;
                      const int nt = L / 64 < 6 ? L / 64 : 6; int kw0 = l0 - 64; if (kw0 < 0) kw0 = 0; if (kw0 > L - 64 * nt) kw0 = L - 64 * nt;
                      const size_t t0 = (size_t)s * SEQ + res, tq = t0 + (size_t)d * l0, tk = t0 + (size_t)d * kw0;
                      att::Unit un; un.Q = QKV + tq * 9216 + gh * 128; un.K = QKV + tk * 9216 + 3072 + gh * 128; un.V = un.K + 3072; un.O = OG + (size_t)gi * CT * 1024 + tq * 1024 + h * 128;
                      un.LSE = LSE + (size_t)gi * CT * 8 + tq * 8 + h;
                      un.ldq = d * 9216; un.ldk = d * 9216; un.ldv = d * 9216; un.ldo = d * 1024; un.ldl = d * 8; un.nt = nt; un.qoff = l0 - kw0;
                      att::attn_unit<CfgC, true, true>(un, (char*)lds_raw, tid); } }
                GRID_BAR();
                { PHASE_VARS(); CHUNK_VARS(); c_merge((bf16*)(BIG + C_OG), (float*)(ws + WS_LSE), (bf16*)(BIG + C_MRG), gw, NGW, lane); }
                GRID_BAR();
                { PHASE_VARS(); CHUNK_VARS(); GEMM_PHASE(pg8::EpiResid, (bf16*)(BIG + C_MRG), WT + OFF_CO, CT, DM, 1024, X, X, DM); }
                GRID_BAR();
            }
            { PHASE_VARS(); CHUNK_VARS();
              norm_rows(X, nullptr, Hb, INP(I_NMLP) + layer * DM, nullptr, nullptr, CT, gw, NGW, lane);
              const float* P = (prompt ? INP(I_PP) + ((size_t)layer * NPROMPT + tok0) * PLED : INP(I_PS) + ((size_t)layer * NPROMPT + (tok0 - NPROMPT)) * PLED); bf16* const PB = (bf16*)(ws + WS_PB);
              for (int i = vcu * 512 + tid; i < CT * PLED / 8; i += G * 512) { const f32x4 a0 = ((const f32x4*)P)[2 * i], a1 = ((const f32x4*)P)[2 * i + 1];
                  v4u w; w.x = pk2(a0.x, a0.y); w.y = pk2(a0.z, a0.w); w.z = pk2(a1.x, a1.y); w.w = pk2(a1.z, a1.w); ((v4u*)PB)[i] = w; } }
            GRID_BAR();
            { PHASE_VARS(); CHUNK_VARS(); GEMM_PHASE(pg8::EpiBf16<1>, Hb, WT + OFF_IN + (size_t)layer * SZ_IN, CT, DFF, DM, (bf16*)(BIG + B_HID), DFF); }
            { PHASE_VARS(); CHUNK_VARS(); GEMM_PHASE(pg8::EpiBf16<0>, (bf16*)(ws + WS_PB), WT + OFF_PLE + (size_t)layer * SZ_PLE, CT, DM, PLED, (bf16*)(ws + WS_E0), DM); }
            GRID_BAR();
            { PHASE_VARS(); CHUNK_VARS(); GEMM_PHASE(pg8::EpiResid, (bf16*)(BIG + B_HID), WT + OFF_OUT + (size_t)layer * SZ_OUT, CT, DM, DFF, X, X, DM); }
            GRID_BAR();
            { PHASE_VARS(); CHUNK_VARS(); norm_rows(X, nullptr, Hb, INP(I_GATEG) + layer * DM, (bf16*)(ws + WS_E0), (float*)(ws + WS_RSTD), CT, gw, NGW, lane); }
            GRID_BAR();
            { PHASE_VARS(); CHUNK_VARS(); GEMM_PHASE(pg8::EpiGate, Hb, WT + OFF_GATE + (size_t)layer * SZ_GATE, CT, DM, DM, X, X, DM, (bf16*)(ws + WS_E0), (float*)(ws + WS_RSTD), INP(I_PLEG) + layer * DM); }
            GRID_BAR();
        }
    }
#undef GRID_BAR
}

extern "C" void kernel_launch(void* const* d_in, const int* in_sizes, int n_in, void* d_out, int out_size, void* d_ws, size_t ws_size, hipStream_t stream) {
    static int grid = 0;
    if (grid == 0) {
        if (n_in != N_IN || out_size != NTOK * DM || ws_size < WS_END) { fprintf(stderr, "kernel_launch: shape mismatch: n_in %d out %d ws %zu (need %zu)\n", n_in, out_size, ws_size, (size_t)WS_END); grid = -1; return; }
        int dev = 0, cus = 0, per_cu = 0;
        if (hipGetDevice(&dev) != hipSuccess || hipDeviceGetAttribute(&cus, hipDeviceAttributeMultiprocessorCount, dev) != hipSuccess) { grid = -1; return; }
        if (hipFuncSetAttribute((const void*)mk_fwd, hipFuncAttributeMaxDynamicSharedMemorySize, LDS_BYTES) != hipSuccess) { fprintf(stderr, "kernel_launch: hipFuncSetAttribute failed\n"); grid = -1; return; }
        if (hipOccupancyMaxActiveBlocksPerMultiprocessor(&per_cu, (const void*)mk_fwd, NWAVES * 64, LDS_BYTES) != hipSuccess || per_cu < 1) { fprintf(stderr, "kernel_launch: occupancy query says %d\n", per_cu); }
        (void)hipGetLastError();
        grid = cus;
    }
    if (grid < 0) return;
    if (hipMemsetAsync((char*)d_ws + WS_CTL, 0, CTL_ZERO_BYTES, stream) != hipSuccess) return;
    Args a{};
    for (int i = 0; i < N_IN; ++i) a.in[i] = (const float*)d_in[i];
    a.out = (float*)d_out; a.ws = (unsigned char*)d_ws;
    hipLaunchKernelGGL(mk_fwd, dim3(grid), dim3(NWAVES * 64), LDS_BYTES, stream, a);
    const hipError_t le = hipPeekAtLastError();
    if (le != hipSuccess) fprintf(stderr, "kernel_launch: launch failed: %s\n", hipGetErrorName(le));
}
```

```cpp
#include <hip/hip_runtime.h>
#include <cstdio>
#include <cstdint>
namespace pg8 {
#define PG8_LAS __attribute__((address_space(3)))
typedef unsigned short bf16_t;
typedef short bf16x8 __attribute__((ext_vector_type(8)));
typedef float f32x4 __attribute__((ext_vector_type(4)));
typedef unsigned u32x4 __attribute__((ext_vector_type(4)));
constexpr int BM = 256, BK = 64, HALF = 128, HTB = HALF * BK * 2  , STAGE_BYTES = 8 * HTB, NXCD = 8, WGM = 8;

__host__ __device__ __forceinline__ int lds_byte(int r, int c) { const int st = (r >> 4) * 2 + (c >> 5), rr = r & 15, cc = c & 31, ob = rr * 64 + cc * 2; return st * 1024 + (ob ^ (((ob >> 9) & 1) << 5)); }
__host__ __device__ __forceinline__ void stage_rc(int b, int& R, int& C) { const int st = b / 1024, sb = b % 1024, swz = sb ^ (((sb >> 9) & 1) << 5); R = (st >> 1) * 16 + swz / 64; C = (st & 1) * 32 + (swz % 64) / 2; }
__host__ __device__ __forceinline__ int perm32(int rho) { const int n = rho >> 4, i = rho & 15; return 8 * (i >> 2) + 4 * n + (i & 3); }

struct Unit { int pm, pn; };
struct Gemm { const bf16_t* A; const bf16_t* Bt; int M, N, K; };

struct StaticOrder {
    int nM, nN, nwg, G, c;
    __host__ __device__ void init(int M, int N, int G_, int c_) { nM = M / BM; nN = N / BM; nwg = nM * nN; G = G_; c = c_; }
    __host__ __device__ bool next(int i, Unit& u) const {
        const long L = (long)i * G + c; if (L >= nwg) return false;
        int wgid = (int)L; { const int q = nwg / NXCD, r = nwg % NXCD, xcd = wgid % NXCD, off = wgid / NXCD; wgid = (xcd < r ? xcd * (q + 1) : r * (q + 1) + (xcd - r) * q) + off; }
        const int nig = WGM * nN, gid = wgid / nig, fm = gid * WGM, gsz = (nM - fm) < WGM ? (nM - fm) : WGM;
        u.pm = fm + ((wgid % nig) % gsz); u.pn = (wgid % nig) / gsz; return true;
    }
    __device__ __forceinline__ void a_ready(const Unit&) const {}
    __device__ __forceinline__ void done(const Unit&) const {}
};

__device__ __forceinline__ unsigned cvt_pk_bf16(float lo, float hi) { unsigned r; asm volatile("v_cvt_pk_bf16_f32 %0, %1, %2" : "=v"(r) : "v"(lo), "v"(hi)); return r; }
typedef float f32x2 __attribute__((ext_vector_type(2)));
typedef unsigned u32x2 __attribute__((ext_vector_type(2)));
template <int ACT> struct EpiBf16 {
    static constexpr bool PERM = true, AFTER_DRAIN = false;
    bf16_t* O; int ldc;
    __device__ __forceinline__ void operator()(const f32x4 (&acc)[2][2][4][2], const Unit& u, int wr, int wc, int fr, int fq) const {
        const int row0 = u.pm * BM + wr * 64 + fr; const int col0 = u.pn * BM + wc * 32 + 8 * fq;
#pragma unroll
        for (int ai = 0; ai < 2; ++ai)
#pragma unroll
            for (int m = 0; m < 4; ++m) { bf16_t* rowp = O + (size_t)(row0 + ai * HALF + m * 16) * ldc + col0;
#pragma unroll
                for (int bj = 0; bj < 2; ++bj) { f32x4 v0 = acc[ai][bj][m][0], v1 = acc[ai][bj][m][1];
                    if (ACT == 1) {
#pragma unroll
                        for (int j = 0; j < 4; ++j) { const float a = fmaxf(v0[j], 0.f), b = fmaxf(v1[j], 0.f); v0[j] = a * a; v1[j] = b * b; } }
                    u32x4 w; w.x = cvt_pk_bf16(v0[0], v0[1]); w.y = cvt_pk_bf16(v0[2], v0[3]); w.z = cvt_pk_bf16(v1[0], v1[1]); w.w = cvt_pk_bf16(v1[2], v1[3]);
                    *(u32x4*)(rowp + bj * HALF) = w; } }
    }
};
struct EpiResid {
    static constexpr bool PERM = false, AFTER_DRAIN = false;
    const float* base; float* out; int ldc;
    __device__ __forceinline__ void operator()(const f32x4 (&acc)[2][2][4][2], const Unit& u, int wr, int wc, int fr, int fq) const {
        const int row0 = u.pm * BM + wr * 64 + fr, col0 = u.pn * BM + wc * 32 + 4 * fq;
#pragma unroll
        for (int ai = 0; ai < 2; ++ai)
#pragma unroll
            for (int m = 0; m < 4; ++m) { const size_t off = (size_t)(row0 + ai * HALF + m * 16) * ldc + col0;
#pragma unroll
                for (int bj = 0; bj < 2; ++bj)
#pragma unroll
                    for (int n = 0; n < 2; ++n) { const f32x4 b = *(const f32x4*)(base + off + bj * HALF + n * 16); *(f32x4*)(out + off + bj * HALF + n * 16) = b + acc[ai][bj][m][n]; }
                asm volatile("" ::: "memory"); }
    }
};
struct EpiGate {
    static constexpr bool PERM = false, AFTER_DRAIN = false;
    const float* base; float* out; int ldc; const bf16_t* e0; const float* rstd; const float* g;
    __device__ __forceinline__ void operator()(const f32x4 (&acc)[2][2][4][2], const Unit& u, int wr, int wc, int fr, int fq) const {
        const int row0 = u.pm * BM + wr * 64 + fr, col0 = u.pn * BM + wc * 32 + 4 * fq;
        f32x4 gv[2][2];
#pragma unroll
        for (int bj = 0; bj < 2; ++bj)
#pragma unroll
            for (int n = 0; n < 2; ++n) gv[bj][n] = *(const f32x4*)(g + col0 + bj * HALF + n * 16);
#pragma unroll
        for (int ai = 0; ai < 2; ++ai)
#pragma unroll
            for (int m = 0; m < 4; ++m) { const int row = row0 + ai * HALF + m * 16; const size_t off = (size_t)row * ldc + col0; const float rs = rstd[row];
#pragma unroll
                for (int bj = 0; bj < 2; ++bj)
#pragma unroll
                    for (int n = 0; n < 2; ++n) { const f32x4 b = *(const f32x4*)(base + off + bj * HALF + n * 16); const u32x2 ew = *(const u32x2*)(e0 + off + bj * HALF + n * 16);
                        f32x4 e; e[0] = __uint_as_float(ew.x << 16); e[1] = __uint_as_float(ew.x & 0xffff0000u); e[2] = __uint_as_float(ew.y << 16); e[3] = __uint_as_float(ew.y & 0xffff0000u);
                        const f32x4 a = acc[ai][bj][m][n]; f32x4 s;
#pragma unroll
                        for (int j = 0; j < 4; ++j) s[j] = __builtin_amdgcn_rcpf(1.0f + __builtin_amdgcn_exp2f(a[j] * -1.4426950408889634f));
                        *(f32x4*)(out + off + bj * HALF + n * 16) = b + s * (e * rs * gv[bj][n]); }
                asm volatile("" ::: "memory"); }
    }
};
template <class Epi, class Sched, bool ALIGN_EPI = false, bool SP2 = false>
__device__ __forceinline__ void gemm_phase(PG8_LAS unsigned char* lds, const Gemm g, const Sched& S, const Epi& E, const int tid) {
    const int wid = __builtin_amdgcn_readfirstlane(tid >> 6), lane = tid & 63, wr = wid >> 2, wc = wid & 3, fr = lane & 15, fq = lane >> 4;
    const int K = g.K, nt = K / BK;
    unsigned voffA[2], voffB[2];
#pragma unroll
    for (int i = 0; i < 2; ++i) { int R, C; stage_rc(tid * 16 + i * 8192, R, C); const int Rb = Epi::PERM ? ((R & ~31) + perm32(R & 31)) : R;
        voffA[i] = (unsigned)(R * K + C) * 2u; voffB[i] = (unsigned)(Rb * K + C) * 2u; }
    const size_t kstep = (size_t)(BK * 2);
    const size_t hstep = (size_t)HALF * K * 2;
    const size_t tstep = 2 * hstep;
    const unsigned ldsw = (unsigned)wid * 1024u;
    const int aoff = lds_byte(wr * 64 + fr, fq * 8), boff = lds_byte(wc * 32 + fr, fq * 8);
#define PG8_SA(b, h) (((b) * 2 + (h)) * HTB)
#define PG8_SB(b, h) ((4 + (b) * 2 + (h)) * HTB)
#define PG8_STAGE(bufoff, gbase, voff) do { _Pragma("unroll") for (int _i = 0; _i < 2; ++_i) \
        __builtin_amdgcn_global_load_lds((const unsigned*)((const char*)(gbase) + (voff)[_i]), (PG8_LAS unsigned*)(lds + (bufoff) + ldsw + _i * 8192), 16, 0, 0); } while (0)
#define PG8_LDA(dst, b, h) do { _Pragma("unroll") for (int m = 0; m < 4; ++m) _Pragma("unroll") for (int k = 0; k < 2; ++k) dst[m][k] = *(const PG8_LAS bf16x8*)(lds + PG8_SA(b, h) + aoff + m * 2048 + k * 1024); } while (0)
#define PG8_LDB(dst, b, h) do { _Pragma("unroll") for (int n = 0; n < 2; ++n) _Pragma("unroll") for (int k = 0; k < 2; ++k) dst[n][k] = *(const PG8_LAS bf16x8*)(lds + PG8_SB(b, h) + boff + n * 2048 + k * 1024); } while (0)
#define PG8_MMA(ai, bj, At, Bt) do { __builtin_amdgcn_s_setprio(1); _Pragma("unroll") for (int m = 0; m < 4; ++m) _Pragma("unroll") for (int n = 0; n < 2; ++n) _Pragma("unroll") for (int k = 0; k < 2; ++k) \
        acc[ai][bj][m][n] = __builtin_amdgcn_mfma_f32_16x16x32_bf16(Bt[n][k], At[m][k], acc[ai][bj][m][n], 0, 0, 0); __builtin_amdgcn_s_setprio(0); } while (0)
#define PG8_WAIT_V(n) asm volatile("s_waitcnt vmcnt(" #n ")" ::: "memory")
#define PG8_WAIT_L(n) asm volatile("s_waitcnt lgkmcnt(" #n ")" ::: "memory")
#define PG8_BAR __builtin_amdgcn_s_barrier()
#define PG8_SCHED __builtin_amdgcn_sched_barrier(0)
    Unit cur, nxt; int ui = 0;
    if (!S.next(0, cur)) return;
    f32x4 acc[2][2][4][2];
#pragma unroll
    for (int a = 0; a < 2; ++a)
#pragma unroll
        for (int b = 0; b < 2; ++b)
#pragma unroll
            for (int m = 0; m < 4; ++m)
#pragma unroll
                for (int n = 0; n < 2; ++n) acc[a][b][m][n] = (f32x4){0.f, 0.f, 0.f, 0.f};
    bf16x8 At[4][2], B0[2][2], B1[2][2];
    const char* cA = (const char*)g.A + (size_t)cur.pm * tstep; const char* cB = (const char*)g.Bt + (size_t)cur.pn * tstep;
    S.a_ready(cur);
    if constexpr (SP2) {
        PG8_STAGE(PG8_SB(0, 0), cB, voffB); PG8_STAGE(PG8_SB(0, 1), cB + hstep, voffB); PG8_STAGE(PG8_SA(0, 0), cA, voffA); PG8_STAGE(PG8_SA(0, 1), cA + hstep, voffA);
        if (wr == 1) PG8_BAR;
        PG8_WAIT_V(2); PG8_BAR;
        PG8_STAGE(PG8_SB(1, 0), cB + kstep, voffB); PG8_STAGE(PG8_SA(1, 0), cA + kstep, voffA); PG8_STAGE(PG8_SB(1, 1), cB + hstep + kstep, voffB);
        PG8_WAIT_V(6); PG8_BAR;
    } else {
        PG8_STAGE(PG8_SB(0, 0), cB, voffB); PG8_STAGE(PG8_SA(0, 0), cA, voffA); PG8_STAGE(PG8_SB(0, 1), cB + hstep, voffB); PG8_STAGE(PG8_SA(0, 1), cA + hstep, voffA);
        if (wr == 1) PG8_BAR;
        PG8_WAIT_V(4); PG8_BAR;
        PG8_STAGE(PG8_SB(1, 0), cB + kstep, voffB); PG8_STAGE(PG8_SA(1, 0), cA + kstep, voffA); PG8_STAGE(PG8_SB(1, 1), cB + hstep + kstep, voffB);
        PG8_WAIT_V(6); PG8_BAR;
    }
    for (;;) {
        const bool has_next = S.next(ui + 1, nxt);
        const char* nA = has_next ? (const char*)g.A + (size_t)nxt.pm * tstep : cA; const char* nB = has_next ? (const char*)g.Bt + (size_t)nxt.pn * tstep : cB;
        for (int t = 0; t < nt; t += 2) {
            const bool last = (t == nt - 2);
            const char* a1 = cA + (size_t)(t + 1) * kstep;
            const char* a2 = last ? nA : cA + (size_t)(t + 2) * kstep; const char* b2 = last ? nB : cB + (size_t)(t + 2) * kstep;
            const char* a3 = a2 + kstep; const char* b3 = b2 + kstep;
            if (last && has_next) S.a_ready(nxt);
            if constexpr (SP2) {
            PG8_LDB(B0, 0, 0); PG8_LDB(B1, 0, 1); PG8_SCHED; PG8_LDA(At, 0, 0); PG8_STAGE(PG8_SA(1, 1), a1 + hstep, voffA);
            PG8_WAIT_V(8); PG8_WAIT_L(0); PG8_BAR; PG8_MMA(0, 0, At, B0); PG8_MMA(0, 1, At, B1); PG8_BAR; PG8_SCHED;
            PG8_LDA(At, 0, 1); PG8_STAGE(PG8_SB(0, 0), b2, voffB); PG8_STAGE(PG8_SB(0, 1), b2 + hstep, voffB); PG8_STAGE(PG8_SA(0, 0), a2, voffA);
            PG8_WAIT_V(8); PG8_WAIT_L(0); PG8_BAR; PG8_MMA(1, 0, At, B0); PG8_MMA(1, 1, At, B1); PG8_BAR; PG8_SCHED;
            PG8_LDB(B0, 1, 0); PG8_LDB(B1, 1, 1); PG8_SCHED; PG8_LDA(At, 1, 0); PG8_STAGE(PG8_SA(0, 1), a2 + hstep, voffA);
            PG8_WAIT_V(8); PG8_WAIT_L(0); PG8_BAR; PG8_MMA(0, 0, At, B0); PG8_MMA(0, 1, At, B1); PG8_BAR; PG8_SCHED;
            PG8_LDA(At, 1, 1); PG8_STAGE(PG8_SB(1, 0), b3, voffB); PG8_STAGE(PG8_SB(1, 1), b3 + hstep, voffB); PG8_STAGE(PG8_SA(1, 0), a3, voffA);
            PG8_WAIT_V(8); PG8_WAIT_L(0); PG8_BAR; PG8_MMA(1, 0, At, B0); PG8_MMA(1, 1, At, B1); PG8_BAR; PG8_SCHED;
            } else {
            PG8_LDB(B0, 0, 0); PG8_SCHED; PG8_LDA(At, 0, 0); PG8_STAGE(PG8_SA(1, 1), a1 + hstep, voffA);
            PG8_WAIT_L(8); PG8_BAR; PG8_WAIT_L(0); PG8_MMA(0, 0, At, B0); PG8_BAR; PG8_SCHED;
            PG8_LDB(B1, 0, 1); PG8_STAGE(PG8_SB(0, 0), b2, voffB);
            PG8_BAR; PG8_WAIT_L(0); PG8_MMA(0, 1, At, B1); PG8_BAR;
            PG8_LDA(At, 0, 1); PG8_STAGE(PG8_SA(0, 0), a2, voffA);
            PG8_BAR; PG8_WAIT_L(0); PG8_MMA(1, 0, At, B0); PG8_BAR; PG8_SCHED;
            PG8_STAGE(PG8_SB(0, 1), b2 + hstep, voffB);
            PG8_WAIT_V(6); PG8_BAR; PG8_MMA(1, 1, At, B1); PG8_BAR;
            PG8_LDB(B0, 1, 0); PG8_SCHED; PG8_LDA(At, 1, 0); PG8_STAGE(PG8_SA(0, 1), a2 + hstep, voffA);
            PG8_WAIT_L(8); PG8_BAR; PG8_WAIT_L(0); PG8_MMA(0, 0, At, B0); PG8_BAR; PG8_SCHED;
            PG8_LDB(B1, 1, 1); PG8_STAGE(PG8_SB(1, 0), b3, voffB);
            PG8_BAR; PG8_WAIT_L(0); PG8_MMA(0, 1, At, B1); PG8_BAR;
            PG8_LDA(At, 1, 1); PG8_STAGE(PG8_SA(1, 0), a3, voffA);
            PG8_BAR; PG8_WAIT_L(0); PG8_MMA(1, 0, At, B0); PG8_BAR; PG8_SCHED;
            PG8_STAGE(PG8_SB(1, 1), b3 + hstep, voffB);
            PG8_WAIT_V(6); PG8_BAR; PG8_MMA(1, 1, At, B1); PG8_BAR;
            }
        }
        if constexpr (ALIGN_EPI) { if (wr == 0) PG8_BAR; }
        if constexpr (!Epi::AFTER_DRAIN) { E(acc, cur, wr, wc, fr, fq); S.done(cur); }
        if (!has_next) break;
#pragma unroll
        for (int a = 0; a < 2; ++a)
#pragma unroll
            for (int b = 0; b < 2; ++b)
#pragma unroll
                for (int m = 0; m < 4; ++m)
#pragma unroll
                    for (int n = 0; n < 2; ++n) acc[a][b][m][n] = (f32x4){0.f, 0.f, 0.f, 0.f};
        cur = nxt; cA = nA; cB = nB; ++ui;
        if constexpr (ALIGN_EPI) { if (wr == 1) PG8_BAR; }
    }
    PG8_WAIT_V(0);
    if constexpr (!ALIGN_EPI) { if (wr == 0) PG8_BAR; }
    PG8_BAR;
    if constexpr (Epi::AFTER_DRAIN) { E.fused(acc, cur, wr, wc, fr, fq, lds, wid, lane); S.done(cur); }
#undef PG8_SA
#undef PG8_SB
#undef PG8_STAGE
#undef PG8_LDA
#undef PG8_LDB
#undef PG8_MMA
#undef PG8_WAIT_V
#undef PG8_WAIT_L
#undef PG8_BAR
#undef PG8_SCHED
}
}
namespace att {
typedef unsigned short bf16_t;
using bf16x8 = __attribute__((ext_vector_type(8))) short;
using s16x4  = __attribute__((ext_vector_type(4))) short;
using f32x16 = __attribute__((ext_vector_type(16))) float;
using u32x4  = __attribute__((ext_vector_type(4))) unsigned;
constexpr int QBLK = 32, KVBLK = 64, NW = 8;
constexpr float THR = 8.f;
#define ATT_SBAR() __builtin_amdgcn_sched_barrier(0)
#define ATT_SYNC() __syncthreads()
__device__ __forceinline__ int crow(int r, int hi) { return (r & 3) + 8 * (r >> 2) + 4 * hi; }
__device__ __forceinline__ unsigned cvtpk(float lo, float hi) { unsigned r; asm volatile("v_cvt_pk_bf16_f32 %0, %1, %2" : "=v"(r) : "v"(lo), "v"(hi)); return r; }
__device__ __forceinline__ bf16x8 ld8(const bf16_t* p) { return *reinterpret_cast<const bf16x8*>(p); }

template <int DQK_, int SDEPTH_, int SCALE_ID> struct Cfg {
    static constexpr int DQK = DQK_, SDEPTH = SDEPTH_, ND0 = DQK_ / 16, KPITCH = DQK_ * 2;
    static constexpr float SCALE = SCALE_ID == 0 ? 0.088388347648318440f   : 0.072168783648703220f  ;
    static constexpr int SHM_V = KVBLK * 128 * 2, SHM_K = KVBLK * DQK_ * 2;
    static constexpr int OST_PITCH = 272, OST_WAVE = 32 * OST_PITCH, OST_BYTES = NW * OST_WAVE;
    static constexpr int KV_BYTES = 2 * SHM_V + 2 * SHM_K;
    static constexpr int QX_OFF = KV_BYTES > OST_BYTES ? KV_BYTES : OST_BYTES;
    static constexpr int WS_OFF = QX_OFF + (DQK_ > 128 ? NW * 4096 : 0);
    static constexpr int LDS_BYTES = WS_OFF + NW * 64 * 4;
};

template <class CF> __device__ __forceinline__ void partialSM(f32x16& p0, f32x16& p1, float& m_reg, float& mn, float& alpha) {
  constexpr float C = CF::SCALE * 1.4426950408889634f;
  float pmax = p0[0];
#pragma unroll
  for (int r = 1; r < 16; ++r) pmax = fmaxf(pmax, p0[r]);
#pragma unroll
  for (int r = 0; r < 16; ++r) pmax = fmaxf(pmax, p1[r]);
  { auto rr = __builtin_amdgcn_permlane32_swap(__float_as_uint(pmax), __float_as_uint(pmax), false, false);
    pmax = fmaxf(__uint_as_float(rr[0]), __uint_as_float(rr[1])); }
  if (__builtin_expect(__all(pmax - m_reg <= THR / CF::SCALE), 1)) { mn = m_reg; alpha = 1.f; }
  else { mn = fmaxf(m_reg, pmax); alpha = __builtin_amdgcn_exp2f((m_reg - mn) * C); m_reg = mn; }
  float mnC = -mn * C;
#pragma unroll
  for (int r = 0; r < 16; ++r) p0[r] = fmaf(p0[r], C, mnC);
#pragma unroll
  for (int r = 0; r < 16; ++r) p1[r] = fmaf(p1[r], C, mnC);
#pragma unroll
  for (int r = 0; r < 16; ++r) p0[r] = __builtin_amdgcn_exp2f(p0[r]);
}
__device__ __forceinline__ void finishSM(f32x16& p0, f32x16& p1, float alpha, float& l_reg, bf16x8& pa0, bf16x8& pa1, bf16x8& pa2, bf16x8& pa3) {
#pragma unroll
  for (int r = 0; r < 16; ++r) p1[r] = __builtin_amdgcn_exp2f(p1[r]);
  float ps = 0;
#pragma unroll
  for (int r = 0; r < 16; ++r) ps += p0[r];
#pragma unroll
  for (int r = 0; r < 16; ++r) ps += p1[r];
  { auto rr = __builtin_amdgcn_permlane32_swap(__float_as_uint(ps), __float_as_uint(ps), false, false);
    ps = __uint_as_float(rr[0]) + __uint_as_float(rr[1]); }
  l_reg = l_reg * alpha + ps;
#define ATT_PK4(P, BASE, OUT) do { unsigned a0 = cvtpk(P[BASE + 0], P[BASE + 1]), a1 = cvtpk(P[BASE + 2], P[BASE + 3]);   \
    unsigned b0 = cvtpk(P[BASE + 4], P[BASE + 5]), b1 = cvtpk(P[BASE + 6], P[BASE + 7]);                              \
    auto r0 = __builtin_amdgcn_permlane32_swap(a0, b0, false, false); auto r1 = __builtin_amdgcn_permlane32_swap(a1, b1, false, false); \
    u32x4 w = {r0[0], r1[0], r0[1], r1[1]}; OUT = *reinterpret_cast<bf16x8*>(&w); } while (0)
  ATT_PK4(p0, 0, pa0); ATT_PK4(p0, 8, pa1); ATT_PK4(p1, 0, pa2); ATT_PK4(p1, 8, pa3);
#undef ATT_PK4
}
template <class CF> __device__ __forceinline__ void qkt(f32x16& p0, f32x16& p1, const char* Ks, const bf16x8* qr, const char* qx, int r32, int hi) {
  p0 = f32x16{}; p1 = f32x16{};
#pragma unroll
  for (int d0 = 0; d0 < CF::ND0; ++d0) { const int cb = (d0 * 16 + hi * 8) * 2;
    bf16x8 b0 = *reinterpret_cast<const bf16x8*>(Ks + (r32) * CF::KPITCH + (cb ^ ((r32 & 7) << 4)));
    bf16x8 b1 = *reinterpret_cast<const bf16x8*>(Ks + (32 + r32) * CF::KPITCH + (cb ^ ((r32 & 7) << 4)));
    bf16x8 q; if (d0 < 8) q = qr[d0]; else q = *reinterpret_cast<const bf16x8*>(qx + (d0 - 8) * 1024);
    p0 = __builtin_amdgcn_mfma_f32_32x32x16_bf16(b0, q, p0, 0, 0, 0);
    p1 = __builtin_amdgcn_mfma_f32_32x32x16_bf16(b1, q, p1, 0, 0, 0); }
}
__device__ __forceinline__ void bandmask(f32x16& p0, f32x16& p1, int kb, int qi, int hi) {
  const float ninf = -__builtin_inff();
  int dq = kb - qi + 4 * hi + 64; asm volatile("" : "+v"(dq));
#pragma unroll
  for (int r = 0; r < 16; ++r) { const int c = (r & 3) + 8 * (r >> 2); if ((unsigned)(dq + c) > 128u) p0[r] = ninf; if ((unsigned)(dq + c + 32) > 128u) p1[r] = ninf; }
}
__device__ __forceinline__ int v_st(int k, int c) { const int kk = (k & ~0xC) | ((k & 4) << 1) | ((k & 8) >> 1); return ((kk >> 3) * 4 + (c >> 5)) * 512 + ((kk & 7) * 32 + (c & 31)) * 2; }
__device__ __forceinline__ int v_rd_base(int lane) { return ((lane & 3) << 3) | (((lane >> 2) & 3) << 6) | (((lane >> 4) & 1) << 5) | (((lane >> 5) & 1) << 8); }
constexpr int v_rd_off(int d0, int ks, int half) { return d0 * 512 + ks * 4096 + half * 2048; }
template <int OFF> __device__ __forceinline__ s16x4 tr_read(int vb) {
  s16x4 r; asm volatile("ds_read_b64_tr_b16 %0, %1 offset:%2" : "=&v"(r) : "v"(vb), "i"(OFF) : "memory"); return r;
}
template <int D0> __device__ __forceinline__ void pv_one(f32x16& od, int vb, bf16x8 pa0, bf16x8 pa1, bf16x8 pa2, bf16x8 pa3) {
  const s16x4 l0 = tr_read<v_rd_off(D0, 0, 0)>(vb), h0 = tr_read<v_rd_off(D0, 0, 1)>(vb), l1 = tr_read<v_rd_off(D0, 1, 0)>(vb), h1 = tr_read<v_rd_off(D0, 1, 1)>(vb);
  const s16x4 l2 = tr_read<v_rd_off(D0, 2, 0)>(vb), h2 = tr_read<v_rd_off(D0, 2, 1)>(vb), l3 = tr_read<v_rd_off(D0, 3, 0)>(vb), h3 = tr_read<v_rd_off(D0, 3, 1)>(vb);
  asm volatile("s_waitcnt lgkmcnt(0)" ::: "memory"); ATT_SBAR();
#define ATT_PK(L, H) (bf16x8){L[0], L[1], L[2], L[3], H[0], H[1], H[2], H[3]}
  od = __builtin_amdgcn_mfma_f32_32x32x16_bf16(pa0, ATT_PK(l0, h0), od, 0, 0, 0);
  od = __builtin_amdgcn_mfma_f32_32x32x16_bf16(pa1, ATT_PK(l1, h1), od, 0, 0, 0);
  od = __builtin_amdgcn_mfma_f32_32x32x16_bf16(pa2, ATT_PK(l2, h2), od, 0, 0, 0);
  od = __builtin_amdgcn_mfma_f32_32x32x16_bf16(pa3, ATT_PK(l3, h3), od, 0, 0, 0);
#undef ATT_PK
}
__device__ __forceinline__ void pv_d0(f32x16* o, int vb, bf16x8 pa0, bf16x8 pa1, bf16x8 pa2, bf16x8 pa3) {
  pv_one<0>(o[0], vb, pa0, pa1, pa2, pa3); pv_one<1>(o[1], vb, pa0, pa1, pa2, pa3); pv_one<2>(o[2], vb, pa0, pa1, pa2, pa3); pv_one<3>(o[3], vb, pa0, pa1, pa2, pa3);
}

struct Unit {
  const bf16_t* Q;
  const bf16_t* K;
  const bf16_t* V;
  bf16_t* O;
  float* LSE;
  int ldq, ldk, ldv, ldo, ldl;
  int nt;
  int qoff;
};

template <class CF, bool MASK, bool WLSE, int LDQ_ = 0, int LDK_ = 0, int LDV_ = 0, int LDO_ = 0>
__device__ __forceinline__ void attn_unit(const Unit& a, char* lds, const int tid) {
  const int ldq = LDQ_ ? LDQ_ : a.ldq, ldk = LDK_ ? LDK_ : a.ldk, ldv = LDV_ ? LDV_ : a.ldv, ldo = LDO_ ? LDO_ : a.ldo;
  constexpr int SDEPTH = CF::SDEPTH, ND0 = CF::ND0, SHM_V = CF::SHM_V, SHM_K = CF::SHM_K;
  const int wid = tid >> 6, lane = tid & 63, r32 = lane & 31, hi = lane >> 5;
  char* V_lds = lds; char* K_lds = lds + 2 * SHM_V;
  float* ws = (float*)(lds + CF::WS_OFF) + wid * 64; float* li_l = ws; float* al_l = ws + 32;
  float m_reg = -1e30f, l_reg = 0; f32x16 o[4] = {}; bf16x8 qr[8];
  const bf16_t* Qw = a.Q + (long)(wid * QBLK + r32) * ldq + hi * 8;
#pragma unroll
  for (int d0 = 0; d0 < 8; ++d0) qr[d0] = ld8(Qw + d0 * 16);
  char* const qx = lds + CF::QX_OFF + wid * 4096 + lane * 16;
  if constexpr (ND0 > 8) {
#pragma unroll
    for (int d0 = 8; d0 < ND0; ++d0) *(bf16x8*)(qx + (d0 - 8) * 1024) = ld8(Qw + d0 * 16);
  }
  const int sr = tid >> 4, sc = (tid & 15) * 8, vst0 = v_st(sr, sc), vst1 = v_st(32 + sr, sc);
  const int kst0 = sr * CF::KPITCH + ((sc * 2) ^ ((sr & 7) << 4)), kst1 = kst0 + 32 * CF::KPITCH;
  const int kr2 = tid >> 3, kst2 = kr2 * CF::KPITCH + ((256 + (tid & 7) * 16) ^ ((kr2 & 7) << 4));
  const bf16_t* const Vg = a.V; const bf16_t* const Kg = a.K;
  const int voff0 = sr * ldv + sc, koff0 = sr * ldk + sc, koff2 = kr2 * ldk + 128 + (tid & 7) * 8;
  const int vb0 = (int)(uintptr_t)V_lds + v_rd_base(lane);
  struct { bf16x8 vs0, vs1, ks0, ks1, ks2; } sr_[SDEPTH];
#define ATT_SLOAD(i, k0) do { const bf16_t* vt_ = Vg + (long)(k0) * ldv; const bf16_t* kt_ = Kg + (long)(k0) * ldk; \
    sr_[i].vs0 = ld8(vt_ + voff0); sr_[i].vs1 = ld8(vt_ + 32 * ldv + voff0); \
    sr_[i].ks0 = ld8(kt_ + koff0); sr_[i].ks1 = ld8(kt_ + 32 * ldk + koff0); if constexpr (ND0 == 12) sr_[i].ks2 = ld8(kt_ + koff2); } while (0)
#define ATT_SWRITE(b, i) do { *(bf16x8*)(V_lds + (b) * SHM_V + vst0) = sr_[i].vs0; *(bf16x8*)(V_lds + (b) * SHM_V + vst1) = sr_[i].vs1; \
    *(bf16x8*)(K_lds + (b) * SHM_K + kst0) = sr_[i].ks0; *(bf16x8*)(K_lds + (b) * SHM_K + kst1) = sr_[i].ks1; if constexpr (ND0 == 12) *(bf16x8*)(K_lds + (b) * SHM_K + kst2) = sr_[i].ks2; } while (0)
#define ATT_SWAIT() do { if constexpr (SDEPTH == 2) { if constexpr (ND0 == 12) asm volatile("s_waitcnt vmcnt(5)" ::: "memory"); else asm volatile("s_waitcnt vmcnt(4)" ::: "memory"); } else asm volatile("s_waitcnt vmcnt(0)" ::: "memory"); } while (0)
#define ATT_RESC(al) do { if (__any((al) < 1.f)) { if (hi == 0) al_l[r32] = (al); asm volatile("s_waitcnt lgkmcnt(0)" ::: "memory"); \
    _Pragma("unroll") for (int d = 0; d < 4; ++d) _Pragma("unroll") for (int r = 0; r < 16; ++r) o[d][r] *= al_l[crow(r, hi)]; } } while (0)
  f32x16 pA0, pA1, pB0, pB1; float mnA, mnB, alA, alB; bf16x8 pa0, pa1, pa2, pa3; const int NT = a.nt;
  const int qi = a.qoff + wid * QBLK + r32;
  constexpr int SE = 0, SO = SDEPTH - 1;
  ATT_SLOAD(SE, 0); asm volatile("s_waitcnt vmcnt(0)" ::: "memory"); ATT_SWRITE(0, SE); ATT_SYNC();
  qkt<CF>(pA0, pA1, K_lds, qr, qx, r32, hi); if constexpr (MASK) bandmask(pA0, pA1, 0, qi, hi); partialSM<CF>(pA0, pA1, m_reg, mnA, alA);
  ATT_SLOAD(SO, KVBLK); if constexpr (SDEPTH == 2) { if (2 < NT) ATT_SLOAD(SE, 2 * KVBLK); }
  ATT_SWAIT(); ATT_SWRITE(1, SO); ATT_SYNC();
  for (int j = 1; j + 1 < NT; j += 2) {
    ATT_SBAR(); qkt<CF>(pB0, pB1, K_lds + SHM_K, qr, qx, r32, hi); if constexpr (MASK) bandmask(pB0, pB1, j * KVBLK, qi, hi);
    finishSM(pA0, pA1, alA, l_reg, pa0, pa1, pa2, pa3); ATT_SBAR();
    ATT_SLOAD(SO, (j + SDEPTH) * KVBLK); ATT_SBAR();
    pv_d0(o, vb0, pa0, pa1, pa2, pa3); partialSM<CF>(pB0, pB1, m_reg, mnB, alB);
    ATT_SYNC(); ATT_SWAIT(); ATT_SWRITE(0, SE);
    ATT_RESC(alB); ATT_SYNC();
    ATT_SBAR(); qkt<CF>(pA0, pA1, K_lds, qr, qx, r32, hi); if constexpr (MASK) bandmask(pA0, pA1, (j + 1) * KVBLK, qi, hi);
    finishSM(pB0, pB1, alB, l_reg, pa0, pa1, pa2, pa3); ATT_SBAR();
    if (SDEPTH == 1 || j + 3 < NT) ATT_SLOAD(SE, (j + 1 + SDEPTH) * KVBLK); ATT_SBAR();
    pv_d0(o, vb0 + SHM_V, pa0, pa1, pa2, pa3); partialSM<CF>(pA0, pA1, m_reg, mnA, alA);
    ATT_SYNC(); ATT_SWAIT(); ATT_SWRITE(1, SO);
    ATT_RESC(alA); ATT_SYNC();
  }
  ATT_SBAR(); qkt<CF>(pB0, pB1, K_lds + SHM_K, qr, qx, r32, hi); if constexpr (MASK) bandmask(pB0, pB1, (NT - 1) * KVBLK, qi, hi);
  finishSM(pA0, pA1, alA, l_reg, pa0, pa1, pa2, pa3); ATT_SBAR();
  pv_d0(o, vb0, pa0, pa1, pa2, pa3); partialSM<CF>(pB0, pB1, m_reg, mnB, alB);
  ATT_SYNC(); ATT_RESC(alB);
  finishSM(pB0, pB1, alB, l_reg, pa0, pa1, pa2, pa3); ATT_SBAR();
  pv_d0(o, vb0 + SHM_V, pa0, pa1, pa2, pa3);
  if (hi == 0) li_l[r32] = l_reg; asm volatile("s_waitcnt lgkmcnt(0)" ::: "memory");
  float rli[16];
#pragma unroll
  for (int r = 0; r < 16; ++r) rli[r] = __builtin_amdgcn_rcpf(li_l[crow(r, hi)]);
  if constexpr (WLSE) { if (hi == 0) a.LSE[(long)(wid * QBLK + r32) * a.ldl] = m_reg * CF::SCALE + __logf(l_reg); }
#ifdef ATT_EPI_DIRECT
  { bf16_t* Ow = a.O + (long)(wid * QBLK) * ldo;
#pragma unroll
  for (int r = 0; r < 16; ++r) { const int orow = crow(r, hi);
#pragma unroll
    for (int d0 = 0; d0 < 4; ++d0) Ow[(long)orow * ldo + d0 * 32 + r32] = (unsigned short)cvtpk(o[d0][r] * rli[r], 0.f); } }
  ATT_SYNC();
#else
  ATT_SYNC();
  char* Ost = lds + wid * CF::OST_WAVE;
#pragma unroll
  for (int r = 0; r < 16; ++r) { const int orow = crow(r, hi);
#pragma unroll
    for (int d0 = 0; d0 < 4; ++d0) { const float v = o[d0][r] * rli[r]; *(unsigned short*)(Ost + orow * CF::OST_PITCH + (d0 * 32 + r32) * 2) = (unsigned short)cvtpk(v, v); } }
  asm volatile("s_waitcnt lgkmcnt(0)" ::: "memory");
  bf16_t* Ow = a.O + (long)(wid * QBLK) * ldo;
#pragma unroll
  for (int i = 0; i < 8; ++i) { const int c = lane + 64 * i, row = c >> 4, ch = c & 15;
    const u32x4 v = *(const u32x4*)(Ost + row * CF::OST_PITCH + ch * 16); *(u32x4*)(Ow + (long)row * ldo + ch * 8) = v; }
  asm volatile("s_waitcnt lgkmcnt(0)" ::: "memory");
  ATT_SYNC();
#endif
#undef ATT_SLOAD
#undef ATT_SWRITE
#undef ATT_SWAIT
#undef ATT_RESC
}
}
__device__ const float RF64_HI[32] = {1.591549367e-01f, 1.193493679e-01f, 8.949939907e-02f, 6.711508334e-02f, 5.032921210e-02f, 3.774158657e-02f, 2.830219641e-02f, 2.122365311e-02f, 1.591549441e-02f, 1.193493698e-02f, 8.949940093e-03f, 6.711508147e-03f, 5.032921210e-03f, 3.774158424e-03f, 2.830219688e-03f, 2.122365171e-03f, 1.591549488e-03f, 1.193493721e-03f, 8.949940093e-04f, 6.711508031e-04f, 5.032921326e-04f, 3.774158540e-04f, 2.830219455e-04f, 2.122365258e-04f, 1.591549371e-04f, 1.193493736e-04f, 8.949940093e-05f, 6.711508468e-05f, 5.032921035e-05f, 3.774158540e-05f, 2.830219637e-05f, 2.122365186e-05f};
__device__ const float RF64_LO[32] = {6.420638243e-09f, 2.294664903e-09f, 2.542919653e-09f, -3.316028840e-10f, 5.173299289e-12f, -1.848551645e-09f, -5.826552019e-10f, -3.431038786e-10f, -1.029942243e-10f, 4.320196978e-11f, 6.802745173e-11f, 1.531042237e-10f, 5.173301024e-13f, 4.797548470e-11f, -1.048316434e-10f, 1.053879969e-10f, -5.686555046e-11f, -1.896286773e-11f, 6.802744999e-12f, 2.695195456e-11f, -1.158979943e-11f, -6.843983713e-12f, 1.279990003e-11f, 1.807650600e-12f, 5.954976963e-12f, -3.351478166e-12f, 6.802745216e-13f, -1.670379113e-12f, 1.751403167e-12f, -6.843983930e-13f, -5.389994549e-13f, 9.083608431e-13f};
__device__ const float RF32_HI[16] = {1.591549367e-01f, 7.008652389e-02f, 3.086376376e-02f, 1.359137055e-02f, 5.985185504e-03f, 2.635675948e-03f, 1.160663669e-03f, 5.111175124e-04f, 2.250790858e-04f, 9.911730740e-05f, 4.364795313e-05f, 1.922110096e-05f, 8.464330676e-06f, 3.727408512e-06f, 1.641426252e-06f, 7.228293271e-07f};
__device__ const float RF32_LO[16] = {6.420638243e-09f, -2.302696700e-09f, -3.597993847e-10f, 9.086624508e-11f, 2.087540557e-10f, -4.944578774e-11f, -2.775752544e-11f, -7.822671330e-12f, -6.755001072e-12f, 1.969154007e-12f, -3.416928741e-13f, -2.712567042e-13f, 1.318804142e-13f, 9.029300745e-14f, 1.098673646e-14f, -2.017673985e-14f};
constexpr int DM = 2048, DFF = 8192, DEPTH = 4, PLED = 256;
constexpr int NTOK = 65536, NPROMPT = 32768, SEQ_P = 4096, SEQ_S = 8192;
constexpr int CT = 32768, NCH = NTOK / CT;
constexpr float EPS = 1e-6f;
constexpr int NWAVES = 8;
enum { I_XP = 0, I_XS, I_PP, I_PS, I_NMIX, I_NMLP, I_WIN, I_WOUT, I_WPLE, I_PLEG, I_GATEG, I_WGATE,
       I_AQKV, I_AQG, I_AKG, I_AO, I_BDQ, I_BCQG, I_BCKVG, I_BUQ, I_BUKV, I_BQG, I_BKG, I_BO, I_CQKV, I_CQG, I_CKG, I_CO, N_IN };
constexpr size_t SZ_IN = (size_t)DFF * DM, SZ_OUT = (size_t)DM * DFF, SZ_PLE = (size_t)DM * PLED, SZ_GATE = (size_t)DM * DM;
constexpr size_t SZ_AQKV = (size_t)3072 * DM, SZ_AO = (size_t)DM * DM;
constexpr size_t SZ_BDQ = (size_t)1280 * DM, SZ_BUQ = (size_t)3072 * 512, SZ_BUKV = (size_t)4096 * 512, SZ_BO = (size_t)DM * DM;
constexpr size_t SZ_CQKV = (size_t)9216 * DM, SZ_CO = (size_t)DM * 1024;
constexpr size_t OFF_IN = 0, OFF_OUT = OFF_IN + 4 * SZ_IN, OFF_PLE = OFF_OUT + 4 * SZ_OUT, OFF_GATE = OFF_PLE + 4 * SZ_PLE;
constexpr size_t OFF_AQKV = OFF_GATE + 4 * SZ_GATE, OFF_AO = OFF_AQKV + 2 * SZ_AQKV;
constexpr size_t OFF_BDQ = OFF_AO + 2 * SZ_AO, OFF_BUQ = OFF_BDQ + SZ_BDQ, OFF_BUKV = OFF_BUQ + SZ_BUQ, OFF_BO = OFF_BUKV + SZ_BUKV;
constexpr size_t OFF_CQKV = OFF_BO + SZ_BO, OFF_CO = OFF_CQKV + SZ_CQKV, WT_TOTAL = OFF_CO + SZ_CO;
constexpr size_t MiB = 1u << 20;
constexpr size_t WS_CTL = 0, CTL_ZERO_BYTES = 1 * MiB;
constexpr size_t WS_T64 = 1 * MiB;
constexpr size_t WS_T32 = 3 * MiB;
constexpr size_t WS_RSTD = 4 * MiB;
constexpr size_t WS_LSE = 5 * MiB;
constexpr size_t WS_WT = 8 * MiB;
constexpr size_t WS_H = WS_WT + ((WT_TOTAL * 2 + MiB - 1) / MiB) * MiB;
constexpr size_t WS_PB = WS_H + (size_t)CT * DM * 2;
constexpr size_t WS_E0 = WS_PB + (size_t)CT * PLED * 2;
constexpr size_t WS_BIG = WS_E0 + (size_t)CT * DM * 2;
constexpr size_t CTB = (size_t)CT * 2;
constexpr size_t B_HID = 0;
constexpr size_t A_QKV = 0, A_O = A_QKV + CTB * 3072;
constexpr size_t BB_LAT = 0, BB_CQ = BB_LAT + CTB * 1280, BB_CKV = BB_CQ + CTB * 512, BB_QB = BB_CKV + CTB * 512, BB_KVB = BB_QB + CTB * 3072, BB_KF = BB_KVB + CTB * 4096, BB_END = BB_KF + CTB * 3072;
constexpr size_t BB_O = 0;
static_assert(CTB * 2048 <= BB_QB, "O overlay");
constexpr size_t C_QKV = 0, C_OG = C_QKV + CTB * 9216, C_END = C_OG + 3 * CTB * 1024;
constexpr size_t BIG_BYTES = BB_END > CTB * 8192 ? (BB_END > C_END ? BB_END : C_END) : (CTB * 8192 > C_END ? CTB * 8192 : C_END);
constexpr size_t WS_END = WS_BIG + BIG_BYTES;
constexpr int CW_BAR = 4096;
constexpr int RING_BYTES = 131072, LDSCTL_OFF = RING_BYTES, MISC_OFF = LDSCTL_OFF + 320, LDS_BYTES = 147456;

#define GAS __attribute__((address_space(1)))
#define LAS __attribute__((address_space(3)))
typedef unsigned short bf16;
typedef unsigned v4u __attribute__((ext_vector_type(4)));
typedef unsigned v2u __attribute__((ext_vector_type(2)));
typedef float f32x4 __attribute__((ext_vector_type(4)));
typedef float f32x2 __attribute__((ext_vector_type(2)));
#define LDS_WAIT() asm volatile("s_waitcnt lgkmcnt(0)" ::: "memory")
#define VM_WAIT() asm volatile("s_waitcnt vmcnt(0)" ::: "memory")
__device__ __forceinline__ unsigned pk2(float lo, float hi) { unsigned r; asm volatile("v_cvt_pk_bf16_f32 %0, %1, %2" : "=v"(r) : "v"(lo), "v"(hi)); return r; }
__device__ __forceinline__ float bflo(unsigned w) { return __uint_as_float(w << 16); }
__device__ __forceinline__ float bfhi(unsigned w) { return __uint_as_float(w & 0xffff0000u); }

#define XB_TMO      128
#define XB_XCNT(j)  (256  + 64 * (j))
#define XB_XSUB(j)  (1280 + 64 * (j))
#define XB_XGEN(j)  (2304 + 64 * (j))
#define XB_TOP      3328
#define XB_TOPGEN   3392
#define XCD_BAR_WORDS 3456
#define XB_SPIN_CAP (1u << 18)
__device__ __forceinline__ unsigned xb_ld(unsigned* p)              { return __hip_atomic_load(p, __ATOMIC_RELAXED, __HIP_MEMORY_SCOPE_AGENT); }
__device__ __forceinline__ unsigned xb_add(unsigned* p, unsigned v) { return __hip_atomic_fetch_add(p, v, __ATOMIC_RELAXED, __HIP_MEMORY_SCOPE_AGENT); }
__device__ __forceinline__ unsigned xb_xcc_id() { return (unsigned)__builtin_amdgcn_s_getreg((3 << 11) | 20) & 0xFu; }
#define XB_SPIN(cond, bar) do { unsigned _sp = 0; while (cond) { __builtin_amdgcn_s_sleep(1); \
    if ((++_sp & 255u) == 0u) { if (xb_ld(&(bar)[XB_TMO])) break; if (_sp > XB_SPIN_CAP) { atomicAdd(&(bar)[XB_TMO], 1u); break; } } } } while (0)
struct XcdBarrier { unsigned* bar; unsigned x; volatile LAS unsigned* st; };
__device__ __forceinline__ XcdBarrier xcd_barrier_post(unsigned* bar, volatile LAS unsigned* st) {
    XcdBarrier b; b.bar = bar; b.x = xb_xcc_id(); b.st = st;
    if (threadIdx.x == 0) (void)xb_add(&bar[XB_XCNT(b.x)], 1u);
    return b;
}
__device__ __forceinline__ void xcd_barrier_complete(unsigned* bar, unsigned x, unsigned& nloc, unsigned& nx) {
    const unsigned G = gridDim.x * gridDim.y * gridDim.z;
    unsigned sum, cnt, mine, sp = 0u;
    for (;;) {
        sum = 0u; cnt = 0u; mine = 0u;
#pragma unroll
        for (unsigned j = 0; j < 16; ++j) { const unsigned c = xb_ld(&bar[XB_XCNT(j)]); sum += c; cnt += (c > 0u) ? 1u : 0u; mine = (j == x) ? c : mine; }
        if (sum == G) break;
        __builtin_amdgcn_s_sleep(1);
        if ((++sp & 255u) == 0u) { if (xb_ld(&bar[XB_TMO])) break; if (sp > XB_SPIN_CAP) { atomicAdd(&bar[XB_TMO], 1u); break; } }
    }
    nloc = mine > 0u ? mine : 1u; nx = cnt > 0u ? cnt : 1u;
}
__device__ __forceinline__ void xcd_barrier(const XcdBarrier& b) {
    asm volatile("s_waitcnt vmcnt(0)" ::: "memory");
    __syncthreads();
    if (threadIdx.x == 0) {
        unsigned* bar = b.bar; asm volatile("" : "+s"(bar));
        __builtin_amdgcn_s_waitcnt(0);
        unsigned bx_ = xb_xcc_id(); asm volatile("" : "+s"(bx_));
        unsigned nloc = b.st[0], nx = b.st[1];
        if (nloc == 0u) { xcd_barrier_complete(bar, bx_, nloc, nx); b.st[0] = nloc; b.st[1] = nx; }
        const unsigned old = xb_add(&bar[XB_XSUB(bx_)], 1u);
        const unsigned gen = old / nloc;
        if (old + 1u == (gen + 1u) * nloc) {
            __builtin_amdgcn_fence(__ATOMIC_RELEASE, "agent");
            asm volatile("s_waitcnt vmcnt(0)" ::: "memory");
            const unsigned og = xb_add(&bar[XB_TOP], 1u);
            const unsigned tg = og / nx;
            if (og + 1u == (tg + 1u) * nx) xb_add(&bar[XB_TOPGEN], 1u);
            else XB_SPIN(xb_ld(&bar[XB_TOPGEN]) == tg, bar);
            __builtin_amdgcn_fence(__ATOMIC_ACQUIRE, "agent");
            xb_add(&bar[XB_XGEN(bx_)], 1u);
            asm volatile("s_waitcnt vmcnt(0)" ::: "memory");
        } else {
            XB_SPIN(xb_ld(&bar[XB_XGEN(bx_)]) == gen, bar);
            __builtin_amdgcn_fence(__ATOMIC_ACQUIRE, "agent");
            asm volatile("s_waitcnt vmcnt(0)" ::: "memory");
        }
    }
    __syncthreads();
}

__device__ __forceinline__ float shx(float v, int lane, int o) { return __int_as_float(__builtin_amdgcn_ds_bpermute((lane ^ o) << 2, __float_as_int(v))); }
__device__ __forceinline__ float wave_sum(float v, int lane) {
#pragma unroll
    for (int o = 1; o < 64; o <<= 1) v += shx(v, lane, o);
    return v;
}
__device__ __forceinline__ float sum16(float v, int lane) {
#pragma unroll
    for (int o = 1; o < 16; o <<= 1) v += shx(v, lane, o);
    return v;
}
__device__ __forceinline__ void unpack8(const v4u w, float (&f)[8]) { f[0] = bflo(w.x); f[1] = bfhi(w.x); f[2] = bflo(w.y); f[3] = bfhi(w.y); f[4] = bflo(w.z); f[5] = bfhi(w.z); f[6] = bflo(w.w); f[7] = bfhi(w.w); }
__device__ __forceinline__ v4u pack8(const float (&f)[8]) { v4u w; w.x = pk2(f[0], f[1]); w.y = pk2(f[2], f[3]); w.z = pk2(f[4], f[5]); w.w = pk2(f[6], f[7]); return w; }

__device__ __forceinline__ void p0_transpose_item(const float* W, int K, int N, bf16* WT, LAS float* scr, int item, int lane) {
    const int nblk = N / 32, kb = item / nblk, nb = item % nblk, k0 = 64 * kb, n0 = 32 * nb;
#pragma unroll 8
    for (int i = 0; i < 32; ++i) { const int kk = 2 * i + (lane >> 5); scr[kk * 33 + (lane & 31)] = W[(size_t)(k0 + kk) * N + n0 + (lane & 31)]; }
    LDS_WAIT(); asm volatile("" ::: "memory");
    const int c = lane & 7;
#pragma unroll
    for (int j = 0; j < 4; ++j) { const int n = (lane >> 3) + 8 * j; const LAS float* s = scr + (8 * c) * 33 + n;
        v4u o; o.x = pk2(s[0 * 33], s[1 * 33]); o.y = pk2(s[2 * 33], s[3 * 33]); o.z = pk2(s[4 * 33], s[5 * 33]); o.w = pk2(s[6 * 33], s[7 * 33]);
        *(GAS v4u*)(WT + (size_t)(n0 + n) * K + k0 + 8 * c) = o; }
    LDS_WAIT(); asm volatile("" ::: "memory");
}

__device__ __forceinline__ void norm_rows(const float* __restrict__ src, float* __restrict__ cpy, bf16* __restrict__ H, const float* __restrict__ g,
                                          const bf16* __restrict__ e0, float* __restrict__ rs_out, int nrows, int gw, int NGW, int lane) {
    f32x4 gv[8];
#pragma unroll
    for (int j = 0; j < 8; ++j) gv[j] = ((const f32x4*)g)[lane + 64 * j];
    for (int m = gw; m < nrows; m += NGW) {
        const f32x4* xr = (const f32x4*)(src + (size_t)m * DM) + lane;
        f32x4 v[8]; float s = 0.f;
#pragma unroll
        for (int j = 0; j < 8; ++j) { v[j] = xr[64 * j]; s += (v[j].x * v[j].x + v[j].y * v[j].y) + (v[j].z * v[j].z + v[j].w * v[j].w); }
        if (cpy) { f32x4* cr = (f32x4*)(cpy + (size_t)m * DM) + lane;
#pragma unroll
            for (int j = 0; j < 8; ++j) cr[64 * j] = v[j]; }
        const float rstd = __builtin_amdgcn_rsqf(wave_sum(s, lane) * (1.f / DM) + EPS);
        v2u* o8 = (v2u*)(H + (size_t)m * DM) + lane;
#pragma unroll
        for (int j = 0; j < 8; ++j) { const f32x4 y = v[j] * rstd * gv[j]; v2u w; w.x = pk2(y.x, y.y); w.y = pk2(y.z, y.w); o8[64 * j] = w; }
        if (e0) {
            const v4u* er = (const v4u*)(e0 + (size_t)m * DM) + lane; float q = 0.f;
#pragma unroll
            for (int j = 0; j < 4; ++j) { float f[8]; unpack8(er[64 * j], f);
#pragma unroll
                for (int t = 0; t < 8; ++t) q += f[t] * f[t]; }
            q = wave_sum(q, lane);
            if (lane == 0) rs_out[m] = __builtin_amdgcn_rsqf(q * (1.f / DM) + EPS);
        }
    }
}

__device__ __forceinline__ void a_qknorm_rope(bf16* __restrict__ qkv, const float* __restrict__ qg, const float* __restrict__ kg, const f32x2* __restrict__ T64, int seqmask, int gw, int NGW, int lane) {
    const int q16 = lane & 15, sub = lane >> 4;
    for (int it = gw; it < CT * 5; it += NGW) {
        const int tl = it / 5, quad = it % 5, hv = quad * 4 + sub;
        bf16* p = qkv + (size_t)tl * 3072 + (hv < 16 ? hv * 128 : 2048 + (hv - 16) * 128) + q16 * 8;
        const float* g = (hv < 16 ? qg : kg) + q16 * 8;
        float f[8]; unpack8(*(const v4u*)p, f);
        float s = 0.f;
#pragma unroll
        for (int t = 0; t < 8; ++t) s += f[t] * f[t];
        const float rstd = __builtin_amdgcn_rsqf(sum16(s, lane) * (1.f / 128.f) + EPS);
        const f32x4 g0 = *(const f32x4*)g, g1 = *(const f32x4*)(g + 4);
        float y[8];
#pragma unroll
        for (int t = 0; t < 4; ++t) { y[t] = f[t] * rstd * g0[t]; y[4 + t] = f[4 + t] * rstd * g1[t]; }
        const int t = tl & seqmask, pos = (q16 < 8) ? (t >> 6) : (t & 63);
        const f32x2* cs = T64 + (size_t)pos * 32 + (q16 & 3) * 8;
        const bool first = (q16 & 4) == 0;
        float o[8];
#pragma unroll
        for (int e = 0; e < 8; ++e) { const float other = shx(y[e], lane, 4); const f32x2 c = cs[e];
            o[e] = first ? (y[e] * c.x - other * c.y) : (y[e] * c.x + other * c.y); }
        *(v4u*)p = pack8(o);
    }
}
__device__ __forceinline__ void b_latnorm(const bf16* __restrict__ lat, bf16* __restrict__ cq, bf16* __restrict__ ckv, const float* __restrict__ cqg, const float* __restrict__ ckvg, int gw, int NGW, int lane) {
    for (int it = gw; it < CT * 2; it += NGW) {
        const int tl = it >> 1, which = it & 1;
        float f[8]; unpack8(*(const v4u*)(lat + (size_t)tl * 1280 + which * 512 + lane * 8), f);
        float s = 0.f;
#pragma unroll
        for (int t = 0; t < 8; ++t) s += f[t] * f[t];
        const float rstd = __builtin_amdgcn_rsqf(wave_sum(s, lane) * (1.f / 512.f) + EPS);
        const float* g = (which ? ckvg : cqg) + lane * 8; const f32x4 g0 = *(const f32x4*)g, g1 = *(const f32x4*)(g + 4);
        float y[8];
#pragma unroll
        for (int t = 0; t < 4; ++t) { y[t] = f[t] * rstd * g0[t]; y[4 + t] = f[4 + t] * rstd * g1[t]; }
        *(v4u*)((which ? ckv : cq) + (size_t)tl * 512 + lane * 8) = pack8(y);
    }
}
__device__ __forceinline__ void b_qknorm_rope(bf16* __restrict__ qb, const bf16* __restrict__ kvb, const bf16* __restrict__ lat, bf16* __restrict__ kf, const float* __restrict__ qg, const float* __restrict__ kg,
                                              const f32x2* __restrict__ T64, int seqmask, int gw, int NGW, int lane) {
    const int q16 = lane & 15, sub = lane >> 4;
    for (int it = gw; it < CT * 8; it += NGW) {
        const int tl = it >> 3, isk = (it >> 2) & 1, h = (it & 3) * 4 + sub;
        const bf16* pn = isk ? (kvb + (size_t)tl * 4096 + h * 256 + q16 * 8) : (qb + (size_t)tl * 3072 + h * 192 + q16 * 8);
        const bf16* pr = isk ? (lat + (size_t)tl * 1280 + 1024 + q16 * 4) : (qb + (size_t)tl * 3072 + h * 192 + 128 + q16 * 4);
        bf16* on = (isk ? kf : qb) + (size_t)tl * 3072 + h * 192 + q16 * 8; bf16* orp = (isk ? kf : qb) + (size_t)tl * 3072 + h * 192 + 128 + q16 * 4;
        const float* g = isk ? kg : qg;
        float f[8]; unpack8(*(const v4u*)pn, f); const v2u rw = *(const v2u*)pr; float r[4] = {bflo(rw.x), bfhi(rw.x), bflo(rw.y), bfhi(rw.y)};
        float s = 0.f;
#pragma unroll
        for (int t = 0; t < 8; ++t) s += f[t] * f[t];
#pragma unroll
        for (int t = 0; t < 4; ++t) s += r[t] * r[t];
        const float rstd = __builtin_amdgcn_rsqf(sum16(s, lane) * (1.f / 192.f) + EPS);
        const f32x4 g0 = *(const f32x4*)(g + q16 * 8), g1 = *(const f32x4*)(g + q16 * 8 + 4), g2 = *(const f32x4*)(g + 128 + q16 * 4);
        float y[8], yr[4];
#pragma unroll
        for (int t = 0; t < 4; ++t) { y[t] = f[t] * rstd * g0[t]; y[4 + t] = f[4 + t] * rstd * g1[t]; yr[t] = r[t] * rstd * g2[t]; }
        const int pos = tl & seqmask;
        const f32x2* cs = T64 + (size_t)pos * 32 + (q16 & 7) * 4;
        const bool first = (q16 & 8) == 0;
        float o[4];
#pragma unroll
        for (int e = 0; e < 4; ++e) { const float other = shx(yr[e], lane, 8); const f32x2 c = cs[e];
            o[e] = first ? (yr[e] * c.x - other * c.y) : (yr[e] * c.x + other * c.y); }
        *(v4u*)on = pack8(y); v2u ow; ow.x = pk2(o[0], o[1]); ow.y = pk2(o[2], o[3]); *(v2u*)orp = ow;
    }
}
__device__ __forceinline__ void c_qknorm_rope(bf16* __restrict__ qkv, const float* __restrict__ qg, const float* __restrict__ kg, const f32x2* __restrict__ T32, int seqmask, int gw, int NGW, int lane) {
    const int q16 = lane & 15, sub = lane >> 4;
    for (int it = gw; it < CT * 12; it += NGW) {
        const int tl = it / 12, quad = it % 12, hv = quad * 4 + sub;
        bf16* p = qkv + (size_t)tl * 9216 + hv * 128 + q16 * 8;
        const float* g = (hv < 24 ? qg : kg) + q16 * 8;
        float f[8]; unpack8(*(const v4u*)p, f);
        float s = 0.f;
#pragma unroll
        for (int t = 0; t < 8; ++t) s += f[t] * f[t];
        const float rstd = __builtin_amdgcn_rsqf(sum16(s, lane) * (1.f / 128.f) + EPS);
        const f32x4 g0 = *(const f32x4*)g, g1 = *(const f32x4*)(g + 4);
        float y[8];
#pragma unroll
        for (int t = 0; t < 4; ++t) { y[t] = f[t] * rstd * g0[t]; y[4 + t] = f[4 + t] * rstd * g1[t]; }
        const int pos = tl & seqmask;
        const f32x2* cs = T32 + (size_t)pos * 16 + (q16 & 1) * 8;
        const bool first = (q16 & 2) == 0, roped = q16 < 4;
        float o[8];
#pragma unroll
        for (int e = 0; e < 8; ++e) { const float other = shx(y[e], lane, 2); const f32x2 c = cs[e];
            const float rv = first ? (y[e] * c.x - other * c.y) : (y[e] * c.x + other * c.y); o[e] = roped ? rv : y[e]; }
        *(v4u*)p = pack8(o);
    }
}
__device__ __forceinline__ void c_merge(const bf16* __restrict__ og, const float* __restrict__ lse, bf16* __restrict__ mrg, int gw, int NGW, int lane) {
    const int q16 = lane & 15, sub = lane >> 4;
    for (int it = gw; it < CT * 2; it += NGW) {
        const int tl = it >> 1, h = (it & 1) * 4 + sub;
        const float l0 = lse[(size_t)tl * 8 + h], l1 = lse[(size_t)CT * 8 + (size_t)tl * 8 + h], l2 = lse[(size_t)2 * CT * 8 + (size_t)tl * 8 + h];
        const float mx = fmaxf(l0, fmaxf(l1, l2));
        float w0 = __expf(l0 - mx), w1 = __expf(l1 - mx), w2 = __expf(l2 - mx); const float inv = 1.f / (w0 + w1 + w2); w0 *= inv; w1 *= inv; w2 *= inv;
        const size_t off = (size_t)tl * 1024 + h * 128 + q16 * 8;
        float a[8], b[8], c[8], o[8]; unpack8(*(const v4u*)(og + off), a); unpack8(*(const v4u*)(og + (size_t)CT * 1024 + off), b); unpack8(*(const v4u*)(og + (size_t)2 * CT * 1024 + off), c);
#pragma unroll
        for (int e = 0; e < 8; ++e) o[e] = w0 * a[e] + w1 * b[e] + w2 * c[e];
        *(v4u*)(mrg + off) = pack8(o);
    }
}
#ifndef ONLY
#define ONLY -1
#endif
#define PH(k) (ONLY < 0 || ONLY == (k))
struct Args { const float* in[N_IN]; float* out; unsigned char* ws; };
typedef att::Cfg<128, 2, 0> CfgA;
typedef att::Cfg<192, 1, 1> CfgB;
typedef att::Cfg<128, 2, 0> CfgC;
static_assert(CfgA::LDS_BYTES <= RING_BYTES && CfgB::LDS_BYTES <= RING_BYTES, "attention LDS");

__device__ __forceinline__ void weight_desc(const Args& a, bf16* WT, int mi, const float*& src, int& K, int& N, bf16*& dst) {
    if (mi < 16) { const int l = mi >> 2, t = mi & 3;
        if (t == 0)      { src = a.in[I_WIN] + (size_t)l * SZ_IN;    K = DM;   N = DFF; dst = WT + OFF_IN + (size_t)l * SZ_IN; }
        else if (t == 1) { src = a.in[I_WOUT] + (size_t)l * SZ_OUT;  K = DFF;  N = DM;  dst = WT + OFF_OUT + (size_t)l * SZ_OUT; }
        else if (t == 2) { src = a.in[I_WPLE] + (size_t)l * SZ_PLE;  K = PLED; N = DM;  dst = WT + OFF_PLE + (size_t)l * SZ_PLE; }
        else             { src = a.in[I_WGATE] + (size_t)l * SZ_GATE; K = DM;  N = DM;  dst = WT + OFF_GATE + (size_t)l * SZ_GATE; }
    } else if (mi < 20) { const int j = (mi - 16) >> 1, t = mi & 1;
        if (t == 0) { src = a.in[I_AQKV] + (size_t)j * SZ_AQKV; K = DM; N = 3072; dst = WT + OFF_AQKV + (size_t)j * SZ_AQKV; }
        else        { src = a.in[I_AO] + (size_t)j * SZ_AO;     K = DM; N = DM;   dst = WT + OFF_AO + (size_t)j * SZ_AO; }
    } else if (mi == 20) { src = a.in[I_BDQ];  K = DM;   N = 1088; dst = WT + OFF_BDQ; }
    else if (mi == 21)   { src = a.in[I_BUQ];  K = 512;  N = 3072; dst = WT + OFF_BUQ; }
    else if (mi == 22)   { src = a.in[I_BUKV]; K = 512;  N = 4096; dst = WT + OFF_BUKV; }
    else if (mi == 23)   { src = a.in[I_BO];   K = DM;   N = DM;   dst = WT + OFF_BO; }
    else if (mi == 24)   { src = a.in[I_CQKV]; K = DM;   N = 9216; dst = WT + OFF_CQKV; }
    else                 { src = a.in[I_CO];   K = 1024; N = DM;   dst = WT + OFF_CO; }
}
__device__ __forceinline__ void rope_entry(float pos, float fh, float fl, f32x2* out) {
    const float hi = pos * fh, err = fmaf(pos, fh, -hi);
    const float fr = (hi - rintf(hi)) + (err + pos * fl);
    f32x2 r; r.x = __builtin_amdgcn_cosf(fr); r.y = __builtin_amdgcn_sinf(fr); *out = r;
}

#define PHASE_VARS() int tid = threadIdx.x; int zi = 0; asm volatile("" : "+v"(tid), "+s"(zi)); \
    const int lane = tid & 63, wave = __builtin_amdgcn_readfirstlane(tid >> 6); \
    const int G = (int)gridDim.x + zi, bx = (int)blockIdx.x + zi; const bool g8 = (G % 8) == 0; \
    const int x8 = g8 ? bx % 8 : 0, r8 = g8 ? bx / 8 : bx, G8 = g8 ? G / 8 : G; const int vcu = g8 ? x8 * G8 + r8 : bx; \
    const int gw = vcu * NWAVES + wave, NGW = G * NWAVES; unsigned char* const ws = args.ws + zi; \
    (void)lane; (void)gw; (void)NGW; (void)x8; (void)r8; (void)G8; (void)ws
#define INP(i) (args.in[(i) + zi])
#define GEMM_PHASE(EPI, Aptr, Wptr, Mv, Nv, Kv, ...) do { pg8::Gemm g_{(Aptr), (Wptr), (Mv), (Nv), (Kv)}; pg8::StaticOrder S_; S_.init((Mv), (Nv), G, bx); \
    EPI E_{__VA_ARGS__}; pg8::gemm_phase<EPI, pg8::StaticOrder, true, true>(lds, g_, S_, E_, tid); } while (0)

__global__ void __launch_bounds__(NWAVES * 64, 2) mk_fwd(Args args) {
    extern __shared__ __attribute__((aligned(16))) unsigned char lds_raw[];
    LAS unsigned char* const lds = (LAS unsigned char*)lds_raw;
    volatile LAS unsigned* MISC = (volatile LAS unsigned*)(lds + MISC_OFF);
    for (int u = threadIdx.x; u < (LDS_BYTES - LDSCTL_OFF) / 4; u += NWAVES * 64) ((LAS unsigned*)(lds + LDSCTL_OFF))[u] = 0u;
    __syncthreads();
    XcdBarrier bar = xcd_barrier_post((unsigned*)(args.ws + WS_CTL) + CW_BAR, MISC + 8);
#define GRID_BAR() xcd_barrier(bar)

    {
        PHASE_VARS();
        bf16* const WT = (bf16*)(ws + WS_WT); f32x2* const T64 = (f32x2*)(ws + WS_T64); f32x2* const T32 = (f32x2*)(ws + WS_T32);
        LAS float* scr = (LAS float*)(lds + wave * 16384);
        for (int mi = 0; mi < 26; ++mi) {
            const float* src; int K, N; bf16* dst; weight_desc(args, WT, mi, src, K, N, dst);
            const int items = (K / 64) * (N / 32);
            for (int it = gw; it < items; it += NGW) p0_transpose_item(src, K, N, dst, scr, it, lane);
        }
        { v4u* z = (v4u*)(WT + OFF_BDQ + (size_t)1088 * DM); const int n16 = 192 * DM * 2 / 16; const v4u zero = {0u, 0u, 0u, 0u};
          for (int i = vcu * 512 + tid; i < n16; i += G * 512) z[i] = zero; }
        for (int i = vcu * 512 + tid; i < 8192 * 32; i += G * 512) { const int pos = i >> 5, j = i & 31; rope_entry((float)pos, RF64_HI[j], RF64_LO[j], T64 + i); }
        for (int i = vcu * 512 + tid; i < 8192 * 16; i += G * 512) { const int pos = i >> 4, j = i & 15; rope_entry((float)pos, RF32_HI[j], RF32_LO[j], T32 + i); }
    }
    GRID_BAR();

    for (int layer_ = 0; layer_ < DEPTH; ++layer_) {
        for (int c_ = 0; c_ < NCH; ++c_) {
#define CHUNK_VARS() const int layer = layer_ + zi, c = c_ + zi; const int lj = layer / 3; const size_t tok0 = (size_t)c * CT; const bool prompt = tok0 < (size_t)NPROMPT; \
    const int SEQ = prompt ? SEQ_P : SEQ_S, NQB = SEQ / 256; float* const X = args.out + tok0 * DM + zi; bf16* const WT = (bf16*)(ws + WS_WT); bf16* const Hb = (bf16*)(ws + WS_H); \
    unsigned char* const BIG = ws + WS_BIG; (void)lj; (void)SEQ; (void)NQB; (void)X; (void)WT; (void)Hb; (void)BIG; (void)prompt
            {
                PHASE_VARS(); CHUNK_VARS();
                const float* src = X; float* cpy = nullptr;
                if (layer == 0) { src = prompt ? INP(I_XP) + tok0 * DM : INP(I_XS) + (tok0 - NPROMPT) * DM; cpy = X; }
                norm_rows(src, cpy, Hb, INP(I_NMIX) + layer * DM, nullptr, nullptr, CT, gw, NGW, lane);
            }
            GRID_BAR();
            const int kind = layer_ % 3;
            if (kind == 0) {
                { PHASE_VARS(); CHUNK_VARS(); GEMM_PHASE(pg8::EpiBf16<0>, Hb, WT + OFF_AQKV + (size_t)lj * SZ_AQKV, CT, 3072, DM, (bf16*)(BIG + A_QKV), 3072); }
                GRID_BAR();
                { PHASE_VARS(); CHUNK_VARS(); a_qknorm_rope((bf16*)(BIG + A_QKV), INP(I_AQG) + lj * 128, INP(I_AKG) + lj * 128, (const f32x2*)(ws + WS_T64), SEQ - 1, gw, NGW, lane); }
                GRID_BAR();
                { const int nu = ((CT / 256) * 16 + (int)gridDim.x - 1) / (int)gridDim.x;
                  for (int i = 0; i < nu; ++i) { PHASE_VARS(); CHUNK_VARS(); bf16* const QKV = (bf16*)(BIG + A_QKV); bf16* const OB = (bf16*)(BIG + A_O);
                      const int U8 = g8 ? (CT / 256) * 16 / 8 : (CT / 256) * 16, UPG = 4 * NQB; if (r8 + G8 * i >= U8) break;
                      const int u = x8 * U8 + r8 + G8 * i, grp = u / UPG, w = u % UPG, s = grp >> 2, kvh = grp & 3, h = kvh * 4 + w / NQB, qb = w % NQB;
                      const size_t t0 = (size_t)s * SEQ, tq = t0 + (size_t)qb * 256;
                      att::Unit un; un.Q = QKV + tq * 3072 + h * 128; un.K = QKV + t0 * 3072 + 2048 + kvh * 128; un.V = un.K + 512; un.O = OB + tq * DM + h * 128; un.LSE = nullptr;
                      un.ldq = 3072; un.ldk = 3072; un.ldv = 3072; un.ldo = DM; un.ldl = 0; un.nt = SEQ / 64; un.qoff = 0;
                      att::attn_unit<CfgA, false, false, 3072, 3072, 3072, DM>(un, (char*)lds_raw, tid); } }
                GRID_BAR();
                { PHASE_VARS(); CHUNK_VARS(); GEMM_PHASE(pg8::EpiResid, (bf16*)(BIG + A_O), WT + OFF_AO + (size_t)lj * SZ_AO, CT, DM, DM, X, X, DM); }
                GRID_BAR();
            } else if (kind == 1) {
                { PHASE_VARS(); CHUNK_VARS(); GEMM_PHASE(pg8::EpiBf16<0>, Hb, WT + OFF_BDQ, CT, 1280, DM, (bf16*)(BIG + BB_LAT), 1280); }
                GRID_BAR();
                { PHASE_VARS(); CHUNK_VARS(); b_latnorm((bf16*)(BIG + BB_LAT), (bf16*)(BIG + BB_CQ), (bf16*)(BIG + BB_CKV), INP(I_BCQG), INP(I_BCKVG), gw, NGW, lane); }
                GRID_BAR();
                { PHASE_VARS(); CHUNK_VARS(); GEMM_PHASE(pg8::EpiBf16<0>, (bf16*)(BIG + BB_CQ), WT + OFF_BUQ, CT, 3072, 512, (bf16*)(BIG + BB_QB), 3072); }
                { PHASE_VARS(); CHUNK_VARS(); GEMM_PHASE(pg8::EpiBf16<0>, (bf16*)(BIG + BB_CKV), WT + OFF_BUKV, CT, 4096, 512, (bf16*)(BIG + BB_KVB), 4096); }
                GRID_BAR();
                { PHASE_VARS(); CHUNK_VARS(); b_qknorm_rope((bf16*)(BIG + BB_QB), (bf16*)(BIG + BB_KVB), (bf16*)(BIG + BB_LAT), (bf16*)(BIG + BB_KF), INP(I_BQG), INP(I_BKG), (const f32x2*)(ws + WS_T64), SEQ - 1, gw, NGW, lane); }
                GRID_BAR();
                { const int nu = ((CT / 256) * 16 + (int)gridDim.x - 1) / (int)gridDim.x;
                  for (int i = 0; i < nu; ++i) { PHASE_VARS(); CHUNK_VARS(); bf16* const QB = (bf16*)(BIG + BB_QB); bf16* const KVB = (bf16*)(BIG + BB_KVB); bf16* const KF = (bf16*)(BIG + BB_KF); bf16* const OB = (bf16*)(BIG + BB_O);
                      const int U8 = g8 ? (CT / 256) * 16 / 8 : (CT / 256) * 16; if (r8 + G8 * i >= U8) break;
                      const int u = x8 * U8 + r8 + G8 * i, grp = u / NQB, qb = u % NQB, s = grp >> 4, h = grp & 15;
                      const size_t t0 = (size_t)s * SEQ, tq = t0 + (size_t)qb * 256;
                      att::Unit un; un.Q = QB + tq * 3072 + h * 192; un.K = KF + t0 * 3072 + h * 192; un.V = KVB + t0 * 4096 + h * 256 + 128; un.O = OB + tq * DM + h * 128; un.LSE = nullptr;
                      un.ldq = 3072; un.ldk = 3072; un.ldv = 4096; un.ldo = DM; un.ldl = 0; un.nt = SEQ / 64; un.qoff = 0;
                      att::attn_unit<CfgB, false, false, 3072, 3072, 4096, DM>(un, (char*)lds_raw, tid); } }
                GRID_BAR();
                { PHASE_VARS(); CHUNK_VARS(); GEMM_PHASE(pg8::EpiResid, (bf16*)(BIG + BB_O), WT + OFF_BO, CT, DM, DM, X, X, DM); }
                GRID_BAR();
            } else {
                { PHASE_VARS(); CHUNK_VARS(); GEMM_PHASE(pg8::EpiBf16<0>, Hb, WT + OFF_CQKV, CT, 9216, DM, (bf16*)(BIG + C_QKV), 9216); }
                GRID_BAR();
                { PHASE_VARS(); CHUNK_VARS(); c_qknorm_rope((bf16*)(BIG + C_QKV), INP(I_CQG), INP(I_CKG), (const f32x2*)(ws + WS_T32), SEQ - 1, gw, NGW, lane); }
                GRID_BAR();
                { const int nu = ((CT / 256) * 24 + (int)gridDim.x - 1) / (int)gridDim.x;
                  for (int i = 0; i < nu; ++i) { PHASE_VARS(); CHUNK_VARS(); bf16* const QKV = (bf16*)(BIG + C_QKV); bf16* const OG = (bf16*)(BIG + C_OG); float* const LSE = (float*)(ws + WS_LSE);
                      const int U8 = g8 ? (CT / 256) * 24 / 8 : (CT / 256) * 24; if (r8 + G8 * i >= U8) break;
                      const int u = x8 * U8 + r8 + G8 * i, grp = u / NQB, blk = u % NQB, s = grp / 24, gh = grp % 24, gi = gh >> 3, h = gh & 7;
                      const int dsh = 2 * gi, d = 1 << dsh, L = SEQ >> dsh, NB = L / 256, res = blk / NB, l0 = (blk % NB) * 256;
                      const int nt = L / 64 < 6 ? L / 64 : 6; int kw0 = l0 - 64; if (kw0 < 0) kw0 = 0; if (kw0 > L - 64 * nt) kw0 = L - 64 * nt;
                      const size_t t0 = (size_t)s * SEQ + res, tq = t0 + (size_t)d * l0, tk = t0 + (size_t)d * kw0;
                      att::Unit un; un.Q = QKV + tq * 9216 + gh * 128; un.K = QKV + tk * 9216 + 3072 + gh * 128; un.V = un.K + 3072; un.O = OG + (size_t)gi * CT * 1024 + tq * 1024 + h * 128;
                      un.LSE = LSE + (size_t)gi * CT * 8 + tq * 8 + h;
                      un.ldq = d * 9216; un.ldk = d * 9216; un.ldv = d * 9216; un.ldo = d * 1024; un.ldl = d * 8; un.nt = nt; un.qoff = l0 - kw0;
                      att::attn_unit<CfgC, true, true>(un, (char*)lds_raw, tid); } }
                GRID_BAR();
                { PHASE_VARS(); CHUNK_VARS(); c_merge((bf16*)(BIG + C_OG), (float*)(ws + WS_LSE), Hb, gw, NGW, lane); }
                GRID_BAR();
                { PHASE_VARS(); CHUNK_VARS(); GEMM_PHASE(pg8::EpiResid, Hb, WT + OFF_CO, CT, DM, 1024, X, X, DM); }
                GRID_BAR();
            }
            { PHASE_VARS(); CHUNK_VARS();
              norm_rows(X, nullptr, Hb, INP(I_NMLP) + layer * DM, nullptr, nullptr, CT, gw, NGW, lane);
              const float* P = (prompt ? INP(I_PP) + ((size_t)layer * NPROMPT + tok0) * PLED : INP(I_PS) + ((size_t)layer * NPROMPT + (tok0 - NPROMPT)) * PLED); bf16* const PB = (bf16*)(ws + WS_PB);
              for (int i = vcu * 512 + tid; i < CT * PLED / 8; i += G * 512) { const f32x4 a0 = ((const f32x4*)P)[2 * i], a1 = ((const f32x4*)P)[2 * i + 1];
                  v4u w; w.x = pk2(a0.x, a0.y); w.y = pk2(a0.z, a0.w); w.z = pk2(a1.x, a1.y); w.w = pk2(a1.z, a1.w); ((v4u*)PB)[i] = w; } }
            GRID_BAR();
            { PHASE_VARS(); CHUNK_VARS(); GEMM_PHASE(pg8::EpiBf16<1>, Hb, WT + OFF_IN + (size_t)layer * SZ_IN, CT, DFF, DM, (bf16*)(BIG + B_HID), DFF); }
            { PHASE_VARS(); CHUNK_VARS(); GEMM_PHASE(pg8::EpiBf16<0>, (bf16*)(ws + WS_PB), WT + OFF_PLE + (size_t)layer * SZ_PLE, CT, DM, PLED, (bf16*)(ws + WS_E0), DM); }
            GRID_BAR();
            { PHASE_VARS(); CHUNK_VARS(); GEMM_PHASE(pg8::EpiResid, (bf16*)(BIG + B_HID), WT + OFF_OUT + (size_t)layer * SZ_OUT, CT, DM, DFF, X, X, DM); }
            GRID_BAR();
            { PHASE_VARS(); CHUNK_VARS(); norm_rows(X, nullptr, Hb, INP(I_GATEG) + layer * DM, (bf16*)(ws + WS_E0), (float*)(ws + WS_RSTD), CT, gw, NGW, lane); }
            GRID_BAR();
            { PHASE_VARS(); CHUNK_VARS(); GEMM_PHASE(pg8::EpiGate, Hb, WT + OFF_GATE + (size_t)layer * SZ_GATE, CT, DM, DM, X, X, DM, (bf16*)(ws + WS_E0), (float*)(ws + WS_RSTD), INP(I_PLEG) + layer * DM); }
            GRID_BAR();
        }
    }
#undef GRID_BAR
}

extern "C" void kernel_launch(void* const* d_in, const int* in_sizes, int n_in, void* d_out, int out_size, void* d_ws, size_t ws_size, hipStream_t stream) {
    static int grid = 0;
    if (grid == 0) {
        if (n_in != N_IN || out_size != NTOK * DM || ws_size < WS_END) { fprintf(stderr, "kernel_launch: shape mismatch: n_in %d out %d ws %zu (need %zu)\n", n_in, out_size, ws_size, (size_t)WS_END); grid = -1; return; }
        int dev = 0, cus = 0, per_cu = 0;
        if (hipGetDevice(&dev) != hipSuccess || hipDeviceGetAttribute(&cus, hipDeviceAttributeMultiprocessorCount, dev) != hipSuccess) { grid = -1; return; }
        if (hipFuncSetAttribute((const void*)mk_fwd, hipFuncAttributeMaxDynamicSharedMemorySize, LDS_BYTES) != hipSuccess) { fprintf(stderr, "kernel_launch: hipFuncSetAttribute failed\n"); grid = -1; return; }
        if (hipOccupancyMaxActiveBlocksPerMultiprocessor(&per_cu, (const void*)mk_fwd, NWAVES * 64, LDS_BYTES) != hipSuccess || per_cu < 1) { fprintf(stderr, "kernel_launch: occupancy query says %d\n", per_cu); }
        (void)hipGetLastError();
        grid = cus;
    }
    if (grid < 0) return;
    if (hipMemsetAsync((char*)d_ws + WS_CTL, 0, CTL_ZERO_BYTES, stream) != hipSuccess) return;
    Args a{};
    for (int i = 0; i < N_IN; ++i) a.in[i] = (const float*)d_in[i];
    a.out = (float*)d_out; a.ws = (unsigned char*)d_ws;
    hipLaunchKernelGGL(mk_fwd, dim3(grid), dim3(NWAVES * 64), LDS_BYTES, stream, a);
    const hipError_t le = hipPeekAtLastError();
    if (le != hipSuccess) fprintf(stderr, "kernel_launch: launch failed: %s\n", hipGetErrorName(le));
}
```

```cpp
#include <hip/hip_runtime.h>
#include <cstdio>
#include <cstdint>
#ifndef PG8_WGM_NARROW
#define PG8_WGM_NARROW 4
#endif
#ifndef PG8_WGM_WIDE
#define PG8_WGM_WIDE 4
#endif
namespace pg8 {
#define PG8_LAS __attribute__((address_space(3)))
typedef unsigned short bf16_t;
typedef short bf16x8 __attribute__((ext_vector_type(8)));
typedef float f32x4 __attribute__((ext_vector_type(4)));
typedef unsigned u32x4 __attribute__((ext_vector_type(4)));
constexpr int BM = 256, BK = 64, HALF = 128, HTB = HALF * BK * 2  , STAGE_BYTES = 8 * HTB, NXCD = 8, WGM = 8;

__host__ __device__ __forceinline__ int lds_byte(int r, int c) { const int st = (r >> 4) * 2 + (c >> 5), rr = r & 15, cc = c & 31, ob = rr * 64 + cc * 2; return st * 1024 + (ob ^ (((ob >> 9) & 1) << 5)); }
__host__ __device__ __forceinline__ void stage_rc(int b, int& R, int& C) { const int st = b / 1024, sb = b % 1024, swz = sb ^ (((sb >> 9) & 1) << 5); R = (st >> 1) * 16 + swz / 64; C = (st & 1) * 32 + (swz % 64) / 2; }
__host__ __device__ __forceinline__ int perm32(int rho) { const int n = rho >> 4, i = rho & 15; return 8 * (i >> 2) + 4 * n + (i & 3); }

struct Unit { int pm, pn; };
struct Gemm { const bf16_t* A; const bf16_t* Bt; int M, N, K; };

struct StaticOrder {
    int nM, nN, nwg, G, c;
    __host__ __device__ void init(int M, int N, int G_, int c_) { nM = M / BM; nN = N / BM; nwg = nM * nN; G = G_; c = c_; }
    __host__ __device__ bool next(int i, Unit& u) const {
        const long L = (long)i * G + c; if (L >= nwg) return false;
        int wgid = (int)L; { const int q = nwg / NXCD, r = nwg % NXCD, xcd = wgid % NXCD, off = wgid / NXCD; wgid = (xcd < r ? xcd * (q + 1) : r * (q + 1) + (xcd - r) * q) + off; }
        const int wgm = (nN <= 8) ? PG8_WGM_NARROW : PG8_WGM_WIDE;
        const int nig = wgm * nN, gid = wgid / nig, fm = gid * wgm, gsz = (nM - fm) < wgm ? (nM - fm) : wgm;
        u.pm = fm + ((wgid % nig) % gsz); u.pn = (wgid % nig) / gsz; return true;
    }
    __device__ __forceinline__ void a_ready(const Unit&) const {}
    __device__ __forceinline__ void done(const Unit&) const {}
};

__device__ __forceinline__ unsigned cvt_pk_bf16(float lo, float hi) { unsigned r; asm volatile("v_cvt_pk_bf16_f32 %0, %1, %2" : "=v"(r) : "v"(lo), "v"(hi)); return r; }
typedef float f32x2 __attribute__((ext_vector_type(2)));
typedef unsigned u32x2 __attribute__((ext_vector_type(2)));
__device__ __forceinline__ float xlane(float v, int lane, int o) { return __int_as_float(__builtin_amdgcn_ds_bpermute((lane ^ o) << 2, __float_as_int(v))); }
template <int ACT, bool RS, bool SS> struct EpiBf16 {
    static constexpr bool PERM = true, AFTER_DRAIN = false, ACC_INIT = false;
    bf16_t* O; int ldc; const float* rs; float* ssp;
    __device__ __forceinline__ void operator()(const f32x4 (&acc)[2][2][4][2], const Unit& u, int wr, int wc, int fr, int fq) const {
        { int t_; asm volatile("v_mbcnt_lo_u32_b32 %0, -1, 0\n\tv_mbcnt_hi_u32_b32 %0, -1, %0" : "=v"(t_)); fr = t_ & 15; fq = (t_ >> 4) & 3; }
        const int row0 = u.pm * BM + wr * 64 + fr; const int col0 = u.pn * BM + wc * 32 + 8 * fq;
        float scr[8];
#pragma unroll
        for (int gi = 0; gi < 8; ++gi) scr[gi] = RS ? rs[row0 + (gi >> 2) * HALF + (gi & 3) * 16] : 1.f;
#pragma unroll
        for (int ai = 0; ai < 2; ++ai)
#pragma unroll
            for (int m = 0; m < 4; ++m) { const int row = row0 + ai * HALF + m * 16; bf16_t* rowp = O + (size_t)row * ldc + col0;
                const float sc = scr[ai * 4 + m];
                float q = 0.f;
#pragma unroll
                for (int bj = 0; bj < 2; ++bj) { f32x4 v0 = acc[ai][bj][m][0], v1 = acc[ai][bj][m][1];
                    if (RS) { v0 = v0 * sc; v1 = v1 * sc; }
                    if (ACT == 1) {
#pragma unroll
                        for (int j = 0; j < 4; ++j) { const float a = fmaxf(v0[j], 0.f), b = fmaxf(v1[j], 0.f); v0[j] = a * a; v1[j] = b * b; } }
                    if (SS) {
#pragma unroll
                        for (int j = 0; j < 4; ++j) q += v0[j] * v0[j] + v1[j] * v1[j]; }
                    u32x4 w; w.x = cvt_pk_bf16(v0[0], v0[1]); w.y = cvt_pk_bf16(v0[2], v0[3]); w.z = cvt_pk_bf16(v1[0], v1[1]); w.w = cvt_pk_bf16(v1[2], v1[3]);
                    __builtin_nontemporal_store(w, (u32x4*)(rowp + bj * HALF)); }
                if (SS) { const int lane = fq * 16 + fr; q += xlane(q, lane, 16); q += xlane(q, lane, 32); if (fq == 0) ssp[(size_t)row * 32 + u.pn * 4 + wc] = q; } }
    }
};
template <int KIND> struct EpiQK {
    static constexpr bool PERM = true, AFTER_DRAIN = false, ACC_INIT = false;
    bf16_t* O; int ldc; const float* rs; const float* qg; const float* kg; const f32x2* T; int seqmask; PG8_LAS float* P; int nq, nqk;
    __device__ __forceinline__ void operator()(const f32x4 (&acc)[2][2][4][2], const Unit& u, int wr, int wc, int fr, int fq) const {
        { int t_; asm volatile("v_mbcnt_lo_u32_b32 %0, -1, 0\n\tv_mbcnt_hi_u32_b32 %0, -1, %0" : "=v"(t_)); fr = t_ & 15; fq = (t_ >> 4) & 3; }
        const int lane = fq * 16 + fr, rl0 = wr * 64 + fr, row0 = u.pm * BM + rl0, col0 = u.pn * BM + wc * 32 + 8 * fq;
        float scr[8];
#pragma unroll
        for (int gi = 0; gi < 8; ++gi) scr[gi] = rs[row0 + (gi >> 2) * HALF + (gi & 3) * 16];
        if (u.pn >= nqk) {
#pragma unroll
            for (int ai = 0; ai < 2; ++ai)
#pragma unroll
                for (int m = 0; m < 4; ++m) { bf16_t* rowp = O + (size_t)(row0 + ai * HALF + m * 16) * ldc + col0; const float sc = scr[ai * 4 + m];
#pragma unroll
                    for (int bj = 0; bj < 2; ++bj) { const f32x4 v0 = acc[ai][bj][m][0] * sc, v1 = acc[ai][bj][m][1] * sc;
                        u32x4 w; w.x = cvt_pk_bf16(v0[0], v0[1]); w.y = cvt_pk_bf16(v0[2], v0[3]); w.z = cvt_pk_bf16(v1[0], v1[1]); w.w = cvt_pk_bf16(v1[2], v1[3]);
                        *(u32x4*)(rowp + bj * HALF) = w; } }
            return;
        }
#pragma unroll
        for (int ai = 0; ai < 2; ++ai)
#pragma unroll
            for (int m = 0; m < 4; ++m) { const float sc = scr[ai * 4 + m];
#pragma unroll
                for (int bj = 0; bj < 2; ++bj) { const f32x4 v0 = acc[ai][bj][m][0] * sc, v1 = acc[ai][bj][m][1] * sc;
                    float q = (v0[0] * v0[0] + v0[1] * v0[1]) + (v0[2] * v0[2] + v0[3] * v0[3]) + (v1[0] * v1[0] + v1[1] * v1[1]) + (v1[2] * v1[2] + v1[3] * v1[3]);
                    q += xlane(q, lane, 16); q += xlane(q, lane, 32);
                    if (fq == 0) P[((ai * HALF + rl0 + m * 16) * 2 + bj) * 4 + wc] = q; } }
        asm volatile("s_waitcnt lgkmcnt(0)" ::: "memory"); __builtin_amdgcn_s_barrier(); asm volatile("" ::: "memory");
        const float* g = (u.pn < nq) ? qg : kg;
        const bool roped = (KIND == 1) || (wc == 0);
        float gl[8];
#pragma unroll
        for (int i = 0; i < 8; ++i) { int d;
            if (KIND == 1) d = (wc >> 1) * 64 + (i & 1) * 32 + (wc & 1) * 16 + fq * 4 + (i >> 1);
            else d = (wc == 0) ? ((i & 1) * 16 + fq * 4 + (i >> 1)) : (wc * 32 + fq * 8 + i);
            gl[i] = g[d]; }
        const int fi0 = (KIND == 1) ? ((wc & 1) * 16 + fq * 4) : (fq * 4);
#pragma unroll
        for (int ai = 0; ai < 2; ++ai)
#pragma unroll
            for (int m = 0; m < 4; ++m) { const int rl = ai * HALF + rl0 + m * 16, row = u.pm * BM + rl; bf16_t* rowp = O + (size_t)row * ldc + col0; const float sc = scr[ai * 4 + m];
                const int t = row & seqmask; const int pos = (KIND == 1) ? ((wc >> 1) ? (t & 63) : (t >> 6)) : t;
                f32x4 c01 = {1.f, 0.f, 1.f, 0.f}, c23 = {1.f, 0.f, 1.f, 0.f};
                if (roped) { const f32x4* cp = (const f32x4*)(T + (size_t)pos * (KIND == 1 ? 32 : 16) + fi0); c01 = cp[0]; c23 = cp[1]; }
#pragma unroll
                for (int bj = 0; bj < 2; ++bj) { const f32x4 p4 = *(const PG8_LAS f32x4*)(P + (rl * 2 + bj) * 4);
                    const float rstd = __builtin_amdgcn_rsqf(((p4[0] + p4[1]) + (p4[2] + p4[3])) * (1.f / 128.f) + 1e-6f) * sc;
                    float y[8];
#pragma unroll
                    for (int j = 0; j < 4; ++j) { y[j] = acc[ai][bj][m][0][j] * rstd * gl[j]; y[4 + j] = acc[ai][bj][m][1][j] * rstd * gl[4 + j]; }
                    float o[8];
                    o[0] = y[0] * c01[0] - y[1] * c01[1]; o[1] = y[1] * c01[0] + y[0] * c01[1]; o[2] = y[2] * c01[2] - y[3] * c01[3]; o[3] = y[3] * c01[2] + y[2] * c01[3];
                    o[4] = y[4] * c23[0] - y[5] * c23[1]; o[5] = y[5] * c23[0] + y[4] * c23[1]; o[6] = y[6] * c23[2] - y[7] * c23[3]; o[7] = y[7] * c23[2] + y[6] * c23[3];
                    u32x4 w; w.x = cvt_pk_bf16(o[0], o[1]); w.y = cvt_pk_bf16(o[2], o[3]); w.z = cvt_pk_bf16(o[4], o[5]); w.w = cvt_pk_bf16(o[6], o[7]);
                    *(u32x4*)(rowp + bj * HALF) = w; } }
    }
};
template <bool GATE, bool F32OUT> struct EpiResidT {
    static constexpr bool PERM = true, AFTER_DRAIN = false, ACC_INIT = !GATE;
    const bf16_t* base; float* out; bf16_t* xb; float* ssp; int ldc; const bf16_t* e0; const float* rs; const float* rse; const float* g;
    __device__ static __forceinline__ void expand(const u32x4 w, f32x4& a0, f32x4& a1) {
        a0[0] = __uint_as_float(w.x << 16); a0[1] = __uint_as_float(w.x & 0xffff0000u); a0[2] = __uint_as_float(w.y << 16); a0[3] = __uint_as_float(w.y & 0xffff0000u);
        a1[0] = __uint_as_float(w.z << 16); a1[1] = __uint_as_float(w.z & 0xffff0000u); a1[2] = __uint_as_float(w.w << 16); a1[3] = __uint_as_float(w.w & 0xffff0000u); }
    __device__ __forceinline__ void issue_base(u32x4 (&raw)[2][4][2], const Unit& u, int wr, int wc) const {
        int fr, fq; { int t_; asm volatile("v_mbcnt_lo_u32_b32 %0, -1, 0\n\tv_mbcnt_hi_u32_b32 %0, -1, %0" : "=v"(t_)); fr = t_ & 15; fq = (t_ >> 4) & 3; }
        const int row0 = u.pm * BM + wr * 64 + fr, col0 = u.pn * BM + wc * 32 + 8 * fq;
#pragma unroll
        for (int ai = 0; ai < 2; ++ai)
#pragma unroll
            for (int m = 0; m < 4; ++m) { const bf16_t* p = base + (size_t)(row0 + ai * HALF + m * 16) * ldc + col0;
                asm volatile("global_load_dwordx4 %0, %2, off\n\tglobal_load_dwordx4 %1, %2, off offset:256" : "=&v"(raw[ai][m][0]), "=&v"(raw[ai][m][1]) : "v"(p) : "memory"); }
    }
    template <int NYOUNGER> __device__ __forceinline__ void finish_base(f32x4 (&acc)[2][2][4][2], u32x4 (&raw)[2][4][2]) const {
        if constexpr (NYOUNGER == 0)
        asm volatile("s_waitcnt vmcnt(0)" : "+v"(raw[0][0][0]), "+v"(raw[0][0][1]), "+v"(raw[0][1][0]), "+v"(raw[0][1][1]), "+v"(raw[0][2][0]), "+v"(raw[0][2][1]), "+v"(raw[0][3][0]), "+v"(raw[0][3][1]),
                     "+v"(raw[1][0][0]), "+v"(raw[1][0][1]), "+v"(raw[1][1][0]), "+v"(raw[1][1][1]), "+v"(raw[1][2][0]), "+v"(raw[1][2][1]), "+v"(raw[1][3][0]), "+v"(raw[1][3][1]) :: "memory");
        else
        asm volatile("s_waitcnt vmcnt(16)" : "+v"(raw[0][0][0]), "+v"(raw[0][0][1]), "+v"(raw[0][1][0]), "+v"(raw[0][1][1]), "+v"(raw[0][2][0]), "+v"(raw[0][2][1]), "+v"(raw[0][3][0]), "+v"(raw[0][3][1]),
                     "+v"(raw[1][0][0]), "+v"(raw[1][0][1]), "+v"(raw[1][1][0]), "+v"(raw[1][1][1]), "+v"(raw[1][2][0]), "+v"(raw[1][2][1]), "+v"(raw[1][3][0]), "+v"(raw[1][3][1]) :: "memory");
        static_assert(NYOUNGER == 0 || NYOUNGER == 16, "finish_base: 0 or 16");
#pragma unroll
        for (int ai = 0; ai < 2; ++ai)
#pragma unroll
            for (int m = 0; m < 4; ++m)
#pragma unroll
                for (int bj = 0; bj < 2; ++bj) expand(raw[ai][m][bj], acc[ai][bj][m][0], acc[ai][bj][m][1]);
    }
    __device__ __forceinline__ void operator()(const f32x4 (&acc)[2][2][4][2], const Unit& u, int wr, int wc, int fr, int fq) const {
        { int t_; asm volatile("v_mbcnt_lo_u32_b32 %0, -1, 0\n\tv_mbcnt_hi_u32_b32 %0, -1, %0" : "=v"(t_)); fr = t_ & 15; fq = (t_ >> 4) & 3; }
        const int row0 = u.pm * BM + wr * 64 + fr, col0 = u.pn * BM + wc * 32 + 8 * fq; const int lane = fq * 16 + fr;
        if constexpr (!GATE) {
#pragma unroll
            for (int ai = 0; ai < 2; ++ai)
#pragma unroll
                for (int m = 0; m < 4; ++m) { const int row = row0 + ai * HALF + m * 16; const size_t off = (size_t)row * ldc + col0; float q = 0.f;
#pragma unroll
                    for (int bj = 0; bj < 2; ++bj) { const f32x4 x0 = acc[ai][bj][m][0], x1 = acc[ai][bj][m][1];
                        if (F32OUT) { *(f32x4*)(out + off + bj * HALF) = x0; *(f32x4*)(out + off + bj * HALF + 4) = x1; }
#pragma unroll
                        for (int j = 0; j < 4; ++j) q += x0[j] * x0[j] + x1[j] * x1[j];
                        u32x4 w; w.x = cvt_pk_bf16(x0[0], x0[1]); w.y = cvt_pk_bf16(x0[2], x0[3]); w.z = cvt_pk_bf16(x1[0], x1[1]); w.w = cvt_pk_bf16(x1[2], x1[3]);
                        *(u32x4*)(xb + off + bj * HALF) = w; }
                    q += xlane(q, lane, 16); q += xlane(q, lane, 32); if (fq == 0) ssp[(size_t)row * 32 + u.pn * 4 + wc] = q; }
        } else {
            f32x4 gv[2][2];
#pragma unroll
            for (int bj = 0; bj < 2; ++bj)
#pragma unroll
                for (int n = 0; n < 2; ++n) gv[bj][n] = *(const f32x4*)(g + col0 + bj * HALF + n * 4);
            float sxr[8], ser[8];
#pragma unroll
            for (int gi = 0; gi < 8; ++gi) { const int row = row0 + (gi >> 2) * HALF + (gi & 3) * 16; sxr[gi] = rs[row]; ser[gi] = rse[row]; }
            u32x4 pb[2][2], pe[2][2];
#define PG8_GLOAD(set, gi) do { const size_t off_ = (size_t)(row0 + ((gi) >> 2) * HALF + ((gi) & 3) * 16) * ldc + col0; _Pragma("unroll") for (int bj = 0; bj < 2; ++bj) { \
                pb[set][bj] = *(const u32x4*)(base + off_ + bj * HALF); pe[set][bj] = *(const u32x4*)(e0 + off_ + bj * HALF); } } while (0)
            PG8_GLOAD(0, 0);
#pragma unroll
            for (int gi = 0; gi < 8; ++gi) { const int ai = gi >> 2, m = gi & 3, cs = gi & 1; const int row = row0 + ai * HALF + m * 16; const size_t off = (size_t)row * ldc + col0;
                if (gi < 7) { if (cs == 0) PG8_GLOAD(1, gi + 1); else PG8_GLOAD(0, gi + 1); }
                const float sx = sxr[gi] * -1.4426950408889634f, se = ser[gi]; float q = 0.f;
#pragma unroll
                for (int bj = 0; bj < 2; ++bj) { f32x4 e_0, e_1, b_0, b_1; expand(pe[cs][bj], e_0, e_1); expand(pb[cs][bj], b_0, b_1);
                    f32x4 d0 = acc[ai][bj][m][0], d1 = acc[ai][bj][m][1];
#pragma unroll
                    for (int j = 0; j < 4; ++j) { d0[j] = __builtin_amdgcn_rcpf(1.0f + __builtin_amdgcn_exp2f(d0[j] * sx)); d1[j] = __builtin_amdgcn_rcpf(1.0f + __builtin_amdgcn_exp2f(d1[j] * sx)); }
                    const f32x4 x0 = b_0 + d0 * (e_0 * se * gv[bj][0]), x1 = b_1 + d1 * (e_1 * se * gv[bj][1]);
                    if (F32OUT) { *(f32x4*)(out + off + bj * HALF) = x0; *(f32x4*)(out + off + bj * HALF + 4) = x1; }
#pragma unroll
                    for (int j = 0; j < 4; ++j) q += x0[j] * x0[j] + x1[j] * x1[j];
                    if (!F32OUT) { u32x4 w; w.x = cvt_pk_bf16(x0[0], x0[1]); w.y = cvt_pk_bf16(x0[2], x0[3]); w.z = cvt_pk_bf16(x1[0], x1[1]); w.w = cvt_pk_bf16(x1[2], x1[3]);
                        *(u32x4*)(xb + off + bj * HALF) = w; } }
                if (!F32OUT) { q += xlane(q, lane, 16); q += xlane(q, lane, 32); if (fq == 0) ssp[(size_t)row * 32 + u.pn * 4 + wc] = q; }
                asm volatile("" ::: "memory"); }
#undef PG8_GLOAD
        }
    }
};
template <class Epi, class Sched, bool ALIGN_EPI = false, bool SP2 = false>
__device__ __forceinline__ void gemm_phase(PG8_LAS unsigned char* lds, const Gemm g, const Sched& S, const Epi& E, const int tid) {
    const int wid = __builtin_amdgcn_readfirstlane(tid >> 6), lane = tid & 63, wr = wid >> 2, wc = wid & 3, fr = lane & 15, fq = lane >> 4;
    const int K = g.K, nt = K / BK;
    unsigned voffA[2], voffB[2];
#pragma unroll
    for (int i = 0; i < 2; ++i) { int R, C; stage_rc(tid * 16 + i * 8192, R, C); const int Rb = Epi::PERM ? ((R & ~31) + perm32(R & 31)) : R;
        voffA[i] = (unsigned)(R * K + C) * 2u; voffB[i] = (unsigned)(Rb * K + C) * 2u; }
    const size_t kstep = (size_t)(BK * 2);
    const size_t hstep = (size_t)HALF * K * 2;
    const size_t tstep = 2 * hstep;
    const unsigned ldsw = (unsigned)wid * 1024u;
    const int aoff = lds_byte(wr * 64 + fr, fq * 8), boff = lds_byte(wc * 32 + fr, fq * 8);
#define PG8_SA(b, h) (((b) * 2 + (h)) * HTB)
#define PG8_SB(b, h) ((4 + (b) * 2 + (h)) * HTB)
#define PG8_STAGE(bufoff, gbase, voff) do { _Pragma("unroll") for (int _i = 0; _i < 2; ++_i) \
        __builtin_amdgcn_global_load_lds((const unsigned*)((const char*)(gbase) + (voff)[_i]), (PG8_LAS unsigned*)(lds + (bufoff) + ldsw + _i * 8192), 16, 0, 0); } while (0)
#define PG8_LDA(dst, b, h) do { _Pragma("unroll") for (int m = 0; m < 4; ++m) _Pragma("unroll") for (int k = 0; k < 2; ++k) dst[m][k] = *(const PG8_LAS bf16x8*)(lds + PG8_SA(b, h) + aoff + m * 2048 + k * 1024); } while (0)
#define PG8_LDB(dst, b, h) do { _Pragma("unroll") for (int n = 0; n < 2; ++n) _Pragma("unroll") for (int k = 0; k < 2; ++k) dst[n][k] = *(const PG8_LAS bf16x8*)(lds + PG8_SB(b, h) + boff + n * 2048 + k * 1024); } while (0)
#define PG8_MMA(ai, bj, At, Bt) do { __builtin_amdgcn_s_setprio(1); _Pragma("unroll") for (int m = 0; m < 4; ++m) _Pragma("unroll") for (int n = 0; n < 2; ++n) _Pragma("unroll") for (int k = 0; k < 2; ++k) \
        acc[ai][bj][m][n] = __builtin_amdgcn_mfma_f32_16x16x32_bf16(Bt[n][k], At[m][k], acc[ai][bj][m][n], 0, 0, 0); __builtin_amdgcn_s_setprio(0); } while (0)
#define PG8_WAIT_V(n) asm volatile("s_waitcnt vmcnt(" #n ")" ::: "memory")
#define PG8_WAIT_L(n) asm volatile("s_waitcnt lgkmcnt(" #n ")" ::: "memory")
#define PG8_BAR __builtin_amdgcn_s_barrier()
#define PG8_SCHED __builtin_amdgcn_sched_barrier(0)
    Unit cur, nxt; int ui = 0;
    if (!S.next(0, cur)) return;
    f32x4 acc[2][2][4][2];
    u32x4 rawb[2][4][2];
    if constexpr (Epi::ACC_INIT) { E.issue_base(rawb, cur, wr, wc); E.template finish_base<0>(acc, rawb); }
    else {
#pragma unroll
    for (int a = 0; a < 2; ++a)
#pragma unroll
        for (int b = 0; b < 2; ++b)
#pragma unroll
            for (int m = 0; m < 4; ++m)
#pragma unroll
                for (int n = 0; n < 2; ++n) acc[a][b][m][n] = (f32x4){0.f, 0.f, 0.f, 0.f};
    }
    bf16x8 At[4][2], B0[2][2], B1[2][2];
    const char* cA = (const char*)g.A + (size_t)cur.pm * tstep; const char* cB = (const char*)g.Bt + (size_t)cur.pn * tstep;
    S.a_ready(cur);
    if constexpr (SP2) {
        PG8_STAGE(PG8_SB(0, 0), cB, voffB); PG8_STAGE(PG8_SB(0, 1), cB + hstep, voffB); PG8_STAGE(PG8_SA(0, 0), cA, voffA); PG8_STAGE(PG8_SA(0, 1), cA + hstep, voffA);
        if (wr == 1) PG8_BAR;
        PG8_WAIT_V(2); PG8_BAR;
        PG8_STAGE(PG8_SB(1, 0), cB + kstep, voffB); PG8_STAGE(PG8_SA(1, 0), cA + kstep, voffA); PG8_STAGE(PG8_SB(1, 1), cB + hstep + kstep, voffB);
        PG8_WAIT_V(6); PG8_BAR;
    } else {
        PG8_STAGE(PG8_SB(0, 0), cB, voffB); PG8_STAGE(PG8_SA(0, 0), cA, voffA); PG8_STAGE(PG8_SB(0, 1), cB + hstep, voffB); PG8_STAGE(PG8_SA(0, 1), cA + hstep, voffA);
        if (wr == 1) PG8_BAR;
        PG8_WAIT_V(4); PG8_BAR;
        PG8_STAGE(PG8_SB(1, 0), cB + kstep, voffB); PG8_STAGE(PG8_SA(1, 0), cA + kstep, voffA); PG8_STAGE(PG8_SB(1, 1), cB + hstep + kstep, voffB);
        PG8_WAIT_V(6); PG8_BAR;
    }
    for (;;) {
        const bool has_next = S.next(ui + 1, nxt);
        const char* nA = has_next ? (const char*)g.A + (size_t)nxt.pm * tstep : cA; const char* nB = has_next ? (const char*)g.Bt + (size_t)nxt.pn * tstep : cB;
        for (int t = 0; t < nt; t += 2) {
            const bool last = (t == nt - 2);
            const char* a1 = cA + (size_t)(t + 1) * kstep;
            const char* a2 = last ? nA : cA + (size_t)(t + 2) * kstep; const char* b2 = last ? nB : cB + (size_t)(t + 2) * kstep;
            const char* a3 = a2 + kstep; const char* b3 = b2 + kstep;
            if (last && has_next) S.a_ready(nxt);
            if constexpr (SP2) {
            PG8_LDB(B0, 0, 0); PG8_LDB(B1, 0, 1); PG8_SCHED; PG8_LDA(At, 0, 0); PG8_STAGE(PG8_SA(1, 1), a1 + hstep, voffA);
            PG8_WAIT_V(8); PG8_WAIT_L(0); PG8_BAR; PG8_MMA(0, 0, At, B0); PG8_MMA(0, 1, At, B1); PG8_BAR; PG8_SCHED;
            PG8_LDA(At, 0, 1); PG8_STAGE(PG8_SB(0, 0), b2, voffB); PG8_STAGE(PG8_SB(0, 1), b2 + hstep, voffB); PG8_STAGE(PG8_SA(0, 0), a2, voffA);
            PG8_WAIT_V(8); PG8_WAIT_L(0); PG8_BAR; PG8_MMA(1, 0, At, B0); PG8_MMA(1, 1, At, B1); PG8_BAR; PG8_SCHED;
            PG8_LDB(B0, 1, 0); PG8_LDB(B1, 1, 1); PG8_SCHED; PG8_LDA(At, 1, 0); PG8_STAGE(PG8_SA(0, 1), a2 + hstep, voffA);
            PG8_WAIT_V(8); PG8_WAIT_L(0); PG8_BAR; PG8_MMA(0, 0, At, B0); PG8_MMA(0, 1, At, B1); PG8_BAR; PG8_SCHED;
            PG8_LDA(At, 1, 1); PG8_STAGE(PG8_SB(1, 0), b3, voffB); PG8_STAGE(PG8_SB(1, 1), b3 + hstep, voffB); PG8_STAGE(PG8_SA(1, 0), a3, voffA);
            PG8_WAIT_V(8); PG8_WAIT_L(0); PG8_BAR; PG8_MMA(1, 0, At, B0); PG8_MMA(1, 1, At, B1); PG8_BAR; PG8_SCHED;
            } else {
            PG8_LDB(B0, 0, 0); PG8_SCHED; PG8_LDA(At, 0, 0); PG8_STAGE(PG8_SA(1, 1), a1 + hstep, voffA);
            PG8_WAIT_L(8); PG8_BAR; PG8_WAIT_L(0); PG8_MMA(0, 0, At, B0); PG8_BAR; PG8_SCHED;
            PG8_LDB(B1, 0, 1); PG8_STAGE(PG8_SB(0, 0), b2, voffB);
            PG8_BAR; PG8_WAIT_L(0); PG8_MMA(0, 1, At, B1); PG8_BAR;
            PG8_LDA(At, 0, 1); PG8_STAGE(PG8_SA(0, 0), a2, voffA);
            PG8_BAR; PG8_WAIT_L(0); PG8_MMA(1, 0, At, B0); PG8_BAR; PG8_SCHED;
            PG8_STAGE(PG8_SB(0, 1), b2 + hstep, voffB);
            PG8_WAIT_V(6); PG8_BAR; PG8_MMA(1, 1, At, B1); PG8_BAR;
            PG8_LDB(B0, 1, 0); PG8_SCHED; PG8_LDA(At, 1, 0); PG8_STAGE(PG8_SA(0, 1), a2 + hstep, voffA);
            PG8_WAIT_L(8); PG8_BAR; PG8_WAIT_L(0); PG8_MMA(0, 0, At, B0); PG8_BAR; PG8_SCHED;
            PG8_LDB(B1, 1, 1); PG8_STAGE(PG8_SB(1, 0), b3, voffB);
            PG8_BAR; PG8_WAIT_L(0); PG8_MMA(0, 1, At, B1); PG8_BAR;
            PG8_LDA(At, 1, 1); PG8_STAGE(PG8_SA(1, 0), a3, voffA);
            PG8_BAR; PG8_WAIT_L(0); PG8_MMA(1, 0, At, B0); PG8_BAR; PG8_SCHED;
            PG8_STAGE(PG8_SB(1, 1), b3 + hstep, voffB);
            PG8_WAIT_V(6); PG8_BAR; PG8_MMA(1, 1, At, B1); PG8_BAR;
            }
        }
        if constexpr (ALIGN_EPI) { if (wr == 0) PG8_BAR; }
        if constexpr (Epi::ACC_INIT) { E.issue_base(rawb, has_next ? nxt : cur, wr, wc); }
        if constexpr (!Epi::AFTER_DRAIN) { E(acc, cur, wr, wc, fr, fq); S.done(cur); }
        if constexpr (Epi::ACC_INIT) E.template finish_base<16>(acc, rawb);
        if (!has_next) break;
        if constexpr (!Epi::ACC_INIT) {
#pragma unroll
        for (int a = 0; a < 2; ++a)
#pragma unroll
            for (int b = 0; b < 2; ++b)
#pragma unroll
                for (int m = 0; m < 4; ++m)
#pragma unroll
                    for (int n = 0; n < 2; ++n) acc[a][b][m][n] = (f32x4){0.f, 0.f, 0.f, 0.f};
        }
        cur = nxt; cA = nA; cB = nB; ++ui;
        if constexpr (ALIGN_EPI) { if (wr == 1) PG8_BAR; }
    }
    PG8_WAIT_V(0);
    if constexpr (!ALIGN_EPI) { if (wr == 0) PG8_BAR; }
    PG8_BAR;
    if constexpr (Epi::AFTER_DRAIN) { E.fused(acc, cur, wr, wc, fr, fq, lds, wid, lane); S.done(cur); }
#undef PG8_SA
#undef PG8_SB
#undef PG8_STAGE
#undef PG8_LDA
#undef PG8_LDB
#undef PG8_MMA
#undef PG8_WAIT_V
#undef PG8_WAIT_L
#undef PG8_BAR
#undef PG8_SCHED
}
}
#ifndef ATT_QKPF
#define ATT_QKPF 0
#endif
#ifndef ATT_B_NQR
#define ATT_B_NQR 6
#endif
#ifndef ATT_B_QK1
#define ATT_B_QK1 1
#endif
#ifndef ATT_B_PV
#define ATT_B_PV 1
#endif
#ifndef ATT_QKSPLIT
#define ATT_QKSPLIT 1
#endif
#ifndef ATT_SMSPLIT
#define ATT_SMSPLIT 1
#endif
#if ATT_SMSPLIT
#define PV_SM(o, vb, a0, a1, a2, a3, q0, q1, m, mn, al) do { if constexpr ((CF::ND0 == 8 || ATT_B_PV) && !MASK) pv_sm<CF>(o, vb, a0, a1, a2, a3, q0, q1, m, mn, al); \
    else { pv_d0(o, vb, a0, a1, a2, a3); partialSM<CF>(q0, q1, m, mn, al); } } while (0)
#else
#define PV_SM(o, vb, a0, a1, a2, a3, q0, q1, m, mn, al) do { pv_d0(o, vb, a0, a1, a2, a3); partialSM<CF>(q0, q1, m, mn, al); } while (0)
#endif
namespace att {
typedef unsigned short bf16_t;
using bf16x8 = __attribute__((ext_vector_type(8))) short;
using s16x4  = __attribute__((ext_vector_type(4))) short;
using f32x16 = __attribute__((ext_vector_type(16))) float;
using u32x4  = __attribute__((ext_vector_type(4))) unsigned;
constexpr int QBLK = 32, KVBLK = 64, NW = 8;
constexpr float THR = 8.f;
#define ATT_SBAR() __builtin_amdgcn_sched_barrier(0)
#define ATT_SYNC() __syncthreads()
__device__ __forceinline__ int crow(int r, int hi) { return (r & 3) + 8 * (r >> 2) + 4 * hi; }
__device__ __forceinline__ unsigned cvtpk(float lo, float hi) { unsigned r; asm volatile("v_cvt_pk_bf16_f32 %0, %1, %2" : "=v"(r) : "v"(lo), "v"(hi)); return r; }
__device__ __forceinline__ bf16x8 ld8(const bf16_t* p) { return *reinterpret_cast<const bf16x8*>(p); }

template <int DQK_, int SDEPTH_, int SCALE_ID> struct Cfg {
    static constexpr int DQK = DQK_, SDEPTH = SDEPTH_, ND0 = DQK_ / 16, KPITCH = DQK_ * 2;
    static constexpr int KSWM = 7;
    static constexpr float SCALE = SCALE_ID == 0 ? 0.088388347648318440f   : 0.072168783648703220f  ;
    static constexpr int SHM_V = KVBLK * 128 * 2, SHM_K = KVBLK * DQK_ * 2;
    static constexpr int OST_PITCH = 272, OST_WAVE = 32 * OST_PITCH, OST_BYTES = NW * OST_WAVE;
    static constexpr int KV_BYTES = 2 * SHM_V + 2 * SHM_K;
    static constexpr int QX_OFF = KV_BYTES > OST_BYTES ? KV_BYTES : OST_BYTES;
    static constexpr int NQR = DQK_ > 128 ? ATT_B_NQR : 8;
    static constexpr int QXW = (DQK_ / 16 - NQR) * 1024, QX_END = QX_OFF + NW * QXW;
    static constexpr int WS_OFF = QX_END + (QX_END >= 131072 ? 1024 : 0);
    static constexpr int LDS_BYTES = WS_OFF + NW * 64 * 4;
    static constexpr int KV3_BYTES = 3 * SHM_V + 3 * SHM_K;
    static constexpr int QX3_OFF = KV3_BYTES > OST_BYTES ? KV3_BYTES : OST_BYTES;
    static constexpr int WS3_OFF = QX3_OFF + (DQK_ > 128 ? NW * 4096 : 0);
    static constexpr int LDS3_BYTES = WS3_OFF + NW * 64 * 4;
};

template <class CF> __device__ __forceinline__ void partialSM(f32x16& p0, f32x16& p1, float& m_reg, float& mn, float& alpha) {
  constexpr float C = CF::SCALE * 1.4426950408889634f;
  float pmax = p0[0];
#pragma unroll
  for (int r = 1; r < 16; ++r) pmax = fmaxf(pmax, p0[r]);
#pragma unroll
  for (int r = 0; r < 16; ++r) pmax = fmaxf(pmax, p1[r]);
  { auto rr = __builtin_amdgcn_permlane32_swap(__float_as_uint(pmax), __float_as_uint(pmax), false, false);
    pmax = fmaxf(__uint_as_float(rr[0]), __uint_as_float(rr[1])); }
  if (__builtin_expect(__all(pmax - m_reg <= THR / CF::SCALE), 1)) { mn = m_reg; alpha = 1.f; }
  else { mn = fmaxf(m_reg, pmax); alpha = __builtin_amdgcn_exp2f((m_reg - mn) * C); m_reg = mn; }
  float mnC = -mn * C;
#pragma unroll
  for (int r = 0; r < 16; ++r) p0[r] = fmaf(p0[r], C, mnC);
#pragma unroll
  for (int r = 0; r < 16; ++r) p1[r] = fmaf(p1[r], C, mnC);
#pragma unroll
  for (int r = 0; r < 16; ++r) p0[r] = __builtin_amdgcn_exp2f(p0[r]);
}
__device__ __forceinline__ void finishSM(f32x16& p0, f32x16& p1, float alpha, float& l_reg, bf16x8& pa0, bf16x8& pa1, bf16x8& pa2, bf16x8& pa3) {
#pragma unroll
  for (int r = 0; r < 16; ++r) p1[r] = __builtin_amdgcn_exp2f(p1[r]);
  float ps = 0;
#pragma unroll
  for (int r = 0; r < 16; ++r) ps += p0[r];
#pragma unroll
  for (int r = 0; r < 16; ++r) ps += p1[r];
  { auto rr = __builtin_amdgcn_permlane32_swap(__float_as_uint(ps), __float_as_uint(ps), false, false);
    ps = __uint_as_float(rr[0]) + __uint_as_float(rr[1]); }
  l_reg = l_reg * alpha + ps;
#define ATT_PK4(P, BASE, OUT) do { unsigned a0 = cvtpk(P[BASE + 0], P[BASE + 1]), a1 = cvtpk(P[BASE + 2], P[BASE + 3]);   \
    unsigned b0 = cvtpk(P[BASE + 4], P[BASE + 5]), b1 = cvtpk(P[BASE + 6], P[BASE + 7]);                              \
    auto r0 = __builtin_amdgcn_permlane32_swap(a0, b0, false, false); auto r1 = __builtin_amdgcn_permlane32_swap(a1, b1, false, false); \
    u32x4 w = {r0[0], r1[0], r0[1], r1[1]}; OUT = *reinterpret_cast<bf16x8*>(&w); } while (0)
  ATT_PK4(p0, 0, pa0); ATT_PK4(p0, 8, pa1); ATT_PK4(p1, 0, pa2); ATT_PK4(p1, 8, pa3);
#undef ATT_PK4
}
template <class CF> __device__ __forceinline__ void qkt(f32x16& p0, f32x16& p1, const char* Ks, const bf16x8* qr, const char* qx, int r32, int hi) {
  p0 = f32x16{}; p1 = f32x16{};
#pragma unroll
  for (int d0 = 0; d0 < CF::ND0; ++d0) { const int cb = (d0 * 16 + hi * 8) * 2;
    bf16x8 b0 = *reinterpret_cast<const bf16x8*>(Ks + (r32) * CF::KPITCH + (cb ^ ((r32 & CF::KSWM) << 4)));
    bf16x8 b1 = *reinterpret_cast<const bf16x8*>(Ks + (32 + r32) * CF::KPITCH + (cb ^ ((r32 & CF::KSWM) << 4)));
    bf16x8 q; if (d0 < CF::NQR) q = qr[d0 < CF::NQR ? d0 : 0]; else q = *reinterpret_cast<const bf16x8*>(qx + (d0 - CF::NQR) * 1024);
    p0 = __builtin_amdgcn_mfma_f32_32x32x16_bf16(b0, q, p0, 0, 0, 0);
    p1 = __builtin_amdgcn_mfma_f32_32x32x16_bf16(b1, q, p1, 0, 0, 0); }
}
__device__ __forceinline__ void bandmask(f32x16& p0, f32x16& p1, int kb, int qi, int hi) {
  const float ninf = -__builtin_inff();
  int dq = kb - qi + 4 * hi + 64; asm volatile("" : "+v"(dq));
#pragma unroll
  for (int r = 0; r < 16; ++r) { const int c = (r & 3) + 8 * (r >> 2); if ((unsigned)(dq + c) > 128u) p0[r] = ninf; if ((unsigned)(dq + c + 32) > 128u) p1[r] = ninf; }
}
__device__ __forceinline__ int v_st(int k, int c) { const int kk = (k & ~0xC) | ((k & 4) << 1) | ((k & 8) >> 1); return ((kk >> 3) * 4 + (c >> 5)) * 512 + ((kk & 7) * 32 + (c & 31)) * 2; }
__device__ __forceinline__ int v_rd_base(int lane) { return ((lane & 3) << 3) | (((lane >> 2) & 3) << 6) | (((lane >> 4) & 1) << 5) | (((lane >> 5) & 1) << 8); }
constexpr int v_rd_off(int d0, int ks, int half) { return d0 * 512 + ks * 4096 + half * 2048; }
template <int OFF> __device__ __forceinline__ s16x4 tr_read(int vb) {
  s16x4 r; asm volatile("ds_read_b64_tr_b16 %0, %1 offset:%2" : "=&v"(r) : "v"(vb), "i"(OFF) : "memory"); return r;
}
template <int D0> __device__ __forceinline__ void pv_one(f32x16& od, int vb, bf16x8 pa0, bf16x8 pa1, bf16x8 pa2, bf16x8 pa3) {
  const s16x4 l0 = tr_read<v_rd_off(D0, 0, 0)>(vb), h0 = tr_read<v_rd_off(D0, 0, 1)>(vb), l1 = tr_read<v_rd_off(D0, 1, 0)>(vb), h1 = tr_read<v_rd_off(D0, 1, 1)>(vb);
  const s16x4 l2 = tr_read<v_rd_off(D0, 2, 0)>(vb), h2 = tr_read<v_rd_off(D0, 2, 1)>(vb), l3 = tr_read<v_rd_off(D0, 3, 0)>(vb), h3 = tr_read<v_rd_off(D0, 3, 1)>(vb);
  asm volatile("s_waitcnt lgkmcnt(0)" ::: "memory"); ATT_SBAR();
#define ATT_PK(L, H) (bf16x8){L[0], L[1], L[2], L[3], H[0], H[1], H[2], H[3]}
  od = __builtin_amdgcn_mfma_f32_32x32x16_bf16(pa0, ATT_PK(l0, h0), od, 0, 0, 0);
  od = __builtin_amdgcn_mfma_f32_32x32x16_bf16(pa1, ATT_PK(l1, h1), od, 0, 0, 0);
  od = __builtin_amdgcn_mfma_f32_32x32x16_bf16(pa2, ATT_PK(l2, h2), od, 0, 0, 0);
  od = __builtin_amdgcn_mfma_f32_32x32x16_bf16(pa3, ATT_PK(l3, h3), od, 0, 0, 0);
#undef ATT_PK
}
__device__ __forceinline__ void pv_d0(f32x16* o, int vb, bf16x8 pa0, bf16x8 pa1, bf16x8 pa2, bf16x8 pa3) {
  pv_one<0>(o[0], vb, pa0, pa1, pa2, pa3); pv_one<1>(o[1], vb, pa0, pa1, pa2, pa3); pv_one<2>(o[2], vb, pa0, pa1, pa2, pa3); pv_one<3>(o[3], vb, pa0, pa1, pa2, pa3);
}

template <class CF> __device__ __forceinline__ void qk_sm(f32x16& n0, f32x16& n1, const char* Ks, const bf16x8* qr, int r32, int hi,
                                                          f32x16& p0, f32x16& p1, float alpha, float& l_reg, bf16x8& pa0, bf16x8& pa1, bf16x8& pa2, bf16x8& pa3) {
  n0 = f32x16{}; n1 = f32x16{};
  const char* kr = Ks + r32 * CF::KPITCH; const int sw = (r32 & CF::KSWM) << 4;
  bf16x8 ka[4], kb[4];
#define ATT_QRD(dst, g) do { _Pragma("unroll") for (int t = 0; t < 2; ++t) { const int cb = ((2 * (g) + t) * 16 + hi * 8) * 2; \
    dst[2 * t] = *reinterpret_cast<const bf16x8*>(kr + (cb ^ sw)); dst[2 * t + 1] = *reinterpret_cast<const bf16x8*>(kr + 32 * CF::KPITCH + (cb ^ sw)); } } while (0)
#define ATT_QMM(src, g) do { _Pragma("unroll") for (int t = 0; t < 2; ++t) { n0 = __builtin_amdgcn_mfma_f32_32x32x16_bf16(src[2 * t], qr[2 * (g) + t], n0, 0, 0, 0); \
    n1 = __builtin_amdgcn_mfma_f32_32x32x16_bf16(src[2 * t + 1], qr[2 * (g) + t], n1, 0, 0, 0); } } while (0)
#define ATT_PK4(P, BASE, OUT) do { unsigned a0 = cvtpk(P[BASE + 0], P[BASE + 1]), a1 = cvtpk(P[BASE + 2], P[BASE + 3]);   \
    unsigned b0 = cvtpk(P[BASE + 4], P[BASE + 5]), b1 = cvtpk(P[BASE + 6], P[BASE + 7]);                              \
    auto r0 = __builtin_amdgcn_permlane32_swap(a0, b0, false, false); auto r1 = __builtin_amdgcn_permlane32_swap(a1, b1, false, false); \
    u32x4 w = {r0[0], r1[0], r0[1], r1[1]}; OUT = *reinterpret_cast<bf16x8*>(&w); } while (0)
#if ATT_QKPF
  ATT_QRD(ka, 0); ATT_QRD(kb, 1); asm volatile("s_waitcnt lgkmcnt(4)" ::: "memory"); ATT_SBAR();
#define ATT_QNEXT(dst, g, last) do { ATT_QRD(dst, g); if (last) asm volatile("s_waitcnt lgkmcnt(0)" ::: "memory"); else asm volatile("s_waitcnt lgkmcnt(4)" ::: "memory"); ATT_SBAR(); } while (0)
#define ATT_QEARLY(dst, g) do { } while (0)
#else
  ATT_QRD(ka, 0); asm volatile("s_waitcnt lgkmcnt(0)" ::: "memory"); ATT_SBAR();
#define ATT_QEARLY(dst, g) ATT_QRD(dst, g)
#endif
  ATT_QEARLY(kb, 1);
#pragma unroll
  for (int r = 0; r < 16; ++r) p1[r] = __builtin_amdgcn_exp2f(p1[r]);
  asm volatile("" : "+v"(p1));
  ATT_QMM(ka, 0);
#if ATT_QKPF
  ATT_QRD(ka, 2); asm volatile("s_waitcnt lgkmcnt(4)" ::: "memory"); ATT_SBAR();
#else
  asm volatile("s_waitcnt lgkmcnt(0)" ::: "memory"); ATT_SBAR();
#endif
  ATT_QEARLY(ka, 2);
  float ps = 0;
#pragma unroll
  for (int r = 0; r < 16; ++r) ps += p0[r];
#pragma unroll
  for (int r = 0; r < 16; ++r) ps += p1[r];
  asm volatile("" : "+v"(ps));
  ATT_QMM(kb, 1);
#if ATT_QKPF
  ATT_QRD(kb, 3); asm volatile("s_waitcnt lgkmcnt(4)" ::: "memory"); ATT_SBAR();
#else
  asm volatile("s_waitcnt lgkmcnt(0)" ::: "memory"); ATT_SBAR();
#endif
  ATT_QEARLY(kb, 3);
  { auto rr = __builtin_amdgcn_permlane32_swap(__float_as_uint(ps), __float_as_uint(ps), false, false);
    ps = __uint_as_float(rr[0]) + __uint_as_float(rr[1]); }
  l_reg = l_reg * alpha + ps;
  ATT_PK4(p0, 0, pa0); ATT_PK4(p0, 8, pa1);
  asm volatile("" : "+v"(l_reg), "+v"(pa0), "+v"(pa1));
  ATT_QMM(ka, 2);
  asm volatile("s_waitcnt lgkmcnt(0)" ::: "memory"); ATT_SBAR();
  ATT_PK4(p1, 0, pa2); ATT_PK4(p1, 8, pa3);
  asm volatile("" : "+v"(pa2), "+v"(pa3));
  ATT_QMM(kb, 3);
#undef ATT_PK4
#undef ATT_QRD
#undef ATT_QMM
#undef ATT_QEARLY
#undef ATT_QNEXT
}
template <class CF> __device__ __forceinline__ void qk_sm1(f32x16& n0, f32x16& n1, const char* Ks, const bf16x8* qr, const char* qx, int r32, int hi,
                                                           f32x16& p0, f32x16& p1, float alpha, float& l_reg, bf16x8& pa0, bf16x8& pa1, bf16x8& pa2, bf16x8& pa3) {
  static_assert(CF::ND0 == 12, "qk_sm1: 12 d0 steps");
  n0 = f32x16{}; n1 = f32x16{};
  const char* kr = Ks + r32 * CF::KPITCH; const int sw = (r32 & CF::KSWM) << 4;
  bf16x8 kf[2][2], qf[2];
#define ATT_QRD(b, d0) do { const int cb = ((d0) * 16 + hi * 8) * 2; kf[b][0] = *reinterpret_cast<const bf16x8*>(kr + (cb ^ sw)); kf[b][1] = *reinterpret_cast<const bf16x8*>(kr + 32 * CF::KPITCH + (cb ^ sw)); \
    if ((d0) >= CF::NQR) qf[b] = *reinterpret_cast<const bf16x8*>(qx + ((d0) - CF::NQR) * 1024); } while (0)
#define ATT_QMM(b, d0) do { const bf16x8 q_ = (d0) < CF::NQR ? qr[(d0) < CF::NQR ? (d0) : 0] : qf[b]; n0 = __builtin_amdgcn_mfma_f32_32x32x16_bf16(kf[b][0], q_, n0, 0, 0, 0); n1 = __builtin_amdgcn_mfma_f32_32x32x16_bf16(kf[b][1], q_, n1, 0, 0, 0); } while (0)
#define ATT_PK4(P, BASE, OUT) do { unsigned a0 = cvtpk(P[BASE + 0], P[BASE + 1]), a1 = cvtpk(P[BASE + 2], P[BASE + 3]);   \
    unsigned b0 = cvtpk(P[BASE + 4], P[BASE + 5]), b1 = cvtpk(P[BASE + 6], P[BASE + 7]);                              \
    auto r0 = __builtin_amdgcn_permlane32_swap(a0, b0, false, false); auto r1 = __builtin_amdgcn_permlane32_swap(a1, b1, false, false); \
    u32x4 w = {r0[0], r1[0], r0[1], r1[1]}; OUT = *reinterpret_cast<bf16x8*>(&w); } while (0)
  ATT_QRD(0, 0); asm volatile("s_waitcnt lgkmcnt(0)" ::: "memory"); ATT_SBAR();
  float ps = 0;
#pragma unroll
  for (int g = 0; g < 12; ++g) {
    if (g + 1 < 12) ATT_QRD((g + 1) & 1, g + 1);
    if (g < 2) {
#pragma unroll
      for (int r = 0; r < 8; ++r) p1[8 * g + r] = __builtin_amdgcn_exp2f(p1[8 * g + r]);
      if (g == 1) asm volatile("" : "+v"(p1)); }
    else if (g < 6) {
#pragma unroll
      for (int r = 0; r < 8; ++r) ps += (g < 4 ? p0[8 * (g - 2) + r] : p1[8 * (g - 4) + r]);
      asm volatile("" : "+v"(ps)); }
    else if (g == 6) {
      { auto rr = __builtin_amdgcn_permlane32_swap(__float_as_uint(ps), __float_as_uint(ps), false, false);
        ps = __uint_as_float(rr[0]) + __uint_as_float(rr[1]); }
      l_reg = l_reg * alpha + ps;
      ATT_PK4(p0, 0, pa0);
      asm volatile("" : "+v"(l_reg), "+v"(pa0)); }
    else if (g == 7) { ATT_PK4(p0, 8, pa1); asm volatile("" : "+v"(pa1)); }
    else if (g == 8) { ATT_PK4(p1, 0, pa2); asm volatile("" : "+v"(pa2)); }
    else if (g == 9) { ATT_PK4(p1, 8, pa3); asm volatile("" : "+v"(pa3)); }
    ATT_QMM(g & 1, g);
    if (g + 1 < 12) { asm volatile("s_waitcnt lgkmcnt(0)" ::: "memory"); ATT_SBAR(); }
  }
#undef ATT_PK4
#undef ATT_QRD
#undef ATT_QMM
}
template <int D0> __device__ __forceinline__ void pv_reads(int vb, s16x4 (&f)[8]) {
  f[0] = tr_read<v_rd_off(D0, 0, 0)>(vb); f[1] = tr_read<v_rd_off(D0, 0, 1)>(vb); f[2] = tr_read<v_rd_off(D0, 1, 0)>(vb); f[3] = tr_read<v_rd_off(D0, 1, 1)>(vb);
  f[4] = tr_read<v_rd_off(D0, 2, 0)>(vb); f[5] = tr_read<v_rd_off(D0, 2, 1)>(vb); f[6] = tr_read<v_rd_off(D0, 3, 0)>(vb); f[7] = tr_read<v_rd_off(D0, 3, 1)>(vb);
  asm volatile("s_waitcnt lgkmcnt(0)" ::: "memory"); ATT_SBAR();
}
__device__ __forceinline__ void pv_mfma4(f32x16& od, const s16x4 (&f)[8], bf16x8 pa0, bf16x8 pa1, bf16x8 pa2, bf16x8 pa3) {
#define ATT_PK(L, H) (bf16x8){L[0], L[1], L[2], L[3], H[0], H[1], H[2], H[3]}
  od = __builtin_amdgcn_mfma_f32_32x32x16_bf16(pa0, ATT_PK(f[0], f[1]), od, 0, 0, 0);
  od = __builtin_amdgcn_mfma_f32_32x32x16_bf16(pa1, ATT_PK(f[2], f[3]), od, 0, 0, 0);
  od = __builtin_amdgcn_mfma_f32_32x32x16_bf16(pa2, ATT_PK(f[4], f[5]), od, 0, 0, 0);
  od = __builtin_amdgcn_mfma_f32_32x32x16_bf16(pa3, ATT_PK(f[6], f[7]), od, 0, 0, 0);
#undef ATT_PK
}
template <class CF> __device__ __forceinline__ void pv_sm(f32x16* o, int vb, bf16x8 pa0, bf16x8 pa1, bf16x8 pa2, bf16x8 pa3, f32x16& p0, f32x16& p1, float& m_reg, float& mn, float& alpha) {
  constexpr float C = CF::SCALE * 1.4426950408889634f;
  s16x4 f[8];
  pv_reads<0>(vb, f);
  float pmax = p0[0];
#pragma unroll
  for (int r = 1; r < 16; ++r) pmax = fmaxf(pmax, p0[r]);
  asm volatile("" : "+v"(pmax));
  pv_mfma4(o[0], f, pa0, pa1, pa2, pa3);
  pv_reads<1>(vb, f);
#pragma unroll
  for (int r = 0; r < 16; ++r) pmax = fmaxf(pmax, p1[r]);
  { auto rr = __builtin_amdgcn_permlane32_swap(__float_as_uint(pmax), __float_as_uint(pmax), false, false);
    pmax = fmaxf(__uint_as_float(rr[0]), __uint_as_float(rr[1])); }
  asm volatile("" : "+v"(pmax));
  pv_mfma4(o[1], f, pa0, pa1, pa2, pa3);
  pv_reads<2>(vb, f);
  if (__builtin_expect(__all(pmax - m_reg <= THR / CF::SCALE), 1)) { mn = m_reg; alpha = 1.f; }
  else { mn = fmaxf(m_reg, pmax); alpha = __builtin_amdgcn_exp2f((m_reg - mn) * C); m_reg = mn; }
  const float mnC = -mn * C;
#pragma unroll
  for (int r = 0; r < 16; ++r) p0[r] = fmaf(p0[r], C, mnC);
#pragma unroll
  for (int r = 0; r < 16; ++r) p1[r] = fmaf(p1[r], C, mnC);
  asm volatile("" : "+v"(p0), "+v"(p1));
  pv_mfma4(o[2], f, pa0, pa1, pa2, pa3);
  pv_reads<3>(vb, f);
#pragma unroll
  for (int r = 0; r < 16; ++r) p0[r] = __builtin_amdgcn_exp2f(p0[r]);
  asm volatile("" : "+v"(p0));
  pv_mfma4(o[3], f, pa0, pa1, pa2, pa3);
}

struct Unit {
  const bf16_t* Q;
  const bf16_t* K;
  const bf16_t* V;
  bf16_t* O;
  float* LSE;
  int ldq, ldk, ldv, ldo, ldl;
  int nt;
  int qoff;
};

template <class CF, bool MASK, bool WLSE, int LDQ_ = 0, int LDK_ = 0, int LDV_ = 0, int LDO_ = 0>
__device__ __forceinline__ void attn_unit(const Unit& a, char* lds, const int tid) {
  const int ldq = LDQ_ ? LDQ_ : a.ldq, ldk = LDK_ ? LDK_ : a.ldk, ldv = LDV_ ? LDV_ : a.ldv, ldo = LDO_ ? LDO_ : a.ldo;
  constexpr int SDEPTH = CF::SDEPTH, ND0 = CF::ND0, SHM_V = CF::SHM_V, SHM_K = CF::SHM_K;
  constexpr bool QK1 = ATT_B_QK1 && CF::ND0 == 12 && !MASK;
  constexpr bool QKSPLIT = ATT_QKSPLIT && CF::ND0 == 8 && !MASK;
  const int wid = tid >> 6, lane = tid & 63, r32 = lane & 31, hi = lane >> 5;
  char* V_lds = lds; char* K_lds = lds + 2 * SHM_V;
  float* ws = (float*)(lds + CF::WS_OFF) + wid * 64; float* li_l = ws; float* al_l = ws + 32;
  float m_reg = -1e30f, l_reg = 0; f32x16 o[4] = {}; bf16x8 qr[8];
  const bf16_t* Qw = a.Q + (long)(wid * QBLK + r32) * ldq + hi * 8;
#pragma unroll
  for (int d0 = 0; d0 < CF::NQR; ++d0) qr[d0] = ld8(Qw + d0 * 16);
  char* const qx = lds + CF::QX_OFF + wid * CF::QXW + lane * 16;
  if constexpr (ND0 > 8) {
#pragma unroll
    for (int d0 = CF::NQR; d0 < ND0; ++d0) *(bf16x8*)(qx + (d0 - CF::NQR) * 1024) = ld8(Qw + d0 * 16);
  }
  const int sr = tid >> 4, sc = (tid & 15) * 8, vst0 = v_st(sr, sc), vst1 = v_st(32 + sr, sc);
  const int kst0 = sr * CF::KPITCH + ((sc * 2) ^ ((sr & CF::KSWM) << 4)), kst1 = kst0 + 32 * CF::KPITCH;
  const int kr2 = tid >> 3, kst2 = kr2 * CF::KPITCH + ((256 + (tid & 7) * 16) ^ ((kr2 & 7) << 4));
  const bf16_t* const Vg = a.V; const bf16_t* const Kg = a.K;
  const int voff0 = sr * ldv + sc, koff0 = sr * ldk + sc, koff2 = kr2 * ldk + 128 + (tid & 7) * 8;
  const int vb0 = (int)(uintptr_t)V_lds + v_rd_base(lane);
  struct { bf16x8 vs0, vs1, ks0, ks1, ks2; } sr_[SDEPTH];
#define ATT_SLOAD(i, k0) do { const bf16_t* vt_ = Vg + (long)(k0) * ldv; const bf16_t* kt_ = Kg + (long)(k0) * ldk; \
    sr_[i].vs0 = ld8(vt_ + voff0); sr_[i].vs1 = ld8(vt_ + 32 * ldv + voff0); \
    sr_[i].ks0 = ld8(kt_ + koff0); sr_[i].ks1 = ld8(kt_ + 32 * ldk + koff0); if constexpr (ND0 == 12) sr_[i].ks2 = ld8(kt_ + koff2); } while (0)
#define ATT_SWRITE(b, i) do { *(bf16x8*)(V_lds + (b) * SHM_V + vst0) = sr_[i].vs0; *(bf16x8*)(V_lds + (b) * SHM_V + vst1) = sr_[i].vs1; \
    *(bf16x8*)(K_lds + (b) * SHM_K + kst0) = sr_[i].ks0; *(bf16x8*)(K_lds + (b) * SHM_K + kst1) = sr_[i].ks1; if constexpr (ND0 == 12) *(bf16x8*)(K_lds + (b) * SHM_K + kst2) = sr_[i].ks2; } while (0)
#define ATT_SWAIT() do { if constexpr (SDEPTH == 2) { if constexpr (ND0 == 12) asm volatile("s_waitcnt vmcnt(5)" ::: "memory"); else asm volatile("s_waitcnt vmcnt(4)" ::: "memory"); } else asm volatile("s_waitcnt vmcnt(0)" ::: "memory"); } while (0)
#define ATT_RESC(al) do { if (__any((al) < 1.f)) { if (hi == 0) al_l[r32] = (al); asm volatile("s_waitcnt lgkmcnt(0)" ::: "memory"); \
    _Pragma("unroll") for (int d = 0; d < 4; ++d) _Pragma("unroll") for (int r = 0; r < 16; ++r) o[d][r] *= al_l[crow(r, hi)]; } } while (0)
  f32x16 pA0, pA1, pB0, pB1; float mnA, mnB, alA, alB; bf16x8 pa0, pa1, pa2, pa3; const int NT = a.nt;
  const int qi = a.qoff + wid * QBLK + r32;
  constexpr int SE = 0, SO = SDEPTH - 1;
  ATT_SLOAD(SE, 0); asm volatile("s_waitcnt vmcnt(0)" ::: "memory"); ATT_SWRITE(0, SE); ATT_SYNC();
  qkt<CF>(pA0, pA1, K_lds, qr, qx, r32, hi); if constexpr (MASK) bandmask(pA0, pA1, 0, qi, hi); partialSM<CF>(pA0, pA1, m_reg, mnA, alA);
  ATT_SLOAD(SO, KVBLK); if constexpr (SDEPTH == 2) { if (2 < NT) ATT_SLOAD(SE, 2 * KVBLK); }
  ATT_SWAIT(); ATT_SWRITE(1, SO); ATT_SYNC();
  for (int j = 1; j + 1 < NT; j += 2) {
    ATT_SBAR(); if constexpr (QKSPLIT) qk_sm<CF>(pB0, pB1, K_lds + SHM_K, qr, r32, hi, pA0, pA1, alA, l_reg, pa0, pa1, pa2, pa3);
    else if constexpr (QK1) qk_sm1<CF>(pB0, pB1, K_lds + SHM_K, qr, qx, r32, hi, pA0, pA1, alA, l_reg, pa0, pa1, pa2, pa3);
    else { qkt<CF>(pB0, pB1, K_lds + SHM_K, qr, qx, r32, hi); if constexpr (MASK) bandmask(pB0, pB1, j * KVBLK, qi, hi);
    finishSM(pA0, pA1, alA, l_reg, pa0, pa1, pa2, pa3); } ATT_SBAR();
    ATT_SLOAD(SO, (j + SDEPTH) * KVBLK); ATT_SBAR();
    PV_SM(o, vb0, pa0, pa1, pa2, pa3, pB0, pB1, m_reg, mnB, alB);
    ATT_SYNC(); ATT_SWAIT(); ATT_SWRITE(0, SE);
    ATT_RESC(alB); ATT_SYNC();
    ATT_SBAR(); if constexpr (QKSPLIT) qk_sm<CF>(pA0, pA1, K_lds, qr, r32, hi, pB0, pB1, alB, l_reg, pa0, pa1, pa2, pa3);
    else if constexpr (QK1) qk_sm1<CF>(pA0, pA1, K_lds, qr, qx, r32, hi, pB0, pB1, alB, l_reg, pa0, pa1, pa2, pa3);
    else { qkt<CF>(pA0, pA1, K_lds, qr, qx, r32, hi); if constexpr (MASK) bandmask(pA0, pA1, (j + 1) * KVBLK, qi, hi);
    finishSM(pB0, pB1, alB, l_reg, pa0, pa1, pa2, pa3); } ATT_SBAR();
    if (SDEPTH == 1 || j + 3 < NT) ATT_SLOAD(SE, (j + 1 + SDEPTH) * KVBLK); ATT_SBAR();
    PV_SM(o, vb0 + SHM_V, pa0, pa1, pa2, pa3, pA0, pA1, m_reg, mnA, alA);
    ATT_SYNC(); ATT_SWAIT(); ATT_SWRITE(1, SO);
    ATT_RESC(alA); ATT_SYNC();
  }
  ATT_SBAR(); if constexpr (QKSPLIT) qk_sm<CF>(pB0, pB1, K_lds + SHM_K, qr, r32, hi, pA0, pA1, alA, l_reg, pa0, pa1, pa2, pa3);
  else if constexpr (QK1) qk_sm1<CF>(pB0, pB1, K_lds + SHM_K, qr, qx, r32, hi, pA0, pA1, alA, l_reg, pa0, pa1, pa2, pa3);
  else { qkt<CF>(pB0, pB1, K_lds + SHM_K, qr, qx, r32, hi); if constexpr (MASK) bandmask(pB0, pB1, (NT - 1) * KVBLK, qi, hi);
  finishSM(pA0, pA1, alA, l_reg, pa0, pa1, pa2, pa3); } ATT_SBAR();
  PV_SM(o, vb0, pa0, pa1, pa2, pa3, pB0, pB1, m_reg, mnB, alB);
  ATT_SYNC(); ATT_RESC(alB);
  finishSM(pB0, pB1, alB, l_reg, pa0, pa1, pa2, pa3); ATT_SBAR();
  pv_d0(o, vb0 + SHM_V, pa0, pa1, pa2, pa3);
  int lane_e; asm volatile("v_mbcnt_lo_u32_b32 %0, -1, 0\n\tv_mbcnt_hi_u32_b32 %0, -1, %0" : "=v"(lane_e));
  const int r32e = lane_e & 31, hie = lane_e >> 5;
  if (hie == 0) li_l[r32e] = l_reg; asm volatile("s_waitcnt lgkmcnt(0)" ::: "memory");
  float rli[16];
#pragma unroll
  for (int r = 0; r < 16; ++r) rli[r] = __builtin_amdgcn_rcpf(li_l[crow(r, hie)]);
  if constexpr (WLSE) { if (hie == 0) a.LSE[(long)(wid * QBLK + r32e) * a.ldl] = m_reg * CF::SCALE + __logf(l_reg); }
#ifdef ATT_EPI_DIRECT
  { bf16_t* Ow = a.O + (long)(wid * QBLK) * ldo;
#pragma unroll
  for (int r = 0; r < 16; ++r) { const int orow = crow(r, hi);
#pragma unroll
    for (int d0 = 0; d0 < 4; ++d0) Ow[(long)orow * ldo + d0 * 32 + r32] = (unsigned short)cvtpk(o[d0][r] * rli[r], 0.f); } }
  ATT_SYNC();
#else
  ATT_SYNC();
  char* Ost = lds + wid * CF::OST_WAVE;
#pragma unroll
  for (int r = 0; r < 16; ++r) { const int orow = crow(r, hie);
#pragma unroll
    for (int d0 = 0; d0 < 4; ++d0) { const float v = o[d0][r] * rli[r]; *(unsigned short*)(Ost + orow * CF::OST_PITCH + (d0 * 32 + r32e) * 2) = (unsigned short)cvtpk(v, v); } }
  asm volatile("s_waitcnt lgkmcnt(0)" ::: "memory");
  bf16_t* Ow = a.O + (long)(wid * QBLK) * ldo;
#pragma unroll
  for (int i = 0; i < 8; ++i) { const int c = lane_e + 64 * i, row = c >> 4, ch = c & 15;
    const u32x4 v = *(const u32x4*)(Ost + row * CF::OST_PITCH + ch * 16); *(u32x4*)(Ow + (long)row * ldo + ch * 8) = v; }
  asm volatile("s_waitcnt lgkmcnt(0)" ::: "memory");
  ATT_SYNC();
#endif
#undef ATT_SLOAD
#undef ATT_SWRITE
#undef ATT_SWAIT
#undef ATT_RESC
}

template <class CF, bool MASK, bool WLSE, int LDQ_ = 0, int LDK_ = 0, int LDV_ = 0, int LDO_ = 0>
__device__ __forceinline__ void attn_unit3(const Unit& a, char* lds, const int tid) {
  const int ldq = LDQ_ ? LDQ_ : a.ldq, ldk = LDK_ ? LDK_ : a.ldk, ldv = LDV_ ? LDV_ : a.ldv, ldo = LDO_ ? LDO_ : a.ldo;
  constexpr int ND0 = CF::ND0, SHM_V = CF::SHM_V, SHM_K = CF::SHM_K;
  const int wid = tid >> 6, lane = tid & 63, r32 = lane & 31, hi = lane >> 5;
  char* V_lds = lds; char* K_lds = lds + 3 * SHM_V;
  float* ws = (float*)(lds + CF::WS3_OFF) + wid * 64; float* li_l = ws; float* al_l = ws + 32;
  float m_reg = -1e30f, l_reg = 0; f32x16 o[4] = {}; bf16x8 qr[8];
  const bf16_t* Qw = a.Q + (long)(wid * QBLK + r32) * ldq + hi * 8;
#pragma unroll
  for (int d0 = 0; d0 < 8; ++d0) qr[d0] = ld8(Qw + d0 * 16);
  char* const qx = lds + CF::QX3_OFF + wid * 4096 + lane * 16;
  if constexpr (ND0 > 8) {
#pragma unroll
    for (int d0 = 8; d0 < ND0; ++d0) *(bf16x8*)(qx + (d0 - 8) * 1024) = ld8(Qw + d0 * 16);
  }
  const int sr = tid >> 4, sc = (tid & 15) * 8, vst0 = v_st(sr, sc), vst1 = v_st(32 + sr, sc);
  const int kst0 = sr * CF::KPITCH + ((sc * 2) ^ ((sr & CF::KSWM) << 4)), kst1 = kst0 + 32 * CF::KPITCH;
  const int kr2 = tid >> 3, kst2 = kr2 * CF::KPITCH + ((256 + (tid & 7) * 16) ^ ((kr2 & 7) << 4));
  const bf16_t* const Vg = a.V; const bf16_t* const Kg = a.K;
  const int voff0 = sr * ldv + sc, koff0 = sr * ldk + sc, koff2 = kr2 * ldk + 128 + (tid & 7) * 8;
  const int vb0 = (int)(uintptr_t)V_lds + v_rd_base(lane);
  struct { bf16x8 vs0, vs1, ks0, ks1, ks2; } sr_[2];
#define ATT_SLOAD(i, k0) do { const bf16_t* vt_ = Vg + (long)(k0) * ldv; const bf16_t* kt_ = Kg + (long)(k0) * ldk; \
    sr_[i].vs0 = ld8(vt_ + voff0); sr_[i].vs1 = ld8(vt_ + 32 * ldv + voff0); \
    sr_[i].ks0 = ld8(kt_ + koff0); sr_[i].ks1 = ld8(kt_ + 32 * ldk + koff0); if constexpr (ND0 == 12) sr_[i].ks2 = ld8(kt_ + koff2); } while (0)
#define ATT_SWRITE(b, i) do { *(bf16x8*)(V_lds + (b) * SHM_V + vst0) = sr_[i].vs0; *(bf16x8*)(V_lds + (b) * SHM_V + vst1) = sr_[i].vs1; \
    *(bf16x8*)(K_lds + (b) * SHM_K + kst0) = sr_[i].ks0; *(bf16x8*)(K_lds + (b) * SHM_K + kst1) = sr_[i].ks1; if constexpr (ND0 == 12) *(bf16x8*)(K_lds + (b) * SHM_K + kst2) = sr_[i].ks2; } while (0)
#define ATT_SWAIT() do { if constexpr (ND0 == 12) asm volatile("s_waitcnt vmcnt(5)" ::: "memory"); else asm volatile("s_waitcnt vmcnt(4)" ::: "memory"); } while (0)
#define ATT_RESC(al) do { if (__any((al) < 1.f)) { if (hi == 0) al_l[r32] = (al); asm volatile("s_waitcnt lgkmcnt(0)" ::: "memory"); \
    _Pragma("unroll") for (int d = 0; d < 4; ++d) _Pragma("unroll") for (int r = 0; r < 16; ++r) o[d][r] *= al_l[crow(r, hi)]; } } while (0)
#define ATT_ROT() do { prv = cur; cur = nxt; nxt = (nxt == 2) ? 0 : nxt + 1; } while (0)
  f32x16 pA0, pA1, pB0, pB1; float mnA, mnB, alA, alB; bf16x8 pa0, pa1, pa2, pa3; const int NT = a.nt;
  const int qi = a.qoff + wid * QBLK + r32;
  int prv = 2, cur = 0, nxt = 1;
  ATT_SLOAD(0, 0); ATT_SLOAD(1, KVBLK); asm volatile("s_waitcnt vmcnt(0)" ::: "memory"); ATT_SWRITE(0, 0); ATT_SWRITE(1, 1);
  if (2 < NT) ATT_SLOAD(0, 2 * KVBLK); if (3 < NT) ATT_SLOAD(1, 3 * KVBLK);
  asm volatile("s_waitcnt lgkmcnt(0)" ::: "memory"); ATT_SYNC();
  qkt<CF>(pA0, pA1, K_lds, qr, qx, r32, hi); if constexpr (MASK) bandmask(pA0, pA1, 0, qi, hi); partialSM<CF>(pA0, pA1, m_reg, mnA, alA);
  ATT_ROT();
  for (int j = 1; j + 1 < NT; j += 2) {
    asm volatile("s_waitcnt lgkmcnt(0)" ::: "memory"); ATT_SYNC();
    ATT_SWAIT(); ATT_SWRITE(nxt, 0); if (j + 3 < NT) ATT_SLOAD(0, (j + 3) * KVBLK);
    ATT_SBAR(); qkt<CF>(pB0, pB1, K_lds + cur * SHM_K, qr, qx, r32, hi); if constexpr (MASK) bandmask(pB0, pB1, j * KVBLK, qi, hi);
    finishSM(pA0, pA1, alA, l_reg, pa0, pa1, pa2, pa3); ATT_SBAR();
    pv_d0(o, vb0 + prv * SHM_V, pa0, pa1, pa2, pa3); partialSM<CF>(pB0, pB1, m_reg, mnB, alB);
    ATT_RESC(alB); ATT_ROT();
    asm volatile("s_waitcnt lgkmcnt(0)" ::: "memory"); ATT_SYNC();
    ATT_SWAIT(); ATT_SWRITE(nxt, 1); if (j + 4 < NT) ATT_SLOAD(1, (j + 4) * KVBLK);
    ATT_SBAR(); qkt<CF>(pA0, pA1, K_lds + cur * SHM_K, qr, qx, r32, hi); if constexpr (MASK) bandmask(pA0, pA1, (j + 1) * KVBLK, qi, hi);
    finishSM(pB0, pB1, alB, l_reg, pa0, pa1, pa2, pa3); ATT_SBAR();
    pv_d0(o, vb0 + prv * SHM_V, pa0, pa1, pa2, pa3); partialSM<CF>(pA0, pA1, m_reg, mnA, alA);
    ATT_RESC(alA); ATT_ROT();
  }
  asm volatile("s_waitcnt lgkmcnt(0)" ::: "memory"); ATT_SYNC();
  ATT_SBAR(); qkt<CF>(pB0, pB1, K_lds + cur * SHM_K, qr, qx, r32, hi); if constexpr (MASK) bandmask(pB0, pB1, (NT - 1) * KVBLK, qi, hi);
  finishSM(pA0, pA1, alA, l_reg, pa0, pa1, pa2, pa3); ATT_SBAR();
  pv_d0(o, vb0 + prv * SHM_V, pa0, pa1, pa2, pa3); partialSM<CF>(pB0, pB1, m_reg, mnB, alB);
  ATT_RESC(alB);
  finishSM(pB0, pB1, alB, l_reg, pa0, pa1, pa2, pa3); ATT_SBAR();
  pv_d0(o, vb0 + cur * SHM_V, pa0, pa1, pa2, pa3);
  if (hi == 0) li_l[r32] = l_reg; asm volatile("s_waitcnt lgkmcnt(0)" ::: "memory");
  float rli[16];
#pragma unroll
  for (int r = 0; r < 16; ++r) rli[r] = __builtin_amdgcn_rcpf(li_l[crow(r, hi)]);
  if constexpr (WLSE) { if (hi == 0) a.LSE[(long)(wid * QBLK + r32) * a.ldl] = m_reg * CF::SCALE + __logf(l_reg); }
  ATT_SYNC();
  char* Ost = lds + wid * CF::OST_WAVE;
#pragma unroll
  for (int r = 0; r < 16; ++r) { const int orow = crow(r, hi);
#pragma unroll
    for (int d0 = 0; d0 < 4; ++d0) { const float v = o[d0][r] * rli[r]; *(unsigned short*)(Ost + orow * CF::OST_PITCH + (d0 * 32 + r32) * 2) = (unsigned short)cvtpk(v, v); } }
  asm volatile("s_waitcnt lgkmcnt(0)" ::: "memory");
  bf16_t* Ow = a.O + (long)(wid * QBLK) * ldo;
#pragma unroll
  for (int i = 0; i < 8; ++i) { const int c = lane + 64 * i, row = c >> 4, ch = c & 15;
    const u32x4 v = *(const u32x4*)(Ost + row * CF::OST_PITCH + ch * 16); *(u32x4*)(Ow + (long)row * ldo + ch * 8) = v; }
  asm volatile("s_waitcnt lgkmcnt(0)" ::: "memory");
  ATT_SYNC();
#undef ATT_SLOAD
#undef ATT_SWRITE
#undef ATT_SWAIT
#undef ATT_RESC
#undef ATT_ROT
}
}
__device__ const float RF64_HI[32] = {1.591549367e-01f, 1.193493679e-01f, 8.949939907e-02f, 6.711508334e-02f, 5.032921210e-02f, 3.774158657e-02f, 2.830219641e-02f, 2.122365311e-02f, 1.591549441e-02f, 1.193493698e-02f, 8.949940093e-03f, 6.711508147e-03f, 5.032921210e-03f, 3.774158424e-03f, 2.830219688e-03f, 2.122365171e-03f, 1.591549488e-03f, 1.193493721e-03f, 8.949940093e-04f, 6.711508031e-04f, 5.032921326e-04f, 3.774158540e-04f, 2.830219455e-04f, 2.122365258e-04f, 1.591549371e-04f, 1.193493736e-04f, 8.949940093e-05f, 6.711508468e-05f, 5.032921035e-05f, 3.774158540e-05f, 2.830219637e-05f, 2.122365186e-05f};
__device__ const float RF64_LO[32] = {6.420638243e-09f, 2.294664903e-09f, 2.542919653e-09f, -3.316028840e-10f, 5.173299289e-12f, -1.848551645e-09f, -5.826552019e-10f, -3.431038786e-10f, -1.029942243e-10f, 4.320196978e-11f, 6.802745173e-11f, 1.531042237e-10f, 5.173301024e-13f, 4.797548470e-11f, -1.048316434e-10f, 1.053879969e-10f, -5.686555046e-11f, -1.896286773e-11f, 6.802744999e-12f, 2.695195456e-11f, -1.158979943e-11f, -6.843983713e-12f, 1.279990003e-11f, 1.807650600e-12f, 5.954976963e-12f, -3.351478166e-12f, 6.802745216e-13f, -1.670379113e-12f, 1.751403167e-12f, -6.843983930e-13f, -5.389994549e-13f, 9.083608431e-13f};
__device__ const float RF32_HI[16] = {1.591549367e-01f, 7.008652389e-02f, 3.086376376e-02f, 1.359137055e-02f, 5.985185504e-03f, 2.635675948e-03f, 1.160663669e-03f, 5.111175124e-04f, 2.250790858e-04f, 9.911730740e-05f, 4.364795313e-05f, 1.922110096e-05f, 8.464330676e-06f, 3.727408512e-06f, 1.641426252e-06f, 7.228293271e-07f};
__device__ const float RF32_LO[16] = {6.420638243e-09f, -2.302696700e-09f, -3.597993847e-10f, 9.086624508e-11f, 2.087540557e-10f, -4.944578774e-11f, -2.775752544e-11f, -7.822671330e-12f, -6.755001072e-12f, 1.969154007e-12f, -3.416928741e-13f, -2.712567042e-13f, 1.318804142e-13f, 9.029300745e-14f, 1.098673646e-14f, -2.017673985e-14f};
constexpr int DM = 2048, DFF = 8192, DEPTH = 4, PLED = 256;
constexpr int NTOK = 65536, NPROMPT = 32768, SEQ_P = 4096, SEQ_S = 8192;
constexpr int CT = 32768, NCH = NTOK / CT;
constexpr float EPS = 1e-6f;
constexpr int NWAVES = 8;
enum { I_XP = 0, I_XS, I_PP, I_PS, I_NMIX, I_NMLP, I_WIN, I_WOUT, I_WPLE, I_PLEG, I_GATEG, I_WGATE,
       I_AQKV, I_AQG, I_AKG, I_AO, I_BDQ, I_BCQG, I_BCKVG, I_BUQ, I_BUKV, I_BQG, I_BKG, I_BO, I_CQKV, I_CQG, I_CKG, I_CO, N_IN };
constexpr size_t SZ_IN = (size_t)DFF * DM, SZ_OUT = (size_t)DM * DFF, SZ_PLE = (size_t)DM * PLED, SZ_GATE = (size_t)DM * DM;
constexpr size_t SZ_AQKV = (size_t)3072 * DM, SZ_AO = (size_t)DM * DM;
constexpr size_t SZ_BDQ = (size_t)1280 * DM, SZ_BUQ = (size_t)3072 * 512, SZ_BUKV = (size_t)4096 * 512, SZ_BO = (size_t)DM * DM;
constexpr size_t SZ_CQKV = (size_t)9216 * DM, SZ_CO = (size_t)DM * 1024;
constexpr size_t OFF_IN = 0, OFF_OUT = OFF_IN + 4 * SZ_IN, OFF_PLE = OFF_OUT + 4 * SZ_OUT, OFF_GATE = OFF_PLE + 4 * SZ_PLE;
constexpr size_t OFF_AQKV = OFF_GATE + 4 * SZ_GATE, OFF_AO = OFF_AQKV + 2 * SZ_AQKV;
constexpr size_t OFF_BDQ = OFF_AO + 2 * SZ_AO, OFF_BUQ = OFF_BDQ + SZ_BDQ, OFF_BUKV = OFF_BUQ + SZ_BUQ, OFF_BO = OFF_BUKV + SZ_BUKV;
constexpr size_t OFF_CQKV = OFF_BO + SZ_BO, OFF_CO = OFF_CQKV + SZ_CQKV, WT_TOTAL = OFF_CO + SZ_CO;
constexpr size_t MiB = 1u << 20;
constexpr size_t WS_CTL = 0, CTL_ZERO_BYTES = 1 * MiB;
constexpr size_t WS_T64 = 1 * MiB;
constexpr size_t WS_T32 = 3 * MiB;
constexpr size_t WS_RSTD = 4 * MiB;
constexpr size_t WS_LSE = 5 * MiB;
constexpr size_t WS_RS = 4 * MiB + 512 * 1024;
constexpr size_t WS_SSP = 8 * MiB;
constexpr size_t WS_SSPE = 12 * MiB;
constexpr size_t WS_WT = 16 * MiB;
constexpr size_t WS_H = WS_WT + ((WT_TOTAL * 2 + MiB - 1) / MiB) * MiB;
constexpr size_t WS_PB = WS_H + (size_t)CT * DM * 2;
constexpr size_t WS_E0 = WS_PB + (size_t)CT * PLED * 2;
constexpr size_t WS_BIG = WS_E0 + (size_t)CT * DM * 2;
constexpr size_t CTB = (size_t)CT * 2;
constexpr size_t B_HID = 0;
constexpr size_t A_QKV = 0, A_O = A_QKV + CTB * 3072;
constexpr size_t BB_LAT = 0, BB_CQ = BB_LAT + CTB * 1280, BB_CKV = BB_CQ + CTB * 512, BB_QB = BB_CKV + CTB * 512, BB_KVB = BB_QB + CTB * 3072, BB_KF = BB_KVB + CTB * 4096, BB_END = BB_KF + CTB * 3072;
constexpr size_t BB_O = 0;
static_assert(CTB * 2048 <= BB_QB, "O overlay");
constexpr size_t C_QKV = 0, C_OG = C_QKV + CTB * 9216, C_END = C_OG + 3 * CTB * 1024;
constexpr size_t BIG_BYTES = BB_END > CTB * 8192 ? (BB_END > C_END ? BB_END : C_END) : (CTB * 8192 > C_END ? CTB * 8192 : C_END);
constexpr size_t WS_END = WS_BIG + BIG_BYTES;

constexpr int CW_BAR = 4096;
constexpr int RING_BYTES = 131072, LDSCTL_OFF = RING_BYTES, MISC_OFF = LDSCTL_OFF + 320, LDS_BYTES = 147456;
constexpr int QKP_OFF = RING_BYTES + 1024;
static_assert(QKP_OFF + 8192 <= LDS_BYTES && MISC_OFF + 128 <= QKP_OFF, "LDS map");

#define GAS __attribute__((address_space(1)))
#define LAS __attribute__((address_space(3)))
typedef unsigned short bf16;
typedef unsigned v4u __attribute__((ext_vector_type(4)));
typedef unsigned v2u __attribute__((ext_vector_type(2)));
typedef float f32x4 __attribute__((ext_vector_type(4)));
typedef float f32x2 __attribute__((ext_vector_type(2)));
#define LDS_WAIT() asm volatile("s_waitcnt lgkmcnt(0)" ::: "memory")
#define VM_WAIT() asm volatile("s_waitcnt vmcnt(0)" ::: "memory")
__device__ __forceinline__ unsigned pk2(float lo, float hi) { unsigned r; asm volatile("v_cvt_pk_bf16_f32 %0, %1, %2" : "=v"(r) : "v"(lo), "v"(hi)); return r; }
__device__ __forceinline__ float bflo(unsigned w) { return __uint_as_float(w << 16); }
__device__ __forceinline__ float bfhi(unsigned w) { return __uint_as_float(w & 0xffff0000u); }

#define XB_TMO      128
#define XB_XCNT(j)  (256  + 64 * (j))
#define XB_XSUB(j)  (1280 + 64 * (j))
#define XB_XGEN(j)  (2304 + 64 * (j))
#define XB_TOP      3328
#define XB_TOPGEN   3392
#define XCD_BAR_WORDS 3456
#define XB_SPIN_CAP (1u << 18)
__device__ __forceinline__ unsigned xb_ld(unsigned* p)              { return __hip_atomic_load(p, __ATOMIC_RELAXED, __HIP_MEMORY_SCOPE_AGENT); }
__device__ __forceinline__ unsigned xb_add(unsigned* p, unsigned v) { return __hip_atomic_fetch_add(p, v, __ATOMIC_RELAXED, __HIP_MEMORY_SCOPE_AGENT); }
__device__ __forceinline__ unsigned xb_xcc_id() { return (unsigned)__builtin_amdgcn_s_getreg((3 << 11) | 20) & 0xFu; }
#define XB_SPIN(cond, bar) do { unsigned _sp = 0; while (cond) { __builtin_amdgcn_s_sleep(1); \
    if ((++_sp & 255u) == 0u) { if (xb_ld(&(bar)[XB_TMO])) break; if (_sp > XB_SPIN_CAP) { atomicAdd(&(bar)[XB_TMO], 1u); break; } } } } while (0)
struct XcdBarrier { unsigned* bar; unsigned x; volatile LAS unsigned* st; };
__device__ __forceinline__ XcdBarrier xcd_barrier_post(unsigned* bar, volatile LAS unsigned* st) {
    XcdBarrier b; b.bar = bar; b.x = xb_xcc_id(); b.st = st;
    if (threadIdx.x == 0) (void)xb_add(&bar[XB_XCNT(b.x)], 1u);
    return b;
}
__device__ __forceinline__ void xcd_barrier_complete(unsigned* bar, unsigned x, unsigned& nloc, unsigned& nx) {
    const unsigned G = gridDim.x * gridDim.y * gridDim.z;
    unsigned sum, cnt, mine, sp = 0u;
    for (;;) {
        sum = 0u; cnt = 0u; mine = 0u;
#pragma unroll
        for (unsigned j = 0; j < 16; ++j) { const unsigned c = xb_ld(&bar[XB_XCNT(j)]); sum += c; cnt += (c > 0u) ? 1u : 0u; mine = (j == x) ? c : mine; }
        if (sum == G) break;
        __builtin_amdgcn_s_sleep(1);
        if ((++sp & 255u) == 0u) { if (xb_ld(&bar[XB_TMO])) break; if (sp > XB_SPIN_CAP) { atomicAdd(&bar[XB_TMO], 1u); break; } }
    }
    nloc = mine > 0u ? mine : 1u; nx = cnt > 0u ? cnt : 1u;
}
__device__ __forceinline__ void xcd_barrier(const XcdBarrier& b) {
    asm volatile("s_waitcnt vmcnt(0)" ::: "memory");
    __syncthreads();
    if (threadIdx.x == 0) {
        unsigned* bar = b.bar; asm volatile("" : "+s"(bar));
        __builtin_amdgcn_s_waitcnt(0);
        unsigned bx_ = xb_xcc_id(); asm volatile("" : "+s"(bx_));
        unsigned nloc = b.st[0], nx = b.st[1];
        if (nloc == 0u) { xcd_barrier_complete(bar, bx_, nloc, nx); b.st[0] = nloc; b.st[1] = nx; }
        const unsigned old = xb_add(&bar[XB_XSUB(bx_)], 1u);
        const unsigned gen = old / nloc;
        if (old + 1u == (gen + 1u) * nloc) {
            __builtin_amdgcn_fence(__ATOMIC_RELEASE, "agent");
            asm volatile("s_waitcnt vmcnt(0)" ::: "memory");
            const unsigned og = xb_add(&bar[XB_TOP], 1u);
            const unsigned tg = og / nx;
            if (og + 1u == (tg + 1u) * nx) xb_add(&bar[XB_TOPGEN], 1u);
            else XB_SPIN(xb_ld(&bar[XB_TOPGEN]) == tg, bar);
            __builtin_amdgcn_fence(__ATOMIC_ACQUIRE, "agent");
            xb_add(&bar[XB_XGEN(bx_)], 1u);
            asm volatile("s_waitcnt vmcnt(0)" ::: "memory");
        } else {
            XB_SPIN(xb_ld(&bar[XB_XGEN(bx_)]) == gen, bar);
            __builtin_amdgcn_fence(__ATOMIC_ACQUIRE, "agent");
            asm volatile("s_waitcnt vmcnt(0)" ::: "memory");
        }
    }
    __syncthreads();
}

__device__ __forceinline__ float shx(float v, int lane, int o) { return __int_as_float(__builtin_amdgcn_ds_bpermute((lane ^ o) << 2, __float_as_int(v))); }
__device__ __forceinline__ float wave_sum(float v, int lane) {
#pragma unroll
    for (int o = 1; o < 64; o <<= 1) v += shx(v, lane, o);
    return v;
}
__device__ __forceinline__ float sum16(float v, int lane) {
#pragma unroll
    for (int o = 1; o < 16; o <<= 1) v += shx(v, lane, o);
    return v;
}
__device__ __forceinline__ void unpack8(const v4u w, float (&f)[8]) { f[0] = bflo(w.x); f[1] = bfhi(w.x); f[2] = bflo(w.y); f[3] = bfhi(w.y); f[4] = bflo(w.z); f[5] = bfhi(w.z); f[6] = bflo(w.w); f[7] = bfhi(w.w); }
__device__ __forceinline__ v4u pack8(const float (&f)[8]) { v4u w; w.x = pk2(f[0], f[1]); w.y = pk2(f[2], f[3]); w.z = pk2(f[4], f[5]); w.w = pk2(f[6], f[7]); return w; }

__device__ __forceinline__ int qk_phys_col(int c, int pmode) {
    if (pmode == 1 && c < 2560) { const int d = c & 127, half = d >> 6, r = d & 63, member = r >> 5, j = r & 31, w = half * 2 + (j >> 4), jj = j & 15; return (c & ~127) + w * 32 + (jj >> 2) * 8 + (jj & 3) * 2 + member; }
    if (pmode == 2 && c < 6144) { const int d = c & 127; if (d < 32) { const int member = d >> 4, j = d & 15; return (c & ~127) + (j >> 2) * 8 + (j & 3) * 2 + member; } }
    return c;
}
__device__ __forceinline__ void p0_transpose_item(const float* W, const float* gk, int K, int N, bf16* WT, LAS float* scr, int item, int lane, int pmode) {
    const int nblk = N / 32, kb = item / nblk, nb = item % nblk, k0 = 64 * kb, n0 = 32 * nb;
    const float* wp = W + (size_t)(k0 + (lane >> 5)) * N + n0 + (lane & 31);
    float wv[32];
#pragma unroll
    for (int i = 0; i < 32; ++i) wv[i] = wp[(size_t)(2 * i) * N];
#pragma unroll
    for (int i = 0; i < 32; ++i) scr[(2 * i + (lane >> 5)) * 33 + (lane & 31)] = wv[i];
    LDS_WAIT(); asm volatile("" ::: "memory");
    const int c = lane & 7;
    f32x4 g0 = {1.f, 1.f, 1.f, 1.f}, g1 = {1.f, 1.f, 1.f, 1.f};
    if (gk) { g0 = *(const f32x4*)(gk + k0 + 8 * c); g1 = *(const f32x4*)(gk + k0 + 8 * c + 4); }
#pragma unroll
    for (int j = 0; j < 4; ++j) { const int n = (lane >> 3) + 8 * j; const LAS float* s = scr + (8 * c) * 33 + n;
        v4u o; o.x = pk2(s[0 * 33] * g0[0], s[1 * 33] * g0[1]); o.y = pk2(s[2 * 33] * g0[2], s[3 * 33] * g0[3]); o.z = pk2(s[4 * 33] * g1[0], s[5 * 33] * g1[1]); o.w = pk2(s[6 * 33] * g1[2], s[7 * 33] * g1[3]);
        *(GAS v4u*)(WT + (size_t)qk_phys_col(n0 + n, pmode) * K + k0 + 8 * c) = o; }
    LDS_WAIT(); asm volatile("" ::: "memory");
}

__device__ __forceinline__ void norm_rows(const float* __restrict__ src, float* __restrict__ cpy, bf16* __restrict__ H, const float* __restrict__ g,
                                          const bf16* __restrict__ e0, float* __restrict__ rs_out, int nrows, int gw, int NGW, int lane) {
    f32x4 gv[8];
#pragma unroll
    for (int j = 0; j < 8; ++j) gv[j] = ((const f32x4*)g)[lane + 64 * j];
    for (int m = gw; m < nrows; m += NGW) {
        const f32x4* xr = (const f32x4*)(src + (size_t)m * DM) + lane;
        f32x4 v[8]; float s = 0.f;
#pragma unroll
        for (int j = 0; j < 8; ++j) { v[j] = xr[64 * j]; s += (v[j].x * v[j].x + v[j].y * v[j].y) + (v[j].z * v[j].z + v[j].w * v[j].w); }
        if (cpy) { f32x4* cr = (f32x4*)(cpy + (size_t)m * DM) + lane;
#pragma unroll
            for (int j = 0; j < 8; ++j) cr[64 * j] = v[j]; }
        const float rstd = __builtin_amdgcn_rsqf(wave_sum(s, lane) * (1.f / DM) + EPS);
        v2u* o8 = (v2u*)(H + (size_t)m * DM) + lane;
#pragma unroll
        for (int j = 0; j < 8; ++j) { const f32x4 y = v[j] * rstd * gv[j]; v2u w; w.x = pk2(y.x, y.y); w.y = pk2(y.z, y.w); o8[64 * j] = w; }
        if (e0) {
            const v4u* er = (const v4u*)(e0 + (size_t)m * DM) + lane; float q = 0.f;
#pragma unroll
            for (int j = 0; j < 4; ++j) { float f[8]; unpack8(er[64 * j], f);
#pragma unroll
                for (int t = 0; t < 8; ++t) q += f[t] * f[t]; }
            q = wave_sum(q, lane);
            if (lane == 0) rs_out[m] = __builtin_amdgcn_rsqf(q * (1.f / DM) + EPS);
        }
    }
}

__device__ __forceinline__ void init_rows(const float* __restrict__ src, bf16* __restrict__ XB, float* __restrict__ rs, int nrows, int gw, int NGW, int lane) {
    for (int m = gw; m < nrows; m += NGW) {
        const f32x4* xr = (const f32x4*)(src + (size_t)m * DM) + lane; v2u* o8 = (v2u*)(XB + (size_t)m * DM) + lane;
        f32x4 v[8]; float s = 0.f;
#pragma unroll
        for (int j = 0; j < 8; ++j) v[j] = xr[64 * j];
#pragma unroll
        for (int j = 0; j < 8; ++j) { s += (v[j].x * v[j].x + v[j].y * v[j].y) + (v[j].z * v[j].z + v[j].w * v[j].w); v2u w; w.x = pk2(v[j].x, v[j].y); w.y = pk2(v[j].z, v[j].w); o8[64 * j] = w; }
        s = wave_sum(s, lane);
        if (lane == 0) rs[m] = __builtin_amdgcn_rsqf(s * (1.f / DM) + EPS);
    }
}
__device__ __forceinline__ void rs_rows(const float* __restrict__ ssp, float* __restrict__ rs, const float* __restrict__ ssp2, float* __restrict__ rs2, int nrows, int gw, int NGW, int lane) {
    constexpr int NB = 8;
    for (int p0 = gw; p0 < nrows / 2; p0 += NGW * NB) {
        float v[NB], w[NB];
#pragma unroll
        for (int b = 0; b < NB; ++b) { const int p = p0 + b * NGW; v[b] = 0.f; w[b] = 0.f; if (p < nrows / 2) { const size_t o = (size_t)(2 * p + (lane >> 5)) * 32 + (lane & 31); v[b] = ssp[o]; if (ssp2) w[b] = ssp2[o]; } }
#pragma unroll
        for (int b = 0; b < NB; ++b) { const int p = p0 + b * NGW; if (p < nrows / 2) { const int row = 2 * p + (lane >> 5); float a = v[b], c = w[b];
#pragma unroll
            for (int o = 1; o < 32; o <<= 1) { a += shx(a, lane, o); if (ssp2) c += shx(c, lane, o); }
            if ((lane & 31) == 0) { rs[row] = __builtin_amdgcn_rsqf(a * (1.f / DM) + EPS); if (ssp2) rs2[row] = __builtin_amdgcn_rsqf(c * (1.f / DM) + EPS); } } }
    }
}
constexpr int RB = 4;
__device__ __forceinline__ void a_qknorm_rope(bf16* __restrict__ qkv, const float* __restrict__ qg, const float* __restrict__ kg, const f32x2* __restrict__ T64, int seqmask, int gw, int NGW, int lane) {
    const int q16 = lane & 15, sub = lane >> 4; const bool first = (q16 & 4) == 0;
    const f32x4 gq0 = *(const f32x4*)(qg + q16 * 8), gq1 = *(const f32x4*)(qg + q16 * 8 + 4), gk0 = *(const f32x4*)(kg + q16 * 8), gk1 = *(const f32x4*)(kg + q16 * 8 + 4);
    for (int it0 = gw; it0 < CT * 5; it0 += NGW * RB) {
        v4u raw[RB]; f32x4 cs[RB][4]; bf16* p[RB]; bool isq[RB];
#pragma unroll
        for (int b = 0; b < RB; ++b) { const int it = it0 + b * NGW; if (it < CT * 5) { const int tl = it / 5, quad = it % 5, hv = quad * 4 + sub; isq[b] = hv < 16;
            p[b] = qkv + (size_t)tl * 3072 + (hv < 16 ? hv * 128 : 2048 + (hv - 16) * 128) + q16 * 8; raw[b] = *(const v4u*)p[b];
            const int t = tl & seqmask, pos = (q16 < 8) ? (t >> 6) : (t & 63); const f32x4* c4 = (const f32x4*)(T64 + (size_t)pos * 32 + (q16 & 3) * 8);
#pragma unroll
            for (int e = 0; e < 4; ++e) cs[b][e] = c4[e]; } }
#pragma unroll
        for (int b = 0; b < RB; ++b) { const int it = it0 + b * NGW; if (it < CT * 5) {
            float f[8]; unpack8(raw[b], f); float s = 0.f;
#pragma unroll
            for (int t = 0; t < 8; ++t) s += f[t] * f[t];
            const float rstd = __builtin_amdgcn_rsqf(sum16(s, lane) * (1.f / 128.f) + EPS);
            const f32x4 g0 = isq[b] ? gq0 : gk0, g1 = isq[b] ? gq1 : gk1; float y[8], o[8];
#pragma unroll
            for (int t = 0; t < 4; ++t) { y[t] = f[t] * rstd * g0[t]; y[4 + t] = f[4 + t] * rstd * g1[t]; }
#pragma unroll
            for (int e = 0; e < 8; ++e) { const float other = shx(y[e], lane, 4); const float c = cs[b][e >> 1][(e & 1) * 2], sn = cs[b][e >> 1][(e & 1) * 2 + 1];
                o[e] = first ? (y[e] * c - other * sn) : (y[e] * c + other * sn); }
            *(v4u*)p[b] = pack8(o); } }
    }
}
__device__ __forceinline__ void b_latnorm(const bf16* __restrict__ lat, bf16* __restrict__ cq, bf16* __restrict__ ckv, const float* __restrict__ cqg, const float* __restrict__ ckvg, int gw, int NGW, int lane) {
    const f32x4 ga0 = *(const f32x4*)(cqg + lane * 8), ga1 = *(const f32x4*)(cqg + lane * 8 + 4), gb0 = *(const f32x4*)(ckvg + lane * 8), gb1 = *(const f32x4*)(ckvg + lane * 8 + 4);
    for (int it0 = gw; it0 < CT * 2; it0 += NGW * RB) {
        v4u raw[RB];
#pragma unroll
        for (int b = 0; b < RB; ++b) { const int it = it0 + b * NGW; if (it < CT * 2) raw[b] = *(const v4u*)(lat + (size_t)(it >> 1) * 1280 + (it & 1) * 512 + lane * 8); }
#pragma unroll
        for (int b = 0; b < RB; ++b) { const int it = it0 + b * NGW; if (it < CT * 2) { const int tl = it >> 1, which = it & 1;
            float f[8]; unpack8(raw[b], f); float s = 0.f;
#pragma unroll
            for (int t = 0; t < 8; ++t) s += f[t] * f[t];
            const float rstd = __builtin_amdgcn_rsqf(wave_sum(s, lane) * (1.f / 512.f) + EPS);
            const f32x4 g0 = which ? gb0 : ga0, g1 = which ? gb1 : ga1; float y[8];
#pragma unroll
            for (int t = 0; t < 4; ++t) { y[t] = f[t] * rstd * g0[t]; y[4 + t] = f[4 + t] * rstd * g1[t]; }
            *(v4u*)((which ? ckv : cq) + (size_t)tl * 512 + lane * 8) = pack8(y); } }
    }
}
__device__ __forceinline__ void b_qknorm_rope(bf16* __restrict__ qb, const bf16* __restrict__ kvb, const bf16* __restrict__ lat, bf16* __restrict__ kf, const float* __restrict__ qg, const float* __restrict__ kg,
                                              const f32x2* __restrict__ T64, int seqmask, int gw, int NGW, int lane) {
    const int q16 = lane & 15, sub = lane >> 4; const bool first = (q16 & 8) == 0;
    const f32x4 gq0 = *(const f32x4*)(qg + q16 * 8), gq1 = *(const f32x4*)(qg + q16 * 8 + 4), gq2 = *(const f32x4*)(qg + 128 + q16 * 4);
    const f32x4 gk0 = *(const f32x4*)(kg + q16 * 8), gk1 = *(const f32x4*)(kg + q16 * 8 + 4), gk2 = *(const f32x4*)(kg + 128 + q16 * 4);
    for (int it0 = gw; it0 < CT * 8; it0 += NGW * RB) {
        v4u rawn[RB]; v2u rawr[RB]; f32x4 cs[RB][2];
#pragma unroll
        for (int b = 0; b < RB; ++b) { const int it = it0 + b * NGW; if (it < CT * 8) { const int tl = it >> 3, isk = (it >> 2) & 1, h = (it & 3) * 4 + sub;
            rawn[b] = *(const v4u*)(isk ? (kvb + (size_t)tl * 4096 + h * 256 + q16 * 8) : (qb + (size_t)tl * 3072 + h * 192 + q16 * 8));
            rawr[b] = *(const v2u*)(isk ? (lat + (size_t)tl * 1280 + 1024 + q16 * 4) : (qb + (size_t)tl * 3072 + h * 192 + 128 + q16 * 4));
            const f32x4* c4 = (const f32x4*)(T64 + (size_t)(tl & seqmask) * 32 + (q16 & 7) * 4); cs[b][0] = c4[0]; cs[b][1] = c4[1]; } }
#pragma unroll
        for (int b = 0; b < RB; ++b) { const int it = it0 + b * NGW; if (it < CT * 8) { const int tl = it >> 3, isk = (it >> 2) & 1, h = (it & 3) * 4 + sub;
            bf16* on = (isk ? kf : qb) + (size_t)tl * 3072 + h * 192 + q16 * 8; bf16* orp = (isk ? kf : qb) + (size_t)tl * 3072 + h * 192 + 128 + q16 * 4;
            float f[8]; unpack8(rawn[b], f); float r[4] = {bflo(rawr[b].x), bfhi(rawr[b].x), bflo(rawr[b].y), bfhi(rawr[b].y)};
            float s = 0.f;
#pragma unroll
            for (int t = 0; t < 8; ++t) s += f[t] * f[t];
#pragma unroll
            for (int t = 0; t < 4; ++t) s += r[t] * r[t];
            const float rstd = __builtin_amdgcn_rsqf(sum16(s, lane) * (1.f / 192.f) + EPS);
            const f32x4 g0 = isk ? gk0 : gq0, g1 = isk ? gk1 : gq1, g2 = isk ? gk2 : gq2; float y[8], yr[4], o[4];
#pragma unroll
            for (int t = 0; t < 4; ++t) { y[t] = f[t] * rstd * g0[t]; y[4 + t] = f[4 + t] * rstd * g1[t]; yr[t] = r[t] * rstd * g2[t]; }
#pragma unroll
            for (int e = 0; e < 4; ++e) { const float other = shx(yr[e], lane, 8); const float c = cs[b][e >> 1][(e & 1) * 2], sn = cs[b][e >> 1][(e & 1) * 2 + 1];
                o[e] = first ? (yr[e] * c - other * sn) : (yr[e] * c + other * sn); }
            *(v4u*)on = pack8(y); v2u ow; ow.x = pk2(o[0], o[1]); ow.y = pk2(o[2], o[3]); *(v2u*)orp = ow; } }
    }
}
__device__ __forceinline__ void c_qknorm_rope(bf16* __restrict__ qkv, const float* __restrict__ qg, const float* __restrict__ kg, const f32x2* __restrict__ T32, int seqmask, int gw, int NGW, int lane) {
    const int q16 = lane & 15, sub = lane >> 4; const bool first = (q16 & 2) == 0, roped = q16 < 4;
    const f32x4 gq0 = *(const f32x4*)(qg + q16 * 8), gq1 = *(const f32x4*)(qg + q16 * 8 + 4), gk0 = *(const f32x4*)(kg + q16 * 8), gk1 = *(const f32x4*)(kg + q16 * 8 + 4);
    for (int it0 = gw; it0 < CT * 12; it0 += NGW * RB) {
        v4u raw[RB]; f32x4 cs[RB][4]; bf16* p[RB]; bool isq[RB];
#pragma unroll
        for (int b = 0; b < RB; ++b) { const int it = it0 + b * NGW; if (it < CT * 12) { const int tl = it / 12, quad = it % 12, hv = quad * 4 + sub; isq[b] = hv < 24;
            p[b] = qkv + (size_t)tl * 9216 + hv * 128 + q16 * 8; raw[b] = *(const v4u*)p[b];
            const f32x4* c4 = (const f32x4*)(T32 + (size_t)(tl & seqmask) * 16 + (q16 & 1) * 8);
#pragma unroll
            for (int e = 0; e < 4; ++e) cs[b][e] = c4[e]; } }
#pragma unroll
        for (int b = 0; b < RB; ++b) { const int it = it0 + b * NGW; if (it < CT * 12) {
            float f[8]; unpack8(raw[b], f); float s = 0.f;
#pragma unroll
            for (int t = 0; t < 8; ++t) s += f[t] * f[t];
            const float rstd = __builtin_amdgcn_rsqf(sum16(s, lane) * (1.f / 128.f) + EPS);
            const f32x4 g0 = isq[b] ? gq0 : gk0, g1 = isq[b] ? gq1 : gk1; float y[8], o[8];
#pragma unroll
            for (int t = 0; t < 4; ++t) { y[t] = f[t] * rstd * g0[t]; y[4 + t] = f[4 + t] * rstd * g1[t]; }
#pragma unroll
            for (int e = 0; e < 8; ++e) { const float other = shx(y[e], lane, 2); const float c = cs[b][e >> 1][(e & 1) * 2], sn = cs[b][e >> 1][(e & 1) * 2 + 1];
                const float rv = first ? (y[e] * c - other * sn) : (y[e] * c + other * sn); o[e] = roped ? rv : y[e]; }
            *(v4u*)p[b] = pack8(o); } }
    }
}
__device__ __forceinline__ void c_merge(const bf16* __restrict__ og, const float* __restrict__ lse, bf16* __restrict__ mrg, int gw, int NGW, int lane) {
    const int q16 = lane & 15, sub = lane >> 4;
    for (int it0 = gw; it0 < CT * 2; it0 += NGW * RB) {
        v4u ra[RB], rb[RB], rc[RB]; float l0[RB], l1[RB], l2[RB];
#pragma unroll
        for (int b = 0; b < RB; ++b) { const int it = it0 + b * NGW; if (it < CT * 2) { const int tl = it >> 1, h = (it & 1) * 4 + sub; const size_t off = (size_t)tl * 1024 + h * 128 + q16 * 8;
            l0[b] = lse[(size_t)tl * 8 + h]; l1[b] = lse[(size_t)CT * 8 + (size_t)tl * 8 + h]; l2[b] = lse[(size_t)2 * CT * 8 + (size_t)tl * 8 + h];
            ra[b] = *(const v4u*)(og + off); rb[b] = *(const v4u*)(og + (size_t)CT * 1024 + off); rc[b] = *(const v4u*)(og + (size_t)2 * CT * 1024 + off); } }
#pragma unroll
        for (int b = 0; b < RB; ++b) { const int it = it0 + b * NGW; if (it < CT * 2) { const int tl = it >> 1, h = (it & 1) * 4 + sub; const size_t off = (size_t)tl * 1024 + h * 128 + q16 * 8;
            const float mx = fmaxf(l0[b], fmaxf(l1[b], l2[b]));
            float w0 = __expf(l0[b] - mx), w1 = __expf(l1[b] - mx), w2 = __expf(l2[b] - mx); const float inv = 1.f / (w0 + w1 + w2); w0 *= inv; w1 *= inv; w2 *= inv;
            float a[8], bb[8], c[8], o[8]; unpack8(ra[b], a); unpack8(rb[b], bb); unpack8(rc[b], c);
#pragma unroll
            for (int e = 0; e < 8; ++e) o[e] = w0 * a[e] + w1 * bb[e] + w2 * c[e];
            *(v4u*)(mrg + off) = pack8(o); } }
    }
}
#ifndef ONLY
#define ONLY -1
#endif
#define PH(k) (ONLY < 0 || ONLY == (k))
#ifndef QKFUSE
#define QKFUSE 1
#endif
#ifndef ATT_PRIO
#define ATT_PRIO 1
#endif
#ifndef TS_MASK
#define TS_MASK 0u
#endif
#ifndef TS_FACTOR
#define TS_FACTOR 1
#endif
__device__ __forceinline__ bool ts_thread0(int wave_u) { int l_; asm volatile("v_mbcnt_lo_u32_b32 %0, -1, 0\n\tv_mbcnt_hi_u32_b32 %0, -1, %0" : "=v"(l_)); return wave_u == 0 && l_ == 0; }
#ifndef REP_ATTA
#define REP_ATTA 1
#endif
#ifndef REP_ATTB
#define REP_ATTB 1
#endif
#ifndef REP_MLPIN
#define REP_MLPIN 1
#endif
#ifndef REP_NORM
#define REP_NORM 1
#endif
#ifndef REP_PRO
#define REP_PRO 1
#endif
#ifndef REP_ATTC
#define REP_ATTC 1
#endif
#ifndef REP_INIT
#define REP_INIT 1
#endif
#ifndef REP_PROJ
#define REP_PROJ 1
#endif
#ifndef REP_MLPOUTK
#define REP_MLPOUTK 1
#endif
struct Args { const float* in[N_IN]; float* out; unsigned char* ws; };
typedef att::Cfg<128, 2, 0> CfgA;
typedef att::Cfg<192, 1, 1> CfgB;
typedef att::Cfg<128, 2, 0> CfgC;
static_assert(CfgA::LDS_BYTES <= RING_BYTES && CfgB::QX_END <= RING_BYTES && (CfgB::WS_OFF == CfgB::QX_END || CfgB::WS_OFF >= QKP_OFF) && CfgB::LDS_BYTES <= LDS_BYTES && CfgA::LDS3_BYTES <= RING_BYTES, "attention LDS (the words between RING_BYTES and QKP_OFF are the kernel's barrier / control words)");
#ifndef ATT_A_FN
#define ATT_A_FN att::attn_unit
#endif
#ifndef ATT_C_FN
#define ATT_C_FN att::attn_unit
#endif

__device__ __forceinline__ void weight_desc(const Args& a, bf16* WT, int mi, const float*& src, const float*& gk, int& K, int& N, bf16*& dst, int& pmode) {
    gk = nullptr; pmode = 0;
    if (mi < 16) { const int l = mi >> 2, t = mi & 3;
        if (t == 0)      { src = a.in[I_WIN] + (size_t)l * SZ_IN;    K = DM;   N = DFF; dst = WT + OFF_IN + (size_t)l * SZ_IN; gk = a.in[I_NMLP] + l * DM; }
        else if (t == 1) { src = a.in[I_WOUT] + (size_t)l * SZ_OUT;  K = DFF;  N = DM;  dst = WT + OFF_OUT + (size_t)l * SZ_OUT; }
        else if (t == 2) { src = a.in[I_WPLE] + (size_t)l * SZ_PLE;  K = PLED; N = DM;  dst = WT + OFF_PLE + (size_t)l * SZ_PLE; }
        else             { src = a.in[I_WGATE] + (size_t)l * SZ_GATE; K = DM;  N = DM;  dst = WT + OFF_GATE + (size_t)l * SZ_GATE; gk = a.in[I_GATEG] + l * DM; }
    } else if (mi < 20) { const int j = (mi - 16) >> 1, t = mi & 1;
        if (t == 0) { src = a.in[I_AQKV] + (size_t)j * SZ_AQKV; K = DM; N = 3072; dst = WT + OFF_AQKV + (size_t)j * SZ_AQKV; gk = a.in[I_NMIX] + (3 * j) * DM; pmode = QKFUSE ? 1 : 0; }
        else        { src = a.in[I_AO] + (size_t)j * SZ_AO;     K = DM; N = DM;   dst = WT + OFF_AO + (size_t)j * SZ_AO; }
    } else if (mi == 20) { src = a.in[I_BDQ];  K = DM;   N = 1088; dst = WT + OFF_BDQ; gk = a.in[I_NMIX] + 1 * DM; }
    else if (mi == 21)   { src = a.in[I_BUQ];  K = 512;  N = 3072; dst = WT + OFF_BUQ; }
    else if (mi == 22)   { src = a.in[I_BUKV]; K = 512;  N = 4096; dst = WT + OFF_BUKV; }
    else if (mi == 23)   { src = a.in[I_BO];   K = DM;   N = DM;   dst = WT + OFF_BO; }
    else if (mi == 24)   { src = a.in[I_CQKV]; K = DM;   N = 9216; dst = WT + OFF_CQKV; gk = a.in[I_NMIX] + 2 * DM; pmode = QKFUSE ? 2 : 0; }
    else                 { src = a.in[I_CO];   K = 1024; N = DM;   dst = WT + OFF_CO; }
}
__device__ __forceinline__ void rope_entry(float pos, float fh, float fl, f32x2* out) {
    const float hi = pos * fh, err = fmaf(pos, fh, -hi);
    const float fr = (hi - rintf(hi)) + (err + pos * fl);
    f32x2 r; r.x = __builtin_amdgcn_cosf(fr); r.y = __builtin_amdgcn_sinf(fr); *out = r;
}

#define PHASE_VARS() int tid, zi = 0; asm volatile("v_mbcnt_lo_u32_b32 %0, -1, 0\n\tv_mbcnt_hi_u32_b32 %0, -1, %0" : "=v"(tid), "+s"(zi)); tid += wave_u * 64; \
    const int lane = tid & 63, wave = __builtin_amdgcn_readfirstlane(tid >> 6); \
    const int G = (int)gridDim.x + zi, bx = (int)blockIdx.x + zi; const bool g8 = (G % 8) == 0; \
    const int x8 = g8 ? bx % 8 : 0, r8 = g8 ? bx / 8 : bx, G8 = g8 ? G / 8 : G; const int vcu = g8 ? x8 * G8 + r8 : bx; \
    const int gw = vcu * NWAVES + wave, NGW = G * NWAVES; unsigned char* const ws = args.ws + zi; \
    (void)lane; (void)gw; (void)NGW; (void)x8; (void)r8; (void)G8; (void)ws
#define INP(i) (args.in[(i) + zi])
#ifndef STAG_TICKS
#define STAG_TICKS 0
#endif
#ifndef STAG2_TICKS
#define STAG2_TICKS 0
#endif
#define STAGGER2(ticks) do { if ((ticks) > 0 && (x8 & 4)) { const unsigned long long t0_ = __builtin_amdgcn_s_memrealtime(); while (__builtin_amdgcn_s_memrealtime() - t0_ < (unsigned long long)(ticks)) __builtin_amdgcn_s_sleep(16); } } while (0)
#define STAGGER(ticks) do { if ((ticks) > 0) { const unsigned long long t0_ = __builtin_amdgcn_s_memrealtime(), tw_ = (unsigned long long)(x8 * (ticks)); while (__builtin_amdgcn_s_memrealtime() - t0_ < tw_) __builtin_amdgcn_s_sleep(16); } } while (0)
#define GEMM_PHASE(EPI, Aptr, Wptr, Mv, Nv, Kv, ...) do { pg8::Gemm g_{(Aptr), (Wptr), (Mv), (Nv), (Kv)}; pg8::StaticOrder S_; S_.init((Mv), (Nv), G, bx); \
    EPI E_{__VA_ARGS__}; pg8::gemm_phase<EPI, pg8::StaticOrder, true, true>(lds, g_, S_, E_, tid); } while (0)

__global__ void __launch_bounds__(NWAVES * 64, 2) mk_fwd(Args args) {
    extern __shared__ __attribute__((aligned(16))) unsigned char lds_raw[];
    LAS unsigned char* const lds = (LAS unsigned char*)lds_raw;
    const int wave_u = __builtin_amdgcn_readfirstlane((int)threadIdx.x >> 6);
    volatile LAS unsigned* MISC = (volatile LAS unsigned*)(lds + MISC_OFF);
    for (int u = threadIdx.x; u < (LDS_BYTES - LDSCTL_OFF) / 4; u += NWAVES * 64) ((LAS unsigned*)(lds + LDSCTL_OFF))[u] = 0u;
    __syncthreads();
    XcdBarrier bar = xcd_barrier_post((unsigned*)(args.ws + WS_CTL) + CW_BAR, MISC + 8);
    if (TS_MASK != 0u && ts_thread0(wave_u)) { const unsigned long long now_ = __builtin_amdgcn_s_memrealtime(); MISC[16] = (unsigned)now_; MISC[17] = (unsigned)(now_ >> 32); }
#define GRID_BAR(id) do { xcd_barrier(bar); if (TS_MASK != 0u && ts_thread0(wave_u)) { const unsigned long long now_ = __builtin_amdgcn_s_memrealtime(); \
    const unsigned long long last_ = ((unsigned long long)MISC[17] << 32) | MISC[16]; if ((TS_MASK >> (id)) & 1u) { const unsigned long long a_ = (((unsigned long long)MISC[19] << 32) | MISC[18]) + (now_ - last_); MISC[18] = (unsigned)a_; MISC[19] = (unsigned)(a_ >> 32); } \
    MISC[16] = (unsigned)now_; MISC[17] = (unsigned)(now_ >> 32); } } while (0)

    for (int rep_ = 0; rep_ < REP_PRO; ++rep_)
    {
        PHASE_VARS();
        bf16* const WT = (bf16*)(ws + WS_WT); f32x2* const T64 = (f32x2*)(ws + WS_T64); f32x2* const T32 = (f32x2*)(ws + WS_T32);
        LAS float* scr = (LAS float*)(lds + wave * 16384);
        int gbase = 0;
        for (int mi = 0; mi < 26; ++mi) {
            const float* src; const float* gk; int K, N, pmode; bf16* dst; weight_desc(args, WT, mi, src, gk, K, N, dst, pmode);
            const int items = (K / 64) * (N / 32); int first = (gw - gbase) % NGW; if (first < 0) first += NGW;
            for (int it = first; it < items; it += NGW) p0_transpose_item(src, gk, K, N, dst, scr, it, lane, pmode);
            gbase = (gbase + items) % NGW;
        }
        { v4u* z = (v4u*)(WT + OFF_BDQ + (size_t)1088 * DM); const int n16 = 192 * DM * 2 / 16; const v4u zero = {0u, 0u, 0u, 0u};
          for (int i = vcu * 512 + tid; i < n16; i += G * 512) z[i] = zero; }
        for (int i = vcu * 512 + tid; i < 8192 * 32; i += G * 512) { const int pos = i >> 5, j = i & 31; rope_entry((float)pos, RF64_HI[j], RF64_LO[j], T64 + i); }
        for (int i = vcu * 512 + tid; i < 8192 * 16; i += G * 512) { const int pos = i >> 4, j = i & 15; rope_entry((float)pos, RF32_HI[j], RF32_LO[j], T32 + i); }
    }
    GRID_BAR(0);

    typedef pg8::EpiBf16<0, true, false> EpiProj; typedef pg8::EpiBf16<0, false, false> EpiPlain; typedef pg8::EpiBf16<1, true, false> EpiMlp; typedef pg8::EpiBf16<0, false, true> EpiPle;
    typedef pg8::EpiResidT<false, false> EpiRes; typedef pg8::EpiResidT<true, false> EpiGate; typedef pg8::EpiResidT<true, true> EpiGateF;
    for (int c_ = 0; c_ < NCH; ++c_) {
#define CHUNK_VARS() const int c = c_ + zi; const size_t tok0 = (size_t)c * CT; const bool prompt = tok0 < (size_t)NPROMPT; \
    const int SEQ = prompt ? SEQ_P : SEQ_S, NQB = SEQ / 256; float* const X = args.out + tok0 * DM + zi; bf16* const WT = (bf16*)(ws + WS_WT); bf16* const XB = (bf16*)(ws + WS_H); \
    unsigned char* const BIG = ws + WS_BIG; bf16* const XBP = (bf16*)(ws + WS_E0); (void)XBP;     float* const SSP = (float*)(ws + WS_SSP); float* const RS = (float*)(ws + WS_RS); \
    (void)SEQ; (void)NQB; (void)X; (void)WT; (void)XB; (void)BIG; (void)prompt; (void)SSP; (void)RS
#define LAYER_VARS() const int layer = layer_ + zi; const int lj = layer / 3; (void)lj
        for (int rep_ = 0; rep_ < REP_INIT; ++rep_)
        { PHASE_VARS(); CHUNK_VARS();
          init_rows(prompt ? INP(I_XP) + tok0 * DM : INP(I_XS) + (tok0 - NPROMPT) * DM, XBP, RS, CT, gw, NGW, lane); }
        GRID_BAR(1);
        for (int layer_ = 0; layer_ < DEPTH; ++layer_) {
            if (layer_ > 0) {
            { PHASE_VARS(); CHUNK_VARS(); rs_rows(SSP, RS, nullptr, nullptr, CT, gw, NGW, lane); }
            GRID_BAR(2); }
            const int kind = layer_ % 3;
            if (kind == 0) {
#if QKFUSE
                { PHASE_VARS(); CHUNK_VARS(); LAYER_VARS(); GEMM_PHASE(pg8::EpiQK<1>, XBP, WT + OFF_AQKV + (size_t)lj * SZ_AQKV, CT, 3072, DM, (bf16*)(BIG + A_QKV), 3072, RS, INP(I_AQG) + lj * 128, INP(I_AKG) + lj * 128, (const f32x2*)(ws + WS_T64), SEQ - 1, (LAS float*)(lds + QKP_OFF), 8, 10); }
#else
                { PHASE_VARS(); CHUNK_VARS(); LAYER_VARS(); GEMM_PHASE(EpiProj, XBP, WT + OFF_AQKV + (size_t)lj * SZ_AQKV, CT, 3072, DM, (bf16*)(BIG + A_QKV), 3072, RS, nullptr); }
#endif
                GRID_BAR(3);
#if !QKFUSE
                { PHASE_VARS(); CHUNK_VARS(); LAYER_VARS(); a_qknorm_rope((bf16*)(BIG + A_QKV), INP(I_AQG) + lj * 128, INP(I_AKG) + lj * 128, (const f32x2*)(ws + WS_T64), SEQ - 1, gw, NGW, lane); }
                GRID_BAR(4);
#endif
                if (ATT_PRIO && wave_u >= 4) __builtin_amdgcn_s_setprio(3);
                for (int rep_ = 0; rep_ < REP_ATTA; ++rep_)
                { const int nu = ((CT / 256) * 16 + (int)gridDim.x - 1) / (int)gridDim.x;
                  for (int i = 0; i < nu; ++i) { PHASE_VARS(); CHUNK_VARS(); bf16* const QKV = (bf16*)(BIG + A_QKV); bf16* const OB = (bf16*)(BIG + A_O);
                      const int U8 = g8 ? (CT / 256) * 16 / 8 : (CT / 256) * 16, UPG = 4 * NQB; if (r8 + G8 * i >= U8) break;
                      const int u = x8 * U8 + r8 + G8 * i, grp = u / UPG, w = u % UPG, s = grp >> 2, kvh = grp & 3, h = kvh * 4 + w / NQB, qb = w % NQB;
                      const size_t t0 = (size_t)s * SEQ, tq = t0 + (size_t)qb * 256;
                      att::Unit un; un.Q = QKV + tq * 3072 + h * 128; un.K = QKV + t0 * 3072 + 2048 + kvh * 128; un.V = un.K + 512; un.O = OB + tq * DM + h * 128; un.LSE = nullptr;
                      un.ldq = 3072; un.ldk = 3072; un.ldv = 3072; un.ldo = DM; un.ldl = 0; un.nt = SEQ / 64; un.qoff = 0;
                      ATT_A_FN<CfgA, false, false, 3072, 3072, 3072, DM>(un, (char*)lds_raw, tid); } }
                if (ATT_PRIO) __builtin_amdgcn_s_setprio(0);
                GRID_BAR(5);
                { PHASE_VARS(); CHUNK_VARS(); LAYER_VARS(); STAGGER2(STAG2_TICKS); GEMM_PHASE(EpiRes, (bf16*)(BIG + A_O), WT + OFF_AO + (size_t)lj * SZ_AO, CT, DM, DM, XBP, nullptr, XB, SSP, DM, nullptr, nullptr, nullptr, nullptr); }
                GRID_BAR(6);
            } else if (kind == 1) {
#ifdef PROBE_PROJ
                { PHASE_VARS(); CHUNK_VARS(); GEMM_PHASE(EpiProj, XBP, WT + OFF_BDQ, CT, 1280, DM, (bf16*)(BIG + BB_LAT), 1280, RS, nullptr); }
#endif
                { PHASE_VARS(); CHUNK_VARS(); GEMM_PHASE(EpiProj, XBP, WT + OFF_BDQ, CT, 1280, DM, (bf16*)(BIG + BB_LAT), 1280, RS, nullptr); }
                GRID_BAR(3);
                { PHASE_VARS(); CHUNK_VARS(); b_latnorm((bf16*)(BIG + BB_LAT), (bf16*)(BIG + BB_CQ), (bf16*)(BIG + BB_CKV), INP(I_BCQG), INP(I_BCKVG), gw, NGW, lane); }
                GRID_BAR(4);
#ifdef PROBE_PROJ
                { PHASE_VARS(); CHUNK_VARS(); GEMM_PHASE(EpiPlain, (bf16*)(BIG + BB_CQ), WT + OFF_BUQ, CT, 3072, 512, (bf16*)(BIG + BB_QB), 3072, nullptr, nullptr); }
#endif
                { PHASE_VARS(); CHUNK_VARS(); GEMM_PHASE(EpiPlain, (bf16*)(BIG + BB_CQ), WT + OFF_BUQ, CT, 3072, 512, (bf16*)(BIG + BB_QB), 3072, nullptr, nullptr); }
#ifdef PROBE_PROJ
                { PHASE_VARS(); CHUNK_VARS(); GEMM_PHASE(EpiPlain, (bf16*)(BIG + BB_CKV), WT + OFF_BUKV, CT, 4096, 512, (bf16*)(BIG + BB_KVB), 4096, nullptr, nullptr); }
#endif
                { PHASE_VARS(); CHUNK_VARS(); GEMM_PHASE(EpiPlain, (bf16*)(BIG + BB_CKV), WT + OFF_BUKV, CT, 4096, 512, (bf16*)(BIG + BB_KVB), 4096, nullptr, nullptr); }
                GRID_BAR(11);
                { PHASE_VARS(); CHUNK_VARS(); b_qknorm_rope((bf16*)(BIG + BB_QB), (bf16*)(BIG + BB_KVB), (bf16*)(BIG + BB_LAT), (bf16*)(BIG + BB_KF), INP(I_BQG), INP(I_BKG), (const f32x2*)(ws + WS_T64), SEQ - 1, gw, NGW, lane); }
                GRID_BAR(4);
                if (ATT_PRIO && wave_u >= 4) __builtin_amdgcn_s_setprio(3);
                for (int rep_ = 0; rep_ < REP_ATTB; ++rep_)
                { const int nu = ((CT / 256) * 16 + (int)gridDim.x - 1) / (int)gridDim.x;
                  for (int i = 0; i < nu; ++i) { PHASE_VARS(); CHUNK_VARS(); bf16* const QB = (bf16*)(BIG + BB_QB); bf16* const KVB = (bf16*)(BIG + BB_KVB); bf16* const KF = (bf16*)(BIG + BB_KF); bf16* const OB = (bf16*)(BIG + BB_O);
                      const int U8 = g8 ? (CT / 256) * 16 / 8 : (CT / 256) * 16; if (r8 + G8 * i >= U8) break;
                      const int u = x8 * U8 + r8 + G8 * i, grp = u / NQB, qb = u % NQB, s = grp >> 4, h = grp & 15;
                      const size_t t0 = (size_t)s * SEQ, tq = t0 + (size_t)qb * 256;
                      att::Unit un; un.Q = QB + tq * 3072 + h * 192; un.K = KF + t0 * 3072 + h * 192; un.V = KVB + t0 * 4096 + h * 256 + 128; un.O = OB + tq * DM + h * 128; un.LSE = nullptr;
                      un.ldq = 3072; un.ldk = 3072; un.ldv = 4096; un.ldo = DM; un.ldl = 0; un.nt = SEQ / 64; un.qoff = 0;
                      att::attn_unit<CfgB, false, false, 3072, 3072, 4096, DM>(un, (char*)lds_raw, tid); } }
                if (ATT_PRIO) __builtin_amdgcn_s_setprio(0);
                GRID_BAR(5);
                { PHASE_VARS(); CHUNK_VARS(); STAGGER2(STAG2_TICKS); GEMM_PHASE(EpiRes, (bf16*)(BIG + BB_O), WT + OFF_BO, CT, DM, DM, XBP, nullptr, XB, SSP, DM, nullptr, nullptr, nullptr, nullptr); }
                GRID_BAR(6);
            } else {
#if QKFUSE
                { PHASE_VARS(); CHUNK_VARS(); GEMM_PHASE(pg8::EpiQK<2>, XBP, WT + OFF_CQKV, CT, 9216, DM, (bf16*)(BIG + C_QKV), 9216, RS, INP(I_CQG), INP(I_CKG), (const f32x2*)(ws + WS_T32), SEQ - 1, (LAS float*)(lds + QKP_OFF), 12, 24); }
#else
                { PHASE_VARS(); CHUNK_VARS(); GEMM_PHASE(EpiProj, XBP, WT + OFF_CQKV, CT, 9216, DM, (bf16*)(BIG + C_QKV), 9216, RS, nullptr); }
#endif
                GRID_BAR(3);
#if !QKFUSE
                { PHASE_VARS(); CHUNK_VARS(); c_qknorm_rope((bf16*)(BIG + C_QKV), INP(I_CQG), INP(I_CKG), (const f32x2*)(ws + WS_T32), SEQ - 1, gw, NGW, lane); }
                GRID_BAR(4);
#endif
                for (int rep_ = 0; rep_ < REP_ATTC; ++rep_)
                { const int nu = ((CT / 256) * 24 + (int)gridDim.x - 1) / (int)gridDim.x;
                  for (int i = 0; i < nu; ++i) { PHASE_VARS(); CHUNK_VARS(); bf16* const QKV = (bf16*)(BIG + C_QKV); bf16* const OG = (bf16*)(BIG + C_OG); float* const LSE = (float*)(ws + WS_LSE);
                      const int U8 = g8 ? (CT / 256) * 24 / 8 : (CT / 256) * 24; if (r8 + G8 * i >= U8) break;
                      const int u = x8 * U8 + r8 + G8 * i, grp = u / NQB, blk = u % NQB, s = grp / 24, gh = grp % 24, gi = gh >> 3, h = gh & 7;
                      const int dsh = 2 * gi, d = 1 << dsh, L = SEQ >> dsh, NB = L / 256, res = blk / NB, l0 = (blk % NB) * 256;
                      const int nt = L / 64 < 6 ? L / 64 : 6; int kw0 = l0 - 64; if (kw0 < 0) kw0 = 0; if (kw0 > L - 64 * nt) kw0 = L - 64 * nt;
                      const size_t t0 = (size_t)s * SEQ + res, tq = t0 + (size_t)d * l0, tk = t0 + (size_t)d * kw0;
                      att::Unit un; un.Q = QKV + tq * 9216 + gh * 128; un.K = QKV + tk * 9216 + 3072 + gh * 128; un.V = un.K + 3072; un.O = OG + (size_t)gi * CT * 1024 + tq * 1024 + h * 128;
                      un.LSE = LSE + (size_t)gi * CT * 8 + tq * 8 + h;
                      un.ldq = d * 9216; un.ldk = d * 9216; un.ldv = d * 9216; un.ldo = d * 1024; un.ldl = d * 8; un.nt = nt; un.qoff = l0 - kw0;
                      ATT_C_FN<CfgC, true, true>(un, (char*)lds_raw, tid); } }
                GRID_BAR(5);
                { PHASE_VARS(); CHUNK_VARS(); c_merge((bf16*)(BIG + C_OG), (float*)(ws + WS_LSE), (bf16*)(BIG + C_QKV), gw, NGW, lane); }
                GRID_BAR(4);
                { PHASE_VARS(); CHUNK_VARS(); STAGGER2(STAG2_TICKS); GEMM_PHASE(EpiRes, (bf16*)(BIG + C_QKV), WT + OFF_CO, CT, DM, 1024, XBP, nullptr, XB, SSP, DM, nullptr, nullptr, nullptr, nullptr); }
                GRID_BAR(6);
            }
            { PHASE_VARS(); CHUNK_VARS(); LAYER_VARS();
              rs_rows(SSP, RS, nullptr, nullptr, CT, gw, NGW, lane);
              const float* P = (prompt ? INP(I_PP) + ((size_t)layer * NPROMPT + tok0) * PLED : INP(I_PS) + ((size_t)layer * NPROMPT + (tok0 - NPROMPT)) * PLED); bf16* const PB = (bf16*)(ws + WS_PB);
              for (int i = vcu * 512 + tid; i < CT * PLED / 8; i += G * 512) { const f32x4 a0 = ((const f32x4*)P)[2 * i], a1 = ((const f32x4*)P)[2 * i + 1];
                  v4u w; w.x = pk2(a0.x, a0.y); w.y = pk2(a0.z, a0.w); w.z = pk2(a1.x, a1.y); w.w = pk2(a1.z, a1.w); ((v4u*)PB)[i] = w; } }
            GRID_BAR(7);
            for (int rep_ = 0; rep_ < REP_MLPIN; ++rep_)
            { PHASE_VARS(); CHUNK_VARS(); LAYER_VARS(); GEMM_PHASE(EpiMlp, XB, WT + OFF_IN + (size_t)layer * SZ_IN, CT, DFF, DM, (bf16*)(BIG + B_HID), DFF, RS, nullptr); }
#ifdef PROBE_PROJ
            { PHASE_VARS(); CHUNK_VARS(); LAYER_VARS(); GEMM_PHASE(EpiPle, (bf16*)(ws + WS_PB), WT + OFF_PLE + (size_t)layer * SZ_PLE, CT, DM, PLED, (bf16*)(ws + WS_E0), DM, nullptr, (float*)(ws + WS_SSPE)); }
#endif
            { PHASE_VARS(); CHUNK_VARS(); LAYER_VARS(); GEMM_PHASE(EpiPle, (bf16*)(ws + WS_PB), WT + OFF_PLE + (size_t)layer * SZ_PLE, CT, DM, PLED, (bf16*)(ws + WS_E0), DM, nullptr, (float*)(ws + WS_SSPE)); }
            GRID_BAR(8);
            { PHASE_VARS(); CHUNK_VARS(); LAYER_VARS(); STAGGER2(STAG2_TICKS); GEMM_PHASE(EpiRes, (bf16*)(BIG + B_HID), WT + OFF_OUT + (size_t)layer * SZ_OUT, CT, DM, DFF, XB, nullptr, XB, SSP, DM, nullptr, nullptr, nullptr, nullptr); }
            GRID_BAR(9);
            { PHASE_VARS(); CHUNK_VARS(); rs_rows(SSP, RS, (float*)(ws + WS_SSPE), (float*)(ws + WS_RSTD), CT, gw, NGW, lane); }
            GRID_BAR(2);
            if (layer_ < DEPTH - 1) { PHASE_VARS(); CHUNK_VARS(); LAYER_VARS(); STAGGER2(STAG2_TICKS); GEMM_PHASE(EpiGate, XB, WT + OFF_GATE + (size_t)layer * SZ_GATE, CT, DM, DM, XB, nullptr, XBP, SSP, DM, (bf16*)(ws + WS_E0), RS, (float*)(ws + WS_RSTD), INP(I_PLEG) + layer * DM); }
            else { PHASE_VARS(); CHUNK_VARS(); LAYER_VARS(); STAGGER2(STAG2_TICKS); GEMM_PHASE(EpiGateF, XB, WT + OFF_GATE + (size_t)layer * SZ_GATE, CT, DM, DM, XB, X, XBP, SSP, DM, (bf16*)(ws + WS_E0), RS, (float*)(ws + WS_RSTD), INP(I_PLEG) + layer * DM); }
            GRID_BAR(10);
        }
    }
    if (TS_MASK != 0u && blockIdx.x == 0 && ts_thread0(wave_u)) { const unsigned long long a_ = (((unsigned long long)MISC[19] << 32) | MISC[18]) * TS_FACTOR, t0_ = __builtin_amdgcn_s_memrealtime(); while (__builtin_amdgcn_s_memrealtime() - t0_ < a_) __builtin_amdgcn_s_sleep(32); }
#undef GRID_BAR
}

extern "C" void kernel_launch(void* const* d_in, const int* in_sizes, int n_in, void* d_out, int out_size, void* d_ws, size_t ws_size, hipStream_t stream) {
    static int grid = 0;
    if (grid == 0) {
        if (n_in != N_IN || out_size != NTOK * DM || ws_size < WS_END) { fprintf(stderr, "kernel_launch: shape mismatch: n_in %d out %d ws %zu (need %zu)\n", n_in, out_size, ws_size, (size_t)WS_END); grid = -1; return; }
        int dev = 0, cus = 0, per_cu = 0;
        if (hipGetDevice(&dev) != hipSuccess || hipDeviceGetAttribute(&cus, hipDeviceAttributeMultiprocessorCount, dev) != hipSuccess) { grid = -1; return; }
        if (hipFuncSetAttribute((const void*)mk_fwd, hipFuncAttributeMaxDynamicSharedMemorySize, LDS_BYTES) != hipSuccess) { fprintf(stderr, "kernel_launch: hipFuncSetAttribute failed\n"); grid = -1; return; }
        if (hipOccupancyMaxActiveBlocksPerMultiprocessor(&per_cu, (const void*)mk_fwd, NWAVES * 64, LDS_BYTES) != hipSuccess || per_cu < 1) { fprintf(stderr, "kernel_launch: occupancy query says %d\n", per_cu); }
        (void)hipGetLastError();
        grid = cus;
    }
    if (grid < 0) return;
    if (hipMemsetAsync((char*)d_ws + WS_CTL, 0, CTL_ZERO_BYTES, stream) != hipSuccess) return;
    Args a{};
    for (int i = 0; i < N_IN; ++i) a.in[i] = (const float*)d_in[i];
    a.out = (float*)d_out; a.ws = (unsigned char*)d_ws;
    hipLaunchKernelGGL(mk_fwd, dim3(grid), dim3(NWAVES * 64), LDS_BYTES, stream, a);
    const hipError_t le = hipPeekAtLastError();
    if (le != hipSuccess) fprintf(stderr, "kernel_launch: launch failed: %s\n", hipGetErrorName(le));
}
```

```cpp
#include <hip/hip_runtime.h>
#include <cstdio>
#include <cstdint>
#ifndef PG8_WGM_NARROW
#define PG8_WGM_NARROW 4
#endif
#ifndef PG8_WGM_WIDE
#define PG8_WGM_WIDE 4
#endif
namespace pg8 {
#define PG8_LAS __attribute__((address_space(3)))
typedef unsigned short bf16_t;
typedef short bf16x8 __attribute__((ext_vector_type(8)));
typedef float f32x4 __attribute__((ext_vector_type(4)));
typedef unsigned u32x4 __attribute__((ext_vector_type(4)));
constexpr int BM = 256, BK = 64, HALF = 128, HTB = HALF * BK * 2  , STAGE_BYTES = 8 * HTB, NXCD = 8, WGM = 8;

__host__ __device__ __forceinline__ int lds_byte(int r, int c) { const int st = (r >> 4) * 2 + (c >> 5), rr = r & 15, cc = c & 31, ob = rr * 64 + cc * 2; return st * 1024 + (ob ^ (((ob >> 9) & 1) << 5)); }
__host__ __device__ __forceinline__ void stage_rc(int b, int& R, int& C) { const int st = b / 1024, sb = b % 1024, swz = sb ^ (((sb >> 9) & 1) << 5); R = (st >> 1) * 16 + swz / 64; C = (st & 1) * 32 + (swz % 64) / 2; }
__host__ __device__ __forceinline__ int perm32(int rho) { const int n = rho >> 4, i = rho & 15; return 8 * (i >> 2) + 4 * n + (i & 3); }

struct Unit { int pm, pn; };
struct Gemm { const bf16_t* A; const bf16_t* Bt; int M, N, K; };

struct StaticOrder {
    int nM, nN, nwg, G, c;
    __host__ __device__ void init(int M, int N, int G_, int c_) { nM = M / BM; nN = N / BM; nwg = nM * nN; G = G_; c = c_; }
    __host__ __device__ bool next(int i, Unit& u) const {
        const long L = (long)i * G + c; if (L >= nwg) return false;
        int wgid = (int)L; { const int q = nwg / NXCD, r = nwg % NXCD, xcd = wgid % NXCD, off = wgid / NXCD; wgid = (xcd < r ? xcd * (q + 1) : r * (q + 1) + (xcd - r) * q) + off; }
        const int wgm = (nN <= 8) ? PG8_WGM_NARROW : PG8_WGM_WIDE;
        const int nig = wgm * nN, gid = wgid / nig, fm = gid * wgm, gsz = (nM - fm) < wgm ? (nM - fm) : wgm;
        u.pm = fm + ((wgid % nig) % gsz); u.pn = (wgid % nig) / gsz; return true;
    }
    __device__ __forceinline__ void a_ready(const Unit&) const {}
    __device__ __forceinline__ void done(const Unit&) const {}
};

__device__ __forceinline__ unsigned cvt_pk_bf16(float lo, float hi) { unsigned r; asm volatile("v_cvt_pk_bf16_f32 %0, %1, %2" : "=v"(r) : "v"(lo), "v"(hi)); return r; }
typedef float f32x2 __attribute__((ext_vector_type(2)));
typedef unsigned u32x2 __attribute__((ext_vector_type(2)));
__device__ __forceinline__ float xlane(float v, int lane, int o) { return __int_as_float(__builtin_amdgcn_ds_bpermute((lane ^ o) << 2, __float_as_int(v))); }
template <int ACT, bool RS, bool SS> struct EpiBf16 {
    static constexpr bool PERM = true, AFTER_DRAIN = false, ACC_INIT = false;
    bf16_t* O; int ldc; const float* rs; float* ssp;
    __device__ __forceinline__ void operator()(const f32x4 (&acc)[2][2][4][2], const Unit& u, int wr, int wc, int fr, int fq) const {
        { int t_; asm volatile("v_mbcnt_lo_u32_b32 %0, -1, 0\n\tv_mbcnt_hi_u32_b32 %0, -1, %0" : "=v"(t_)); fr = t_ & 15; fq = (t_ >> 4) & 3; }
        const int row0 = u.pm * BM + wr * 64 + fr; const int col0 = u.pn * BM + wc * 32 + 8 * fq;
        float scr[8];
#pragma unroll
        for (int gi = 0; gi < 8; ++gi) scr[gi] = RS ? rs[row0 + (gi >> 2) * HALF + (gi & 3) * 16] : 1.f;
#pragma unroll
        for (int ai = 0; ai < 2; ++ai)
#pragma unroll
            for (int m = 0; m < 4; ++m) { const int row = row0 + ai * HALF + m * 16; bf16_t* rowp = O + (size_t)row * ldc + col0;
                const float sc = scr[ai * 4 + m];
                float q = 0.f;
#pragma unroll
                for (int bj = 0; bj < 2; ++bj) { f32x4 v0 = acc[ai][bj][m][0], v1 = acc[ai][bj][m][1];
                    if (RS) { v0 = v0 * sc; v1 = v1 * sc; }
                    if (ACT == 1) {
#pragma unroll
                        for (int j = 0; j < 4; ++j) { const float a = fmaxf(v0[j], 0.f), b = fmaxf(v1[j], 0.f); v0[j] = a * a; v1[j] = b * b; } }
                    if (SS) {
#pragma unroll
                        for (int j = 0; j < 4; ++j) q += v0[j] * v0[j] + v1[j] * v1[j]; }
                    u32x4 w; w.x = cvt_pk_bf16(v0[0], v0[1]); w.y = cvt_pk_bf16(v0[2], v0[3]); w.z = cvt_pk_bf16(v1[0], v1[1]); w.w = cvt_pk_bf16(v1[2], v1[3]);
                    __builtin_nontemporal_store(w, (u32x4*)(rowp + bj * HALF)); }
                if (SS) { const int lane = fq * 16 + fr; q += xlane(q, lane, 16); q += xlane(q, lane, 32); if (fq == 0) ssp[(size_t)row * 32 + u.pn * 4 + wc] = q; } }
    }
};
template <int KIND> struct EpiQK {
    static constexpr bool PERM = true, AFTER_DRAIN = false, ACC_INIT = false;
    bf16_t* O; int ldc; const float* rs; const float* qg; const float* kg; const f32x2* T; int seqmask; PG8_LAS float* P; int nq, nqk;
    __device__ __forceinline__ void operator()(const f32x4 (&acc)[2][2][4][2], const Unit& u, int wr, int wc, int fr, int fq) const {
        { int t_; asm volatile("v_mbcnt_lo_u32_b32 %0, -1, 0\n\tv_mbcnt_hi_u32_b32 %0, -1, %0" : "=v"(t_)); fr = t_ & 15; fq = (t_ >> 4) & 3; }
        const int lane = fq * 16 + fr, rl0 = wr * 64 + fr, row0 = u.pm * BM + rl0, col0 = u.pn * BM + wc * 32 + 8 * fq;
        float scr[8];
#pragma unroll
        for (int gi = 0; gi < 8; ++gi) scr[gi] = rs[row0 + (gi >> 2) * HALF + (gi & 3) * 16];
        if (u.pn >= nqk) {
#pragma unroll
            for (int ai = 0; ai < 2; ++ai)
#pragma unroll
                for (int m = 0; m < 4; ++m) { bf16_t* rowp = O + (size_t)(row0 + ai * HALF + m * 16) * ldc + col0; const float sc = scr[ai * 4 + m];
#pragma unroll
                    for (int bj = 0; bj < 2; ++bj) { const f32x4 v0 = acc[ai][bj][m][0] * sc, v1 = acc[ai][bj][m][1] * sc;
                        u32x4 w; w.x = cvt_pk_bf16(v0[0], v0[1]); w.y = cvt_pk_bf16(v0[2], v0[3]); w.z = cvt_pk_bf16(v1[0], v1[1]); w.w = cvt_pk_bf16(v1[2], v1[3]);
                        *(u32x4*)(rowp + bj * HALF) = w; } }
            return;
        }
#pragma unroll
        for (int ai = 0; ai < 2; ++ai)
#pragma unroll
            for (int m = 0; m < 4; ++m) { const float sc = scr[ai * 4 + m];
#pragma unroll
                for (int bj = 0; bj < 2; ++bj) { const f32x4 v0 = acc[ai][bj][m][0] * sc, v1 = acc[ai][bj][m][1] * sc;
                    float q = (v0[0] * v0[0] + v0[1] * v0[1]) + (v0[2] * v0[2] + v0[3] * v0[3]) + (v1[0] * v1[0] + v1[1] * v1[1]) + (v1[2] * v1[2] + v1[3] * v1[3]);
                    q += xlane(q, lane, 16); q += xlane(q, lane, 32);
                    if (fq == 0) P[((ai * HALF + rl0 + m * 16) * 2 + bj) * 4 + wc] = q; } }
        asm volatile("s_waitcnt lgkmcnt(0)" ::: "memory"); __builtin_amdgcn_s_barrier(); asm volatile("" ::: "memory");
        const float* g = (u.pn < nq) ? qg : kg;
        const bool roped = (KIND == 1) || (wc == 0);
        float gl[8];
#pragma unroll
        for (int i = 0; i < 8; ++i) { int d;
            if (KIND == 1) d = (wc >> 1) * 64 + (i & 1) * 32 + (wc & 1) * 16 + fq * 4 + (i >> 1);
            else d = (wc == 0) ? ((i & 1) * 16 + fq * 4 + (i >> 1)) : (wc * 32 + fq * 8 + i);
            gl[i] = g[d]; }
        const int fi0 = (KIND == 1) ? ((wc & 1) * 16 + fq * 4) : (fq * 4);
#pragma unroll
        for (int ai = 0; ai < 2; ++ai)
#pragma unroll
            for (int m = 0; m < 4; ++m) { const int rl = ai * HALF + rl0 + m * 16, row = u.pm * BM + rl; bf16_t* rowp = O + (size_t)row * ldc + col0; const float sc = scr[ai * 4 + m];
                const int t = row & seqmask; const int pos = (KIND == 1) ? ((wc >> 1) ? (t & 63) : (t >> 6)) : t;
                f32x4 c01 = {1.f, 0.f, 1.f, 0.f}, c23 = {1.f, 0.f, 1.f, 0.f};
                if (roped) { const f32x4* cp = (const f32x4*)(T + (size_t)pos * (KIND == 1 ? 32 : 16) + fi0); c01 = cp[0]; c23 = cp[1]; }
#pragma unroll
                for (int bj = 0; bj < 2; ++bj) { const f32x4 p4 = *(const PG8_LAS f32x4*)(P + (rl * 2 + bj) * 4);
                    const float rstd = __builtin_amdgcn_rsqf(((p4[0] + p4[1]) + (p4[2] + p4[3])) * (1.f / 128.f) + 1e-6f) * sc;
                    float y[8];
#pragma unroll
                    for (int j = 0; j < 4; ++j) { y[j] = acc[ai][bj][m][0][j] * rstd * gl[j]; y[4 + j] = acc[ai][bj][m][1][j] * rstd * gl[4 + j]; }
                    float o[8];
                    o[0] = y[0] * c01[0] - y[1] * c01[1]; o[1] = y[1] * c01[0] + y[0] * c01[1]; o[2] = y[2] * c01[2] - y[3] * c01[3]; o[3] = y[3] * c01[2] + y[2] * c01[3];
                    o[4] = y[4] * c23[0] - y[5] * c23[1]; o[5] = y[5] * c23[0] + y[4] * c23[1]; o[6] = y[6] * c23[2] - y[7] * c23[3]; o[7] = y[7] * c23[2] + y[6] * c23[3];
                    u32x4 w; w.x = cvt_pk_bf16(o[0], o[1]); w.y = cvt_pk_bf16(o[2], o[3]); w.z = cvt_pk_bf16(o[4], o[5]); w.w = cvt_pk_bf16(o[6], o[7]);
                    *(u32x4*)(rowp + bj * HALF) = w; } }
    }
};
template <bool GATE, bool F32OUT> struct EpiResidT {
    static constexpr bool PERM = true, AFTER_DRAIN = false, ACC_INIT = !GATE;
    const bf16_t* base; float* out; bf16_t* xb; float* ssp; int ldc; const bf16_t* e0; const float* rs; const float* rse; const float* g;
    __device__ static __forceinline__ void expand(const u32x4 w, f32x4& a0, f32x4& a1) {
        a0[0] = __uint_as_float(w.x << 16); a0[1] = __uint_as_float(w.x & 0xffff0000u); a0[2] = __uint_as_float(w.y << 16); a0[3] = __uint_as_float(w.y & 0xffff0000u);
        a1[0] = __uint_as_float(w.z << 16); a1[1] = __uint_as_float(w.z & 0xffff0000u); a1[2] = __uint_as_float(w.w << 16); a1[3] = __uint_as_float(w.w & 0xffff0000u); }
    __device__ __forceinline__ void issue_base(u32x4 (&raw)[2][4][2], const Unit& u, int wr, int wc) const {
        int fr, fq; { int t_; asm volatile("v_mbcnt_lo_u32_b32 %0, -1, 0\n\tv_mbcnt_hi_u32_b32 %0, -1, %0" : "=v"(t_)); fr = t_ & 15; fq = (t_ >> 4) & 3; }
        const int row0 = u.pm * BM + wr * 64 + fr, col0 = u.pn * BM + wc * 32 + 8 * fq;
#pragma unroll
        for (int ai = 0; ai < 2; ++ai)
#pragma unroll
            for (int m = 0; m < 4; ++m) { const bf16_t* p = base + (size_t)(row0 + ai * HALF + m * 16) * ldc + col0;
                asm volatile("global_load_dwordx4 %0, %2, off\n\tglobal_load_dwordx4 %1, %2, off offset:256" : "=&v"(raw[ai][m][0]), "=&v"(raw[ai][m][1]) : "v"(p) : "memory"); }
    }
    template <int NYOUNGER> __device__ __forceinline__ void finish_base(f32x4 (&acc)[2][2][4][2], u32x4 (&raw)[2][4][2]) const {
        if constexpr (NYOUNGER == 0)
        asm volatile("s_waitcnt vmcnt(0)" : "+v"(raw[0][0][0]), "+v"(raw[0][0][1]), "+v"(raw[0][1][0]), "+v"(raw[0][1][1]), "+v"(raw[0][2][0]), "+v"(raw[0][2][1]), "+v"(raw[0][3][0]), "+v"(raw[0][3][1]),
                     "+v"(raw[1][0][0]), "+v"(raw[1][0][1]), "+v"(raw[1][1][0]), "+v"(raw[1][1][1]), "+v"(raw[1][2][0]), "+v"(raw[1][2][1]), "+v"(raw[1][3][0]), "+v"(raw[1][3][1]) :: "memory");
        else
        asm volatile("s_waitcnt vmcnt(16)" : "+v"(raw[0][0][0]), "+v"(raw[0][0][1]), "+v"(raw[0][1][0]), "+v"(raw[0][1][1]), "+v"(raw[0][2][0]), "+v"(raw[0][2][1]), "+v"(raw[0][3][0]), "+v"(raw[0][3][1]),
                     "+v"(raw[1][0][0]), "+v"(raw[1][0][1]), "+v"(raw[1][1][0]), "+v"(raw[1][1][1]), "+v"(raw[1][2][0]), "+v"(raw[1][2][1]), "+v"(raw[1][3][0]), "+v"(raw[1][3][1]) :: "memory");
        static_assert(NYOUNGER == 0 || NYOUNGER == 16, "finish_base: 0 or 16");
#pragma unroll
        for (int ai = 0; ai < 2; ++ai)
#pragma unroll
            for (int m = 0; m < 4; ++m)
#pragma unroll
                for (int bj = 0; bj < 2; ++bj) expand(raw[ai][m][bj], acc[ai][bj][m][0], acc[ai][bj][m][1]);
    }
    __device__ __forceinline__ void operator()(const f32x4 (&acc)[2][2][4][2], const Unit& u, int wr, int wc, int fr, int fq) const {
        { int t_; asm volatile("v_mbcnt_lo_u32_b32 %0, -1, 0\n\tv_mbcnt_hi_u32_b32 %0, -1, %0" : "=v"(t_)); fr = t_ & 15; fq = (t_ >> 4) & 3; }
        const int row0 = u.pm * BM + wr * 64 + fr, col0 = u.pn * BM + wc * 32 + 8 * fq; const int lane = fq * 16 + fr;
        if constexpr (!GATE) {
#pragma unroll
            for (int ai = 0; ai < 2; ++ai)
#pragma unroll
                for (int m = 0; m < 4; ++m) { const int row = row0 + ai * HALF + m * 16; const size_t off = (size_t)row * ldc + col0; float q = 0.f;
#pragma unroll
                    for (int bj = 0; bj < 2; ++bj) { const f32x4 x0 = acc[ai][bj][m][0], x1 = acc[ai][bj][m][1];
                        if (F32OUT) { *(f32x4*)(out + off + bj * HALF) = x0; *(f32x4*)(out + off + bj * HALF + 4) = x1; }
#pragma unroll
                        for (int j = 0; j < 4; ++j) q += x0[j] * x0[j] + x1[j] * x1[j];
                        u32x4 w; w.x = cvt_pk_bf16(x0[0], x0[1]); w.y = cvt_pk_bf16(x0[2], x0[3]); w.z = cvt_pk_bf16(x1[0], x1[1]); w.w = cvt_pk_bf16(x1[2], x1[3]);
                        *(u32x4*)(xb + off + bj * HALF) = w; }
                    q += xlane(q, lane, 16); q += xlane(q, lane, 32); if (fq == 0) ssp[(size_t)row * 32 + u.pn * 4 + wc] = q; }
        } else {
            f32x4 gv[2][2];
#pragma unroll
            for (int bj = 0; bj < 2; ++bj)
#pragma unroll
                for (int n = 0; n < 2; ++n) gv[bj][n] = *(const f32x4*)(g + col0 + bj * HALF + n * 4);
            float sxr[8], ser[8];
#pragma unroll
            for (int gi = 0; gi < 8; ++gi) { const int row = row0 + (gi >> 2) * HALF + (gi & 3) * 16; sxr[gi] = rs[row]; ser[gi] = rse[row]; }
            u32x4 pb[2][2], pe[2][2];
#define PG8_GLOAD(set, gi) do { const size_t off_ = (size_t)(row0 + ((gi) >> 2) * HALF + ((gi) & 3) * 16) * ldc + col0; _Pragma("unroll") for (int bj = 0; bj < 2; ++bj) { \
                pb[set][bj] = *(const u32x4*)(base + off_ + bj * HALF); pe[set][bj] = *(const u32x4*)(e0 + off_ + bj * HALF); } } while (0)
            PG8_GLOAD(0, 0);
#pragma unroll
            for (int gi = 0; gi < 8; ++gi) { const int ai = gi >> 2, m = gi & 3, cs = gi & 1; const int row = row0 + ai * HALF + m * 16; const size_t off = (size_t)row * ldc + col0;
                if (gi < 7) { if (cs == 0) PG8_GLOAD(1, gi + 1); else PG8_GLOAD(0, gi + 1); }
                const float sx = sxr[gi] * -1.4426950408889634f, se = ser[gi]; float q = 0.f;
#pragma unroll
                for (int bj = 0; bj < 2; ++bj) { f32x4 e_0, e_1, b_0, b_1; expand(pe[cs][bj], e_0, e_1); expand(pb[cs][bj], b_0, b_1);
                    f32x4 d0 = acc[ai][bj][m][0], d1 = acc[ai][bj][m][1];
#pragma unroll
                    for (int j = 0; j < 4; ++j) { d0[j] = __builtin_amdgcn_rcpf(1.0f + __builtin_amdgcn_exp2f(d0[j] * sx)); d1[j] = __builtin_amdgcn_rcpf(1.0f + __builtin_amdgcn_exp2f(d1[j] * sx)); }
                    const f32x4 x0 = b_0 + d0 * (e_0 * se * gv[bj][0]), x1 = b_1 + d1 * (e_1 * se * gv[bj][1]);
                    if (F32OUT) { *(f32x4*)(out + off + bj * HALF) = x0; *(f32x4*)(out + off + bj * HALF + 4) = x1; }
#pragma unroll
                    for (int j = 0; j < 4; ++j) q += x0[j] * x0[j] + x1[j] * x1[j];
                    if (!F32OUT) { u32x4 w; w.x = cvt_pk_bf16(x0[0], x0[1]); w.y = cvt_pk_bf16(x0[2], x0[3]); w.z = cvt_pk_bf16(x1[0], x1[1]); w.w = cvt_pk_bf16(x1[2], x1[3]);
                        *(u32x4*)(xb + off + bj * HALF) = w; } }
                if (!F32OUT) { q += xlane(q, lane, 16); q += xlane(q, lane, 32); if (fq == 0) ssp[(size_t)row * 32 + u.pn * 4 + wc] = q; }
                asm volatile("" ::: "memory"); }
#undef PG8_GLOAD
        }
    }
};
template <class Epi, class Sched, bool ALIGN_EPI = false, bool SP2 = false>
__device__ __forceinline__ void gemm_phase(PG8_LAS unsigned char* lds, const Gemm g, const Sched& S, const Epi& E, const int tid) {
    const int wid = __builtin_amdgcn_readfirstlane(tid >> 6), lane = tid & 63, wr = wid >> 2, wc = wid & 3, fr = lane & 15, fq = lane >> 4;
    const int K = g.K, nt = K / BK;
    unsigned voffA[2], voffB[2];
#pragma unroll
    for (int i = 0; i < 2; ++i) { int R, C; stage_rc(tid * 16 + i * 8192, R, C); const int Rb = Epi::PERM ? ((R & ~31) + perm32(R & 31)) : R;
        voffA[i] = (unsigned)(R * K + C) * 2u; voffB[i] = (unsigned)(Rb * K + C) * 2u; }
    const size_t kstep = (size_t)(BK * 2);
    const size_t hstep = (size_t)HALF * K * 2;
    const size_t tstep = 2 * hstep;
    const unsigned ldsw = (unsigned)wid * 1024u;
    const int aoff = lds_byte(wr * 64 + fr, fq * 8), boff = lds_byte(wc * 32 + fr, fq * 8);
#define PG8_SA(b, h) (((b) * 2 + (h)) * HTB)
#define PG8_SB(b, h) ((4 + (b) * 2 + (h)) * HTB)
#define PG8_STAGE(bufoff, gbase, voff) do { _Pragma("unroll") for (int _i = 0; _i < 2; ++_i) \
        __builtin_amdgcn_global_load_lds((const unsigned*)((const char*)(gbase) + (voff)[_i]), (PG8_LAS unsigned*)(lds + (bufoff) + ldsw + _i * 8192), 16, 0, 0); } while (0)
#define PG8_LDA(dst, b, h) do { _Pragma("unroll") for (int m = 0; m < 4; ++m) _Pragma("unroll") for (int k = 0; k < 2; ++k) dst[m][k] = *(const PG8_LAS bf16x8*)(lds + PG8_SA(b, h) + aoff + m * 2048 + k * 1024); } while (0)
#define PG8_LDB(dst, b, h) do { _Pragma("unroll") for (int n = 0; n < 2; ++n) _Pragma("unroll") for (int k = 0; k < 2; ++k) dst[n][k] = *(const PG8_LAS bf16x8*)(lds + PG8_SB(b, h) + boff + n * 2048 + k * 1024); } while (0)
#define PG8_MMA(ai, bj, At, Bt) do { __builtin_amdgcn_s_setprio(1); _Pragma("unroll") for (int m = 0; m < 4; ++m) _Pragma("unroll") for (int n = 0; n < 2; ++n) _Pragma("unroll") for (int k = 0; k < 2; ++k) \
        acc[ai][bj][m][n] = __builtin_amdgcn_mfma_f32_16x16x32_bf16(Bt[n][k], At[m][k], acc[ai][bj][m][n], 0, 0, 0); __builtin_amdgcn_s_setprio(0); } while (0)
#define PG8_WAIT_V(n) asm volatile("s_waitcnt vmcnt(" #n ")" ::: "memory")
#define PG8_WAIT_L(n) asm volatile("s_waitcnt lgkmcnt(" #n ")" ::: "memory")
#define PG8_BAR __builtin_amdgcn_s_barrier()
#define PG8_SCHED __builtin_amdgcn_sched_barrier(0)
    Unit cur, nxt; int ui = 0;
    if (!S.next(0, cur)) return;
    f32x4 acc[2][2][4][2];
    u32x4 rawb[2][4][2];
    if constexpr (Epi::ACC_INIT) { E.issue_base(rawb, cur, wr, wc); E.template finish_base<0>(acc, rawb); }
    else {
#pragma unroll
    for (int a = 0; a < 2; ++a)
#pragma unroll
        for (int b = 0; b < 2; ++b)
#pragma unroll
            for (int m = 0; m < 4; ++m)
#pragma unroll
                for (int n = 0; n < 2; ++n) acc[a][b][m][n] = (f32x4){0.f, 0.f, 0.f, 0.f};
    }
    bf16x8 At[4][2], B0[2][2], B1[2][2];
    const char* cA = (const char*)g.A + (size_t)cur.pm * tstep; const char* cB = (const char*)g.Bt + (size_t)cur.pn * tstep;
    S.a_ready(cur);
    if constexpr (SP2) {
        PG8_STAGE(PG8_SB(0, 0), cB, voffB); PG8_STAGE(PG8_SB(0, 1), cB + hstep, voffB); PG8_STAGE(PG8_SA(0, 0), cA, voffA); PG8_STAGE(PG8_SA(0, 1), cA + hstep, voffA);
        if (wr == 1) PG8_BAR;
        PG8_WAIT_V(2); PG8_BAR;
        PG8_STAGE(PG8_SB(1, 0), cB + kstep, voffB); PG8_STAGE(PG8_SA(1, 0), cA + kstep, voffA); PG8_STAGE(PG8_SB(1, 1), cB + hstep + kstep, voffB);
        PG8_WAIT_V(6); PG8_BAR;
    } else {
        PG8_STAGE(PG8_SB(0, 0), cB, voffB); PG8_STAGE(PG8_SA(0, 0), cA, voffA); PG8_STAGE(PG8_SB(0, 1), cB + hstep, voffB); PG8_STAGE(PG8_SA(0, 1), cA + hstep, voffA);
        if (wr == 1) PG8_BAR;
        PG8_WAIT_V(4); PG8_BAR;
        PG8_STAGE(PG8_SB(1, 0), cB + kstep, voffB); PG8_STAGE(PG8_SA(1, 0), cA + kstep, voffA); PG8_STAGE(PG8_SB(1, 1), cB + hstep + kstep, voffB);
        PG8_WAIT_V(6); PG8_BAR;
    }
    for (;;) {
        const bool has_next = S.next(ui + 1, nxt);
        const char* nA = has_next ? (const char*)g.A + (size_t)nxt.pm * tstep : cA; const char* nB = has_next ? (const char*)g.Bt + (size_t)nxt.pn * tstep : cB;
        for (int t = 0; t < nt; t += 2) {
            const bool last = (t == nt - 2);
            const char* a1 = cA + (size_t)(t + 1) * kstep;
            const char* a2 = last ? nA : cA + (size_t)(t + 2) * kstep; const char* b2 = last ? nB : cB + (size_t)(t + 2) * kstep;
            const char* a3 = a2 + kstep; const char* b3 = b2 + kstep;
            if (last && has_next) S.a_ready(nxt);
            if constexpr (SP2) {
            PG8_LDB(B0, 0, 0); PG8_LDB(B1, 0, 1); PG8_SCHED; PG8_LDA(At, 0, 0); PG8_STAGE(PG8_SA(1, 1), a1 + hstep, voffA);
            PG8_WAIT_V(8); PG8_WAIT_L(0); PG8_BAR; PG8_MMA(0, 0, At, B0); PG8_MMA(0, 1, At, B1); PG8_BAR; PG8_SCHED;
            PG8_LDA(At, 0, 1); PG8_STAGE(PG8_SB(0, 0), b2, voffB); PG8_STAGE(PG8_SB(0, 1), b2 + hstep, voffB); PG8_STAGE(PG8_SA(0, 0), a2, voffA);
            PG8_WAIT_V(8); PG8_WAIT_L(0); PG8_BAR; PG8_MMA(1, 0, At, B0); PG8_MMA(1, 1, At, B1); PG8_BAR; PG8_SCHED;
            PG8_LDB(B0, 1, 0); PG8_LDB(B1, 1, 1); PG8_SCHED; PG8_LDA(At, 1, 0); PG8_STAGE(PG8_SA(0, 1), a2 + hstep, voffA);
            PG8_WAIT_V(8); PG8_WAIT_L(0); PG8_BAR; PG8_MMA(0, 0, At, B0); PG8_MMA(0, 1, At, B1); PG8_BAR; PG8_SCHED;
            PG8_LDA(At, 1, 1); PG8_STAGE(PG8_SB(1, 0), b3, voffB); PG8_STAGE(PG8_SB(1, 1), b3 + hstep, voffB); PG8_STAGE(PG8_SA(1, 0), a3, voffA);
            PG8_WAIT_V(8); PG8_WAIT_L(0); PG8_BAR; PG8_MMA(1, 0, At, B0); PG8_MMA(1, 1, At, B1); PG8_BAR; PG8_SCHED;
            } else {
            PG8_LDB(B0, 0, 0); PG8_SCHED; PG8_LDA(At, 0, 0); PG8_STAGE(PG8_SA(1, 1), a1 + hstep, voffA);
            PG8_WAIT_L(8); PG8_BAR; PG8_WAIT_L(0); PG8_MMA(0, 0, At, B0); PG8_BAR; PG8_SCHED;
            PG8_LDB(B1, 0, 1); PG8_STAGE(PG8_SB(0, 0), b2, voffB);
            PG8_BAR; PG8_WAIT_L(0); PG8_MMA(0, 1, At, B1); PG8_BAR;
            PG8_LDA(At, 0, 1); PG8_STAGE(PG8_SA(0, 0), a2, voffA);
            PG8_BAR; PG8_WAIT_L(0); PG8_MMA(1, 0, At, B0); PG8_BAR; PG8_SCHED;
            PG8_STAGE(PG8_SB(0, 1), b2 + hstep, voffB);
            PG8_WAIT_V(6); PG8_BAR; PG8_MMA(1, 1, At, B1); PG8_BAR;
            PG8_LDB(B0, 1, 0); PG8_SCHED; PG8_LDA(At, 1, 0); PG8_STAGE(PG8_SA(0, 1), a2 + hstep, voffA);
            PG8_WAIT_L(8); PG8_BAR; PG8_WAIT_L(0); PG8_MMA(0, 0, At, B0); PG8_BAR; PG8_SCHED;
            PG8_LDB(B1, 1, 1); PG8_STAGE(PG8_SB(1, 0), b3, voffB);
            PG8_BAR; PG8_WAIT_L(0); PG8_MMA(0, 1, At, B1); PG8_BAR;
            PG8_LDA(At, 1, 1); PG8_STAGE(PG8_SA(1, 0), a3, voffA);
            PG8_BAR; PG8_WAIT_L(0); PG8_MMA(1, 0, At, B0); PG8_BAR; PG8_SCHED;
            PG8_STAGE(PG8_SB(1, 1), b3 + hstep, voffB);
            PG8_WAIT_V(6); PG8_BAR; PG8_MMA(1, 1, At, B1); PG8_BAR;
            }
        }
        if constexpr (ALIGN_EPI) { if (wr == 0) PG8_BAR; }
        if constexpr (Epi::ACC_INIT) { E.issue_base(rawb, has_next ? nxt : cur, wr, wc); }
        if constexpr (!Epi::AFTER_DRAIN) { E(acc, cur, wr, wc, fr, fq); S.done(cur); }
        if constexpr (Epi::ACC_INIT) E.template finish_base<16>(acc, rawb);
        if (!has_next) break;
        if constexpr (!Epi::ACC_INIT) {
#pragma unroll
        for (int a = 0; a < 2; ++a)
#pragma unroll
            for (int b = 0; b < 2; ++b)
#pragma unroll
                for (int m = 0; m < 4; ++m)
#pragma unroll
                    for (int n = 0; n < 2; ++n) acc[a][b][m][n] = (f32x4){0.f, 0.f, 0.f, 0.f};
        }
        cur = nxt; cA = nA; cB = nB; ++ui;
        if constexpr (ALIGN_EPI) { if (wr == 1) PG8_BAR; }
    }
    PG8_WAIT_V(0);
    if constexpr (!ALIGN_EPI) { if (wr == 0) PG8_BAR; }
    PG8_BAR;
    if constexpr (Epi::AFTER_DRAIN) { E.fused(acc, cur, wr, wc, fr, fq, lds, wid, lane); S.done(cur); }
#undef PG8_SA
#undef PG8_SB
#undef PG8_STAGE
#undef PG8_LDA
#undef PG8_LDB
#undef PG8_MMA
#undef PG8_WAIT_V
#undef PG8_WAIT_L
#undef PG8_BAR
#undef PG8_SCHED
}
}
#ifndef ATT_QKPF
#define ATT_QKPF 0
#endif
#ifndef ATT_B_NQR
#define ATT_B_NQR 6
#endif
#ifndef ATT_B_QK1
#define ATT_B_QK1 1
#endif
#ifndef ATT_B_PV
#define ATT_B_PV 1
#endif
#ifndef ATT_QKSPLIT
#define ATT_QKSPLIT 1
#endif
#ifndef ATT_SMSPLIT
#define ATT_SMSPLIT 1
#endif
#if ATT_SMSPLIT
#define PV_SM(o, vb, a0, a1, a2, a3, q0, q1, m, mn, al) do { if constexpr ((CF::ND0 == 8 || ATT_B_PV) && !MASK) pv_sm<CF>(o, vb, a0, a1, a2, a3, q0, q1, m, mn, al); \
    else { pv_d0(o, vb, a0, a1, a2, a3); partialSM<CF>(q0, q1, m, mn, al); } } while (0)
#else
#define PV_SM(o, vb, a0, a1, a2, a3, q0, q1, m, mn, al) do { pv_d0(o, vb, a0, a1, a2, a3); partialSM<CF>(q0, q1, m, mn, al); } while (0)
#endif
namespace att {
typedef unsigned short bf16_t;
using bf16x8 = __attribute__((ext_vector_type(8))) short;
using s16x4  = __attribute__((ext_vector_type(4))) short;
using f32x16 = __attribute__((ext_vector_type(16))) float;
using u32x4  = __attribute__((ext_vector_type(4))) unsigned;
constexpr int QBLK = 32, KVBLK = 64, NW = 8;
constexpr float THR = 8.f;
#define ATT_SBAR() __builtin_amdgcn_sched_barrier(0)
#define ATT_SYNC() __syncthreads()
__device__ __forceinline__ int crow(int r, int hi) { return (r & 3) + 8 * (r >> 2) + 4 * hi; }
__device__ __forceinline__ unsigned cvtpk(float lo, float hi) { unsigned r; asm volatile("v_cvt_pk_bf16_f32 %0, %1, %2" : "=v"(r) : "v"(lo), "v"(hi)); return r; }
__device__ __forceinline__ bf16x8 ld8(const bf16_t* p) { return *reinterpret_cast<const bf16x8*>(p); }

template <int DQK_, int SDEPTH_, int SCALE_ID> struct Cfg {
    static constexpr int DQK = DQK_, SDEPTH = SDEPTH_, ND0 = DQK_ / 16, KPITCH = DQK_ * 2;
    static constexpr int KSWM = 7;
    static constexpr float SCALE = SCALE_ID == 0 ? 0.088388347648318440f   : 0.072168783648703220f  ;
    static constexpr int SHM_V = KVBLK * 128 * 2, SHM_K = KVBLK * DQK_ * 2;
    static constexpr int OST_PITCH = 272, OST_WAVE = 32 * OST_PITCH, OST_BYTES = NW * OST_WAVE;
    static constexpr int KV_BYTES = 2 * SHM_V + 2 * SHM_K;
    static constexpr int QX_OFF = KV_BYTES > OST_BYTES ? KV_BYTES : OST_BYTES;
    static constexpr int NQR = DQK_ > 128 ? ATT_B_NQR : 8;
    static constexpr int QXW = (DQK_ / 16 - NQR) * 1024, QX_END = QX_OFF + NW * QXW;
    static constexpr int WS_OFF = QX_END + (QX_END >= 131072 ? 1024 : 0);
    static constexpr int LDS_BYTES = WS_OFF + NW * 64 * 4;
    static constexpr int KV3_BYTES = 3 * SHM_V + 3 * SHM_K;
    static constexpr int QX3_OFF = KV3_BYTES > OST_BYTES ? KV3_BYTES : OST_BYTES;
    static constexpr int WS3_OFF = QX3_OFF + (DQK_ > 128 ? NW * 4096 : 0);
    static constexpr int LDS3_BYTES = WS3_OFF + NW * 64 * 4;
};

template <class CF> __device__ __forceinline__ void partialSM(f32x16& p0, f32x16& p1, float& m_reg, float& mn, float& alpha) {
  constexpr float C = CF::SCALE * 1.4426950408889634f;
  float pmax = p0[0];
#pragma unroll
  for (int r = 1; r < 16; ++r) pmax = fmaxf(pmax, p0[r]);
#pragma unroll
  for (int r = 0; r < 16; ++r) pmax = fmaxf(pmax, p1[r]);
  { auto rr = __builtin_amdgcn_permlane32_swap(__float_as_uint(pmax), __float_as_uint(pmax), false, false);
    pmax = fmaxf(__uint_as_float(rr[0]), __uint_as_float(rr[1])); }
  if (__builtin_expect(__all(pmax - m_reg <= THR / CF::SCALE), 1)) { mn = m_reg; alpha = 1.f; }
  else { mn = fmaxf(m_reg, pmax); alpha = __builtin_amdgcn_exp2f((m_reg - mn) * C); m_reg = mn; }
  float mnC = -mn * C;
#pragma unroll
  for (int r = 0; r < 16; ++r) p0[r] = fmaf(p0[r], C, mnC);
#pragma unroll
  for (int r = 0; r < 16; ++r) p1[r] = fmaf(p1[r], C, mnC);
#pragma unroll
  for (int r = 0; r < 16; ++r) p0[r] = __builtin_amdgcn_exp2f(p0[r]);
}
__device__ __forceinline__ void finishSM(f32x16& p0, f32x16& p1, float alpha, float& l_reg, bf16x8& pa0, bf16x8& pa1, bf16x8& pa2, bf16x8& pa3) {
#pragma unroll
  for (int r = 0; r < 16; ++r) p1[r] = __builtin_amdgcn_exp2f(p1[r]);
  float ps = 0;
#pragma unroll
  for (int r = 0; r < 16; ++r) ps += p0[r];
#pragma unroll
  for (int r = 0; r < 16; ++r) ps += p1[r];
  { auto rr = __builtin_amdgcn_permlane32_swap(__float_as_uint(ps), __float_as_uint(ps), false, false);
    ps = __uint_as_float(rr[0]) + __uint_as_float(rr[1]); }
  l_reg = l_reg * alpha + ps;
#define ATT_PK4(P, BASE, OUT) do { unsigned a0 = cvtpk(P[BASE + 0], P[BASE + 1]), a1 = cvtpk(P[BASE + 2], P[BASE + 3]);   \
    unsigned b0 = cvtpk(P[BASE + 4], P[BASE + 5]), b1 = cvtpk(P[BASE + 6], P[BASE + 7]);                              \
    auto r0 = __builtin_amdgcn_permlane32_swap(a0, b0, false, false); auto r1 = __builtin_amdgcn_permlane32_swap(a1, b1, false, false); \
    u32x4 w = {r0[0], r1[0], r0[1], r1[1]}; OUT = *reinterpret_cast<bf16x8*>(&w); } while (0)
  ATT_PK4(p0, 0, pa0); ATT_PK4(p0, 8, pa1); ATT_PK4(p1, 0, pa2); ATT_PK4(p1, 8, pa3);
#undef ATT_PK4
}
template <class CF> __device__ __forceinline__ void qkt(f32x16& p0, f32x16& p1, const char* Ks, const bf16x8* qr, const char* qx, int r32, int hi) {
  p0 = f32x16{}; p1 = f32x16{};
#pragma unroll
  for (int d0 = 0; d0 < CF::ND0; ++d0) { const int cb = (d0 * 16 + hi * 8) * 2;
    bf16x8 b0 = *reinterpret_cast<const bf16x8*>(Ks + (r32) * CF::KPITCH + (cb ^ ((r32 & CF::KSWM) << 4)));
    bf16x8 b1 = *reinterpret_cast<const bf16x8*>(Ks + (32 + r32) * CF::KPITCH + (cb ^ ((r32 & CF::KSWM) << 4)));
    bf16x8 q; if (d0 < CF::NQR) q = qr[d0 < CF::NQR ? d0 : 0]; else q = *reinterpret_cast<const bf16x8*>(qx + (d0 - CF::NQR) * 1024);
    p0 = __builtin_amdgcn_mfma_f32_32x32x16_bf16(b0, q, p0, 0, 0, 0);
    p1 = __builtin_amdgcn_mfma_f32_32x32x16_bf16(b1, q, p1, 0, 0, 0); }
}
__device__ __forceinline__ void bandmask(f32x16& p0, f32x16& p1, int kb, int qi, int hi) {
  const float ninf = -__builtin_inff();
  int dq = kb - qi + 4 * hi + 64; asm volatile("" : "+v"(dq));
#pragma unroll
  for (int r = 0; r < 16; ++r) { const int c = (r & 3) + 8 * (r >> 2); if ((unsigned)(dq + c) > 128u) p0[r] = ninf; if ((unsigned)(dq + c + 32) > 128u) p1[r] = ninf; }
}
__device__ __forceinline__ int v_st(int k, int c) { const int kk = (k & ~0xC) | ((k & 4) << 1) | ((k & 8) >> 1); return ((kk >> 3) * 4 + (c >> 5)) * 512 + ((kk & 7) * 32 + (c & 31)) * 2; }
__device__ __forceinline__ int v_rd_base(int lane) { return ((lane & 3) << 3) | (((lane >> 2) & 3) << 6) | (((lane >> 4) & 1) << 5) | (((lane >> 5) & 1) << 8); }
constexpr int v_rd_off(int d0, int ks, int half) { return d0 * 512 + ks * 4096 + half * 2048; }
template <int OFF> __device__ __forceinline__ s16x4 tr_read(int vb) {
  s16x4 r; asm volatile("ds_read_b64_tr_b16 %0, %1 offset:%2" : "=&v"(r) : "v"(vb), "i"(OFF) : "memory"); return r;
}
template <int D0> __device__ __forceinline__ void pv_one(f32x16& od, int vb, bf16x8 pa0, bf16x8 pa1, bf16x8 pa2, bf16x8 pa3) {
  const s16x4 l0 = tr_read<v_rd_off(D0, 0, 0)>(vb), h0 = tr_read<v_rd_off(D0, 0, 1)>(vb), l1 = tr_read<v_rd_off(D0, 1, 0)>(vb), h1 = tr_read<v_rd_off(D0, 1, 1)>(vb);
  const s16x4 l2 = tr_read<v_rd_off(D0, 2, 0)>(vb), h2 = tr_read<v_rd_off(D0, 2, 1)>(vb), l3 = tr_read<v_rd_off(D0, 3, 0)>(vb), h3 = tr_read<v_rd_off(D0, 3, 1)>(vb);
  asm volatile("s_waitcnt lgkmcnt(0)" ::: "memory"); ATT_SBAR();
#define ATT_PK(L, H) (bf16x8){L[0], L[1], L[2], L[3], H[0], H[1], H[2], H[3]}
  od = __builtin_amdgcn_mfma_f32_32x32x16_bf16(pa0, ATT_PK(l0, h0), od, 0, 0, 0);
  od = __builtin_amdgcn_mfma_f32_32x32x16_bf16(pa1, ATT_PK(l1, h1), od, 0, 0, 0);
  od = __builtin_amdgcn_mfma_f32_32x32x16_bf16(pa2, ATT_PK(l2, h2), od, 0, 0, 0);
  od = __builtin_amdgcn_mfma_f32_32x32x16_bf16(pa3, ATT_PK(l3, h3), od, 0, 0, 0);
#undef ATT_PK
}
__device__ __forceinline__ void pv_d0(f32x16* o, int vb, bf16x8 pa0, bf16x8 pa1, bf16x8 pa2, bf16x8 pa3) {
  pv_one<0>(o[0], vb, pa0, pa1, pa2, pa3); pv_one<1>(o[1], vb, pa0, pa1, pa2, pa3); pv_one<2>(o[2], vb, pa0, pa1, pa2, pa3); pv_one<3>(o[3], vb, pa0, pa1, pa2, pa3);
}

template <class CF> __device__ __forceinline__ void qk_sm(f32x16& n0, f32x16& n1, const char* Ks, const bf16x8* qr, int r32, int hi,
                                                          f32x16& p0, f32x16& p1, float alpha, float& l_reg, bf16x8& pa0, bf16x8& pa1, bf16x8& pa2, bf16x8& pa3) {
  n0 = f32x16{}; n1 = f32x16{};
  const char* kr = Ks + r32 * CF::KPITCH; const int sw = (r32 & CF::KSWM) << 4;
  bf16x8 ka[4], kb[4];
#define ATT_QRD(dst, g) do { _Pragma("unroll") for (int t = 0; t < 2; ++t) { const int cb = ((2 * (g) + t) * 16 + hi * 8) * 2; \
    dst[2 * t] = *reinterpret_cast<const bf16x8*>(kr + (cb ^ sw)); dst[2 * t + 1] = *reinterpret_cast<const bf16x8*>(kr + 32 * CF::KPITCH + (cb ^ sw)); } } while (0)
#define ATT_QMM(src, g) do { _Pragma("unroll") for (int t = 0; t < 2; ++t) { n0 = __builtin_amdgcn_mfma_f32_32x32x16_bf16(src[2 * t], qr[2 * (g) + t], n0, 0, 0, 0); \
    n1 = __builtin_amdgcn_mfma_f32_32x32x16_bf16(src[2 * t + 1], qr[2 * (g) + t], n1, 0, 0, 0); } } while (0)
#define ATT_PK4(P, BASE, OUT) do { unsigned a0 = cvtpk(P[BASE + 0], P[BASE + 1]), a1 = cvtpk(P[BASE + 2], P[BASE + 3]);   \
    unsigned b0 = cvtpk(P[BASE + 4], P[BASE + 5]), b1 = cvtpk(P[BASE + 6], P[BASE + 7]);                              \
    auto r0 = __builtin_amdgcn_permlane32_swap(a0, b0, false, false); auto r1 = __builtin_amdgcn_permlane32_swap(a1, b1, false, false); \
    u32x4 w = {r0[0], r1[0], r0[1], r1[1]}; OUT = *reinterpret_cast<bf16x8*>(&w); } while (0)
#if ATT_QKPF
  ATT_QRD(ka, 0); ATT_QRD(kb, 1); asm volatile("s_waitcnt lgkmcnt(4)" ::: "memory"); ATT_SBAR();
#define ATT_QNEXT(dst, g, last) do { ATT_QRD(dst, g); if (last) asm volatile("s_waitcnt lgkmcnt(0)" ::: "memory"); else asm volatile("s_waitcnt lgkmcnt(4)" ::: "memory"); ATT_SBAR(); } while (0)
#define ATT_QEARLY(dst, g) do { } while (0)
#else
  ATT_QRD(ka, 0); asm volatile("s_waitcnt lgkmcnt(0)" ::: "memory"); ATT_SBAR();
#define ATT_QEARLY(dst, g) ATT_QRD(dst, g)
#endif
  ATT_QEARLY(kb, 1);
#pragma unroll
  for (int r = 0; r < 16; ++r) p1[r] = __builtin_amdgcn_exp2f(p1[r]);
  asm volatile("" : "+v"(p1));
  ATT_QMM(ka, 0);
#if ATT_QKPF
  ATT_QRD(ka, 2); asm volatile("s_waitcnt lgkmcnt(4)" ::: "memory"); ATT_SBAR();
#else
  asm volatile("s_waitcnt lgkmcnt(0)" ::: "memory"); ATT_SBAR();
#endif
  ATT_QEARLY(ka, 2);
  float ps = 0;
#pragma unroll
  for (int r = 0; r < 16; ++r) ps += p0[r];
#pragma unroll
  for (int r = 0; r < 16; ++r) ps += p1[r];
  asm volatile("" : "+v"(ps));
  ATT_QMM(kb, 1);
#if ATT_QKPF
  ATT_QRD(kb, 3); asm volatile("s_waitcnt lgkmcnt(4)" ::: "memory"); ATT_SBAR();
#else
  asm volatile("s_waitcnt lgkmcnt(0)" ::: "memory"); ATT_SBAR();
#endif
  ATT_QEARLY(kb, 3);
  { auto rr = __builtin_amdgcn_permlane32_swap(__float_as_uint(ps), __float_as_uint(ps), false, false);
    ps = __uint_as_float(rr[0]) + __uint_as_float(rr[1]); }
  l_reg = l_reg * alpha + ps;
  ATT_PK4(p0, 0, pa0); ATT_PK4(p0, 8, pa1);
  asm volatile("" : "+v"(l_reg), "+v"(pa0), "+v"(pa1));
  ATT_QMM(ka, 2);
  asm volatile("s_waitcnt lgkmcnt(0)" ::: "memory"); ATT_SBAR();
  ATT_PK4(p1, 0, pa2); ATT_PK4(p1, 8, pa3);
  asm volatile("" : "+v"(pa2), "+v"(pa3));
  ATT_QMM(kb, 3);
#undef ATT_PK4
#undef ATT_QRD
#undef ATT_QMM
#undef ATT_QEARLY
#undef ATT_QNEXT
}
template <class CF> __device__ __forceinline__ void qk_sm1(f32x16& n0, f32x16& n1, const char* Ks, const bf16x8* qr, const char* qx, int r32, int hi,
                                                           f32x16& p0, f32x16& p1, float alpha, float& l_reg, bf16x8& pa0, bf16x8& pa1, bf16x8& pa2, bf16x8& pa3) {
  static_assert(CF::ND0 == 12, "qk_sm1: 12 d0 steps");
  n0 = f32x16{}; n1 = f32x16{};
  const char* kr = Ks + r32 * CF::KPITCH; const int sw = (r32 & CF::KSWM) << 4;
  bf16x8 kf[2][2], qf[2];
#define ATT_QRD(b, d0) do { const int cb = ((d0) * 16 + hi * 8) * 2; kf[b][0] = *reinterpret_cast<const bf16x8*>(kr + (cb ^ sw)); kf[b][1] = *reinterpret_cast<const bf16x8*>(kr + 32 * CF::KPITCH + (cb ^ sw)); \
    if ((d0) >= CF::NQR) qf[b] = *reinterpret_cast<const bf16x8*>(qx + ((d0) - CF::NQR) * 1024); } while (0)
#define ATT_QMM(b, d0) do { const bf16x8 q_ = (d0) < CF::NQR ? qr[(d0) < CF::NQR ? (d0) : 0] : qf[b]; n0 = __builtin_amdgcn_mfma_f32_32x32x16_bf16(kf[b][0], q_, n0, 0, 0, 0); n1 = __builtin_amdgcn_mfma_f32_32x32x16_bf16(kf[b][1], q_, n1, 0, 0, 0); } while (0)
#define ATT_PK4(P, BASE, OUT) do { unsigned a0 = cvtpk(P[BASE + 0], P[BASE + 1]), a1 = cvtpk(P[BASE + 2], P[BASE + 3]);   \
    unsigned b0 = cvtpk(P[BASE + 4], P[BASE + 5]), b1 = cvtpk(P[BASE + 6], P[BASE + 7]);                              \
    auto r0 = __builtin_amdgcn_permlane32_swap(a0, b0, false, false); auto r1 = __builtin_amdgcn_permlane32_swap(a1, b1, false, false); \
    u32x4 w = {r0[0], r1[0], r0[1], r1[1]}; OUT = *reinterpret_cast<bf16x8*>(&w); } while (0)
  ATT_QRD(0, 0); asm volatile("s_waitcnt lgkmcnt(0)" ::: "memory"); ATT_SBAR();
  float ps = 0;
#pragma unroll
  for (int g = 0; g < 12; ++g) {
    if (g + 1 < 12) ATT_QRD((g + 1) & 1, g + 1);
    if (g < 2) {
#pragma unroll
      for (int r = 0; r < 8; ++r) p1[8 * g + r] = __builtin_amdgcn_exp2f(p1[8 * g + r]);
      if (g == 1) asm volatile("" : "+v"(p1)); }
    else if (g < 6) {
#pragma unroll
      for (int r = 0; r < 8; ++r) ps += (g < 4 ? p0[8 * (g - 2) + r] : p1[8 * (g - 4) + r]);
      asm volatile("" : "+v"(ps)); }
    else if (g == 6) {
      { auto rr = __builtin_amdgcn_permlane32_swap(__float_as_uint(ps), __float_as_uint(ps), false, false);
        ps = __uint_as_float(rr[0]) + __uint_as_float(rr[1]); }
      l_reg = l_reg * alpha + ps;
      ATT_PK4(p0, 0, pa0);
      asm volatile("" : "+v"(l_reg), "+v"(pa0)); }
    else if (g == 7) { ATT_PK4(p0, 8, pa1); asm volatile("" : "+v"(pa1)); }
    else if (g == 8) { ATT_PK4(p1, 0, pa2); asm volatile("" : "+v"(pa2)); }
    else if (g == 9) { ATT_PK4(p1, 8, pa3); asm volatile("" : "+v"(pa3)); }
    ATT_QMM(g & 1, g);
    if (g + 1 < 12) { asm volatile("s_waitcnt lgkmcnt(0)" ::: "memory"); ATT_SBAR(); }
  }
#undef ATT_PK4
#undef ATT_QRD
#undef ATT_QMM
}
template <int D0> __device__ __forceinline__ void pv_reads(int vb, s16x4 (&f)[8]) {
  f[0] = tr_read<v_rd_off(D0, 0, 0)>(vb); f[1] = tr_read<v_rd_off(D0, 0, 1)>(vb); f[2] = tr_read<v_rd_off(D0, 1, 0)>(vb); f[3] = tr_read<v_rd_off(D0, 1, 1)>(vb);
  f[4] = tr_read<v_rd_off(D0, 2, 0)>(vb); f[5] = tr_read<v_rd_off(D0, 2, 1)>(vb); f[6] = tr_read<v_rd_off(D0, 3, 0)>(vb); f[7] = tr_read<v_rd_off(D0, 3, 1)>(vb);
  asm volatile("s_waitcnt lgkmcnt(0)" ::: "memory"); ATT_SBAR();
}
__device__ __forceinline__ void pv_mfma4(f32x16& od, const s16x4 (&f)[8], bf16x8 pa0, bf16x8 pa1, bf16x8 pa2, bf16x8 pa3) {
#define ATT_PK(L, H) (bf16x8){L[0], L[1], L[2], L[3], H[0], H[1], H[2], H[3]}
  od = __builtin_amdgcn_mfma_f32_32x32x16_bf16(pa0, ATT_PK(f[0], f[1]), od, 0, 0, 0);
  od = __builtin_amdgcn_mfma_f32_32x32x16_bf16(pa1, ATT_PK(f[2], f[3]), od, 0, 0, 0);
  od = __builtin_amdgcn_mfma_f32_32x32x16_bf16(pa2, ATT_PK(f[4], f[5]), od, 0, 0, 0);
  od = __builtin_amdgcn_mfma_f32_32x32x16_bf16(pa3, ATT_PK(f[6], f[7]), od, 0, 0, 0);
#undef ATT_PK
}
template <class CF> __device__ __forceinline__ void pv_sm(f32x16* o, int vb, bf16x8 pa0, bf16x8 pa1, bf16x8 pa2, bf16x8 pa3, f32x16& p0, f32x16& p1, float& m_reg, float& mn, float& alpha) {
  constexpr float C = CF::SCALE * 1.4426950408889634f;
  s16x4 f[8];
  pv_reads<0>(vb, f);
  float pmax = p0[0];
#pragma unroll
  for (int r = 1; r < 16; ++r) pmax = fmaxf(pmax, p0[r]);
  asm volatile("" : "+v"(pmax));
  pv_mfma4(o[0], f, pa0, pa1, pa2, pa3);
  pv_reads<1>(vb, f);
#pragma unroll
  for (int r = 0; r < 16; ++r) pmax = fmaxf(pmax, p1[r]);
  { auto rr = __builtin_amdgcn_permlane32_swap(__float_as_uint(pmax), __float_as_uint(pmax), false, false);
    pmax = fmaxf(__uint_as_float(rr[0]), __uint_as_float(rr[1])); }
  asm volatile("" : "+v"(pmax));
  pv_mfma4(o[1], f, pa0, pa1, pa2, pa3);
  pv_reads<2>(vb, f);
  if (__builtin_expect(__all(pmax - m_reg <= THR / CF::SCALE), 1)) { mn = m_reg; alpha = 1.f; }
  else { mn = fmaxf(m_reg, pmax); alpha = __builtin_amdgcn_exp2f((m_reg - mn) * C); m_reg = mn; }
  const float mnC = -mn * C;
#pragma unroll
  for (int r = 0; r < 16; ++r) p0[r] = fmaf(p0[r], C, mnC);
#pragma unroll
  for (int r = 0; r < 16; ++r) p1[r] = fmaf(p1[r], C, mnC);
  asm volatile("" : "+v"(p0), "+v"(p1));
  pv_mfma4(o[2], f, pa0, pa1, pa2, pa3);
  pv_reads<3>(vb, f);
#pragma unroll
  for (int r = 0; r < 16; ++r) p0[r] = __builtin_amdgcn_exp2f(p0[r]);
  asm volatile("" : "+v"(p0));
  pv_mfma4(o[3], f, pa0, pa1, pa2, pa3);
}

struct Unit {
  const bf16_t* Q;
  const bf16_t* K;
  const bf16_t* V;
  bf16_t* O;
  float* LSE;
  int ldq, ldk, ldv, ldo, ldl;
  int nt;
  int qoff;
};

template <class CF, bool MASK, bool WLSE, int LDQ_ = 0, int LDK_ = 0, int LDV_ = 0, int LDO_ = 0>
__device__ __forceinline__ void attn_unit(const Unit& a, char* lds, const int tid) {
  const int ldq = LDQ_ ? LDQ_ : a.ldq, ldk = LDK_ ? LDK_ : a.ldk, ldv = LDV_ ? LDV_ : a.ldv, ldo = LDO_ ? LDO_ : a.ldo;
  constexpr int SDEPTH = CF::SDEPTH, ND0 = CF::ND0, SHM_V = CF::SHM_V, SHM_K = CF::SHM_K;
  constexpr bool QK1 = ATT_B_QK1 && CF::ND0 == 12 && !MASK;
  constexpr bool QKSPLIT = ATT_QKSPLIT && CF::ND0 == 8 && !MASK;
  const int wid = tid >> 6, lane = tid & 63, r32 = lane & 31, hi = lane >> 5;
  char* V_lds = lds; char* K_lds = lds + 2 * SHM_V;
  float* ws = (float*)(lds + CF::WS_OFF) + wid * 64; float* li_l = ws; float* al_l = ws + 32;
  float m_reg = -1e30f, l_reg = 0; f32x16 o[4] = {}; bf16x8 qr[8];
  const bf16_t* Qw = a.Q + (long)(wid * QBLK + r32) * ldq + hi * 8;
#pragma unroll
  for (int d0 = 0; d0 < CF::NQR; ++d0) qr[d0] = ld8(Qw + d0 * 16);
  char* const qx = lds + CF::QX_OFF + wid * CF::QXW + lane * 16;
  if constexpr (ND0 > 8) {
#pragma unroll
    for (int d0 = CF::NQR; d0 < ND0; ++d0) *(bf16x8*)(qx + (d0 - CF::NQR) * 1024) = ld8(Qw + d0 * 16);
  }
  const int sr = tid >> 4, sc = (tid & 15) * 8, vst0 = v_st(sr, sc), vst1 = v_st(32 + sr, sc);
  const int kst0 = sr * CF::KPITCH + ((sc * 2) ^ ((sr & CF::KSWM) << 4)), kst1 = kst0 + 32 * CF::KPITCH;
  const int kr2 = tid >> 3, kst2 = kr2 * CF::KPITCH + ((256 + (tid & 7) * 16) ^ ((kr2 & 7) << 4));
  const bf16_t* const Vg = a.V; const bf16_t* const Kg = a.K;
  const int voff0 = sr * ldv + sc, koff0 = sr * ldk + sc, koff2 = kr2 * ldk + 128 + (tid & 7) * 8;
  const int vb0 = (int)(uintptr_t)V_lds + v_rd_base(lane);
  struct { bf16x8 vs0, vs1, ks0, ks1, ks2; } sr_[SDEPTH];
#define ATT_SLOAD(i, k0) do { const bf16_t* vt_ = Vg + (long)(k0) * ldv; const bf16_t* kt_ = Kg + (long)(k0) * ldk; \
    sr_[i].vs0 = ld8(vt_ + voff0); sr_[i].vs1 = ld8(vt_ + 32 * ldv + voff0); \
    sr_[i].ks0 = ld8(kt_ + koff0); sr_[i].ks1 = ld8(kt_ + 32 * ldk + koff0); if constexpr (ND0 == 12) sr_[i].ks2 = ld8(kt_ + koff2); } while (0)
#define ATT_SWRITE(b, i) do { *(bf16x8*)(V_lds + (b) * SHM_V + vst0) = sr_[i].vs0; *(bf16x8*)(V_lds + (b) * SHM_V + vst1) = sr_[i].vs1; \
    *(bf16x8*)(K_lds + (b) * SHM_K + kst0) = sr_[i].ks0; *(bf16x8*)(K_lds + (b) * SHM_K + kst1) = sr_[i].ks1; if constexpr (ND0 == 12) *(bf16x8*)(K_lds + (b) * SHM_K + kst2) = sr_[i].ks2; } while (0)
#define ATT_SWAIT() do { if constexpr (SDEPTH == 2) { if constexpr (ND0 == 12) asm volatile("s_waitcnt vmcnt(5)" ::: "memory"); else asm volatile("s_waitcnt vmcnt(4)" ::: "memory"); } else asm volatile("s_waitcnt vmcnt(0)" ::: "memory"); } while (0)
#define ATT_RESC(al) do { if (__any((al) < 1.f)) { if (hi == 0) al_l[r32] = (al); asm volatile("s_waitcnt lgkmcnt(0)" ::: "memory"); \
    _Pragma("unroll") for (int d = 0; d < 4; ++d) _Pragma("unroll") for (int r = 0; r < 16; ++r) o[d][r] *= al_l[crow(r, hi)]; } } while (0)
  f32x16 pA0, pA1, pB0, pB1; float mnA, mnB, alA, alB; bf16x8 pa0, pa1, pa2, pa3; const int NT = a.nt;
  const int qi = a.qoff + wid * QBLK + r32;
  constexpr int SE = 0, SO = SDEPTH - 1;
  ATT_SLOAD(SE, 0); asm volatile("s_waitcnt vmcnt(0)" ::: "memory"); ATT_SWRITE(0, SE); ATT_SYNC();
  qkt<CF>(pA0, pA1, K_lds, qr, qx, r32, hi); if constexpr (MASK) bandmask(pA0, pA1, 0, qi, hi); partialSM<CF>(pA0, pA1, m_reg, mnA, alA);
  ATT_SLOAD(SO, KVBLK); if constexpr (SDEPTH == 2) { if (2 < NT) ATT_SLOAD(SE, 2 * KVBLK); }
  ATT_SWAIT(); ATT_SWRITE(1, SO); ATT_SYNC();
  for (int j = 1; j + 1 < NT; j += 2) {
    ATT_SBAR(); if constexpr (QKSPLIT) qk_sm<CF>(pB0, pB1, K_lds + SHM_K, qr, r32, hi, pA0, pA1, alA, l_reg, pa0, pa1, pa2, pa3);
    else if constexpr (QK1) qk_sm1<CF>(pB0, pB1, K_lds + SHM_K, qr, qx, r32, hi, pA0, pA1, alA, l_reg, pa0, pa1, pa2, pa3);
    else { qkt<CF>(pB0, pB1, K_lds + SHM_K, qr, qx, r32, hi); if constexpr (MASK) bandmask(pB0, pB1, j * KVBLK, qi, hi);
    finishSM(pA0, pA1, alA, l_reg, pa0, pa1, pa2, pa3); } ATT_SBAR();
    ATT_SLOAD(SO, (j + SDEPTH) * KVBLK); ATT_SBAR();
    PV_SM(o, vb0, pa0, pa1, pa2, pa3, pB0, pB1, m_reg, mnB, alB);
    ATT_SYNC(); ATT_SWAIT(); ATT_SWRITE(0, SE);
    ATT_RESC(alB); ATT_SYNC();
    ATT_SBAR(); if constexpr (QKSPLIT) qk_sm<CF>(pA0, pA1, K_lds, qr, r32, hi, pB0, pB1, alB, l_reg, pa0, pa1, pa2, pa3);
    else if constexpr (QK1) qk_sm1<CF>(pA0, pA1, K_lds, qr, qx, r32, hi, pB0, pB1, alB, l_reg, pa0, pa1, pa2, pa3);
    else { qkt<CF>(pA0, pA1, K_lds, qr, qx, r32, hi); if constexpr (MASK) bandmask(pA0, pA1, (j + 1) * KVBLK, qi, hi);
    finishSM(pB0, pB1, alB, l_reg, pa0, pa1, pa2, pa3); } ATT_SBAR();
    if (SDEPTH == 1 || j + 3 < NT) ATT_SLOAD(SE, (j + 1 + SDEPTH) * KVBLK); ATT_SBAR();
    PV_SM(o, vb0 + SHM_V, pa0, pa1, pa2, pa3, pA0, pA1, m_reg, mnA, alA);
    ATT_SYNC(); ATT_SWAIT(); ATT_SWRITE(1, SO);
    ATT_RESC(alA); ATT_SYNC();
  }
  ATT_SBAR(); if constexpr (QKSPLIT) qk_sm<CF>(pB0, pB1, K_lds + SHM_K, qr, r32, hi, pA0, pA1, alA, l_reg, pa0, pa1, pa2, pa3);
  else if constexpr (QK1) qk_sm1<CF>(pB0, pB1, K_lds + SHM_K, qr, qx, r32, hi, pA0, pA1, alA, l_reg, pa0, pa1, pa2, pa3);
  else { qkt<CF>(pB0, pB1, K_lds + SHM_K, qr, qx, r32, hi); if constexpr (MASK) bandmask(pB0, pB1, (NT - 1) * KVBLK, qi, hi);
  finishSM(pA0, pA1, alA, l_reg, pa0, pa1, pa2, pa3); } ATT_SBAR();
  PV_SM(o, vb0, pa0, pa1, pa2, pa3, pB0, pB1, m_reg, mnB, alB);
  ATT_SYNC(); ATT_RESC(alB);
  finishSM(pB0, pB1, alB, l_reg, pa0, pa1, pa2, pa3); ATT_SBAR();
  pv_d0(o, vb0 + SHM_V, pa0, pa1, pa2, pa3);
  int lane_e; asm volatile("v_mbcnt_lo_u32_b32 %0, -1, 0\n\tv_mbcnt_hi_u32_b32 %0, -1, %0" : "=v"(lane_e));
  const int r32e = lane_e & 31, hie = lane_e >> 5;
  if (hie == 0) li_l[r32e] = l_reg; asm volatile("s_waitcnt lgkmcnt(0)" ::: "memory");
  float rli[16];
#pragma unroll
  for (int r = 0; r < 16; ++r) rli[r] = __builtin_amdgcn_rcpf(li_l[crow(r, hie)]);
  if constexpr (WLSE) { if (hie == 0) a.LSE[(long)(wid * QBLK + r32e) * a.ldl] = m_reg * CF::SCALE + __logf(l_reg); }
#ifdef ATT_EPI_DIRECT
  { bf16_t* Ow = a.O + (long)(wid * QBLK) * ldo;
#pragma unroll
  for (int r = 0; r < 16; ++r) { const int orow = crow(r, hi);
#pragma unroll
    for (int d0 = 0; d0 < 4; ++d0) Ow[(long)orow * ldo + d0 * 32 + r32] = (unsigned short)cvtpk(o[d0][r] * rli[r], 0.f); } }
  ATT_SYNC();
#else
  ATT_SYNC();
  char* Ost = lds + wid * CF::OST_WAVE;
#pragma unroll
  for (int r = 0; r < 16; ++r) { const int orow = crow(r, hie);
#pragma unroll
    for (int d0 = 0; d0 < 4; ++d0) { const float v = o[d0][r] * rli[r]; *(unsigned short*)(Ost + orow * CF::OST_PITCH + (d0 * 32 + r32e) * 2) = (unsigned short)cvtpk(v, v); } }
  asm volatile("s_waitcnt lgkmcnt(0)" ::: "memory");
  bf16_t* Ow = a.O + (long)(wid * QBLK) * ldo;
#pragma unroll
  for (int i = 0; i < 8; ++i) { const int c = lane_e + 64 * i, row = c >> 4, ch = c & 15;
    const u32x4 v = *(const u32x4*)(Ost + row * CF::OST_PITCH + ch * 16); *(u32x4*)(Ow + (long)row * ldo + ch * 8) = v; }
  asm volatile("s_waitcnt lgkmcnt(0)" ::: "memory");
  ATT_SYNC();
#endif
#undef ATT_SLOAD
#undef ATT_SWRITE
#undef ATT_SWAIT
#undef ATT_RESC
}

template <class CF, bool MASK, bool WLSE, int LDQ_ = 0, int LDK_ = 0, int LDV_ = 0, int LDO_ = 0>
__device__ __forceinline__ void attn_unit3(const Unit& a, char* lds, const int tid) {
  const int ldq = LDQ_ ? LDQ_ : a.ldq, ldk = LDK_ ? LDK_ : a.ldk, ldv = LDV_ ? LDV_ : a.ldv, ldo = LDO_ ? LDO_ : a.ldo;
  constexpr int ND0 = CF::ND0, SHM_V = CF::SHM_V, SHM_K = CF::SHM_K;
  const int wid = tid >> 6, lane = tid & 63, r32 = lane & 31, hi = lane >> 5;
  char* V_lds = lds; char* K_lds = lds + 3 * SHM_V;
  float* ws = (float*)(lds + CF::WS3_OFF) + wid * 64; float* li_l = ws; float* al_l = ws + 32;
  float m_reg = -1e30f, l_reg = 0; f32x16 o[4] = {}; bf16x8 qr[8];
  const bf16_t* Qw = a.Q + (long)(wid * QBLK + r32) * ldq + hi * 8;
#pragma unroll
  for (int d0 = 0; d0 < 8; ++d0) qr[d0] = ld8(Qw + d0 * 16);
  char* const qx = lds + CF::QX3_OFF + wid * 4096 + lane * 16;
  if constexpr (ND0 > 8) {
#pragma unroll
    for (int d0 = 8; d0 < ND0; ++d0) *(bf16x8*)(qx + (d0 - 8) * 1024) = ld8(Qw + d0 * 16);
  }
  const int sr = tid >> 4, sc = (tid & 15) * 8, vst0 = v_st(sr, sc), vst1 = v_st(32 + sr, sc);
  const int kst0 = sr * CF::KPITCH + ((sc * 2) ^ ((sr & CF::KSWM) << 4)), kst1 = kst0 + 32 * CF::KPITCH;
  const int kr2 = tid >> 3, kst2 = kr2 * CF::KPITCH + ((256 + (tid & 7) * 16) ^ ((kr2 & 7) << 4));
  const bf16_t* const Vg = a.V; const bf16_t* const Kg = a.K;
  const int voff0 = sr * ldv + sc, koff0 = sr * ldk + sc, koff2 = kr2 * ldk + 128 + (tid & 7) * 8;
  const int vb0 = (int)(uintptr_t)V_lds + v_rd_base(lane);
  struct { bf16x8 vs0, vs1, ks0, ks1, ks2; } sr_[2];
#define ATT_SLOAD(i, k0) do { const bf16_t* vt_ = Vg + (long)(k0) * ldv; const bf16_t* kt_ = Kg + (long)(k0) * ldk; \
    sr_[i].vs0 = ld8(vt_ + voff0); sr_[i].vs1 = ld8(vt_ + 32 * ldv + voff0); \
    sr_[i].ks0 = ld8(kt_ + koff0); sr_[i].ks1 = ld8(kt_ + 32 * ldk + koff0); if constexpr (ND0 == 12) sr_[i].ks2 = ld8(kt_ + koff2); } while (0)
#define ATT_SWRITE(b, i) do { *(bf16x8*)(V_lds + (b) * SHM_V + vst0) = sr_[i].vs0; *(bf16x8*)(V_lds + (b) * SHM_V + vst1) = sr_[i].vs1; \
    *(bf16x8*)(K_lds + (b) * SHM_K + kst0) = sr_[i].ks0; *(bf16x8*)(K_lds + (b) * SHM_K + kst1) = sr_[i].ks1; if constexpr (ND0 == 12) *(bf16x8*)(K_lds + (b) * SHM_K + kst2) = sr_[i].ks2; } while (0)
#define ATT_SWAIT() do { if constexpr (ND0 == 12) asm volatile("s_waitcnt vmcnt(5)" ::: "memory"); else asm volatile("s_waitcnt vmcnt(4)" ::: "memory"); } while (0)
#define ATT_RESC(al) do { if (__any((al) < 1.f)) { if (hi == 0) al_l[r32] = (al); asm volatile("s_waitcnt lgkmcnt(0)" ::: "memory"); \
    _Pragma("unroll") for (int d = 0; d < 4; ++d) _Pragma("unroll") for (int r = 0; r < 16; ++r) o[d][r] *= al_l[crow(r, hi)]; } } while (0)
#define ATT_ROT() do { prv = cur; cur = nxt; nxt = (nxt == 2) ? 0 : nxt + 1; } while (0)
  f32x16 pA0, pA1, pB0, pB1; float mnA, mnB, alA, alB; bf16x8 pa0, pa1, pa2, pa3; const int NT = a.nt;
  const int qi = a.qoff + wid * QBLK + r32;
  int prv = 2, cur = 0, nxt = 1;
  ATT_SLOAD(0, 0); ATT_SLOAD(1, KVBLK); asm volatile("s_waitcnt vmcnt(0)" ::: "memory"); ATT_SWRITE(0, 0); ATT_SWRITE(1, 1);
  if (2 < NT) ATT_SLOAD(0, 2 * KVBLK); if (3 < NT) ATT_SLOAD(1, 3 * KVBLK);
  asm volatile("s_waitcnt lgkmcnt(0)" ::: "memory"); ATT_SYNC();
  qkt<CF>(pA0, pA1, K_lds, qr, qx, r32, hi); if constexpr (MASK) bandmask(pA0, pA1, 0, qi, hi); partialSM<CF>(pA0, pA1, m_reg, mnA, alA);
  ATT_ROT();
  for (int j = 1; j + 1 < NT; j += 2) {
    asm volatile("s_waitcnt lgkmcnt(0)" ::: "memory"); ATT_SYNC();
    ATT_SWAIT(); ATT_SWRITE(nxt, 0); if (j + 3 < NT) ATT_SLOAD(0, (j + 3) * KVBLK);
    ATT_SBAR(); qkt<CF>(pB0, pB1, K_lds + cur * SHM_K, qr, qx, r32, hi); if constexpr (MASK) bandmask(pB0, pB1, j * KVBLK, qi, hi);
    finishSM(pA0, pA1, alA, l_reg, pa0, pa1, pa2, pa3); ATT_SBAR();
    pv_d0(o, vb0 + prv * SHM_V, pa0, pa1, pa2, pa3); partialSM<CF>(pB0, pB1, m_reg, mnB, alB);
    ATT_RESC(alB); ATT_ROT();
    asm volatile("s_waitcnt lgkmcnt(0)" ::: "memory"); ATT_SYNC();
    ATT_SWAIT(); ATT_SWRITE(nxt, 1); if (j + 4 < NT) ATT_SLOAD(1, (j + 4) * KVBLK);
    ATT_SBAR(); qkt<CF>(pA0, pA1, K_lds + cur * SHM_K, qr, qx, r32, hi); if constexpr (MASK) bandmask(pA0, pA1, (j + 1) * KVBLK, qi, hi);
    finishSM(pB0, pB1, alB, l_reg, pa0, pa1, pa2, pa3); ATT_SBAR();
    pv_d0(o, vb0 + prv * SHM_V, pa0, pa1, pa2, pa3); partialSM<CF>(pA0, pA1, m_reg, mnA, alA);
    ATT_RESC(alA); ATT_ROT();
  }
  asm volatile("s_waitcnt lgkmcnt(0)" ::: "memory"); ATT_SYNC();
  ATT_SBAR(); qkt<CF>(pB0, pB1, K_lds + cur * SHM_K, qr, qx, r32, hi); if constexpr (MASK) bandmask(pB0, pB1, (NT - 1) * KVBLK, qi, hi);
  finishSM(pA0, pA1, alA, l_reg, pa0, pa1, pa2, pa3); ATT_SBAR();
  pv_d0(o, vb0 + prv * SHM_V, pa0, pa1, pa2, pa3); partialSM<CF>(pB0, pB1, m_reg, mnB, alB);
  ATT_RESC(alB);
  finishSM(pB0, pB1, alB, l_reg, pa0, pa1, pa2, pa3); ATT_SBAR();
  pv_d0(o, vb0 + cur * SHM_V, pa0, pa1, pa2, pa3);
  if (hi == 0) li_l[r32] = l_reg; asm volatile("s_waitcnt lgkmcnt(0)" ::: "memory");
  float rli[16];
#pragma unroll
  for (int r = 0; r < 16; ++r) rli[r] = __builtin_amdgcn_rcpf(li_l[crow(r, hi)]);
  if constexpr (WLSE) { if (hi == 0) a.LSE[(long)(wid * QBLK + r32) * a.ldl] = m_reg * CF::SCALE + __logf(l_reg); }
  ATT_SYNC();
  char* Ost = lds + wid * CF::OST_WAVE;
#pragma unroll
  for (int r = 0; r < 16; ++r) { const int orow = crow(r, hi);
#pragma unroll
    for (int d0 = 0; d0 < 4; ++d0) { const float v = o[d0][r] * rli[r]; *(unsigned short*)(Ost + orow * CF::OST_PITCH + (d0 * 32 + r32) * 2) = (unsigned short)cvtpk(v, v); } }
  asm volatile("s_waitcnt lgkmcnt(0)" ::: "memory");
  bf16_t* Ow = a.O + (long)(wid * QBLK) * ldo;
#pragma unroll
  for (int i = 0; i < 8; ++i) { const int c = lane + 64 * i, row = c >> 4, ch = c & 15;
    const u32x4 v = *(const u32x4*)(Ost + row * CF::OST_PITCH + ch * 16); *(u32x4*)(Ow + (long)row * ldo + ch * 8) = v; }
  asm volatile("s_waitcnt lgkmcnt(0)" ::: "memory");
  ATT_SYNC();
#undef ATT_SLOAD
#undef ATT_SWRITE
#undef ATT_SWAIT
#undef ATT_RESC
#undef ATT_ROT
}
}
__device__ const float RF64_HI[32] = {1.591549367e-01f, 1.193493679e-01f, 8.949939907e-02f, 6.711508334e-02f, 5.032921210e-02f, 3.774158657e-02f, 2.830219641e-02f, 2.122365311e-02f, 1.591549441e-02f, 1.193493698e-02f, 8.949940093e-03f, 6.711508147e-03f, 5.032921210e-03f, 3.774158424e-03f, 2.830219688e-03f, 2.122365171e-03f, 1.591549488e-03f, 1.193493721e-03f, 8.949940093e-04f, 6.711508031e-04f, 5.032921326e-04f, 3.774158540e-04f, 2.830219455e-04f, 2.122365258e-04f, 1.591549371e-04f, 1.193493736e-04f, 8.949940093e-05f, 6.711508468e-05f, 5.032921035e-05f, 3.774158540e-05f, 2.830219637e-05f, 2.122365186e-05f};
__device__ const float RF64_LO[32] = {6.420638243e-09f, 2.294664903e-09f, 2.542919653e-09f, -3.316028840e-10f, 5.173299289e-12f, -1.848551645e-09f, -5.826552019e-10f, -3.431038786e-10f, -1.029942243e-10f, 4.320196978e-11f, 6.802745173e-11f, 1.531042237e-10f, 5.173301024e-13f, 4.797548470e-11f, -1.048316434e-10f, 1.053879969e-10f, -5.686555046e-11f, -1.896286773e-11f, 6.802744999e-12f, 2.695195456e-11f, -1.158979943e-11f, -6.843983713e-12f, 1.279990003e-11f, 1.807650600e-12f, 5.954976963e-12f, -3.351478166e-12f, 6.802745216e-13f, -1.670379113e-12f, 1.751403167e-12f, -6.843983930e-13f, -5.389994549e-13f, 9.083608431e-13f};
__device__ const float RF32_HI[16] = {1.591549367e-01f, 7.008652389e-02f, 3.086376376e-02f, 1.359137055e-02f, 5.985185504e-03f, 2.635675948e-03f, 1.160663669e-03f, 5.111175124e-04f, 2.250790858e-04f, 9.911730740e-05f, 4.364795313e-05f, 1.922110096e-05f, 8.464330676e-06f, 3.727408512e-06f, 1.641426252e-06f, 7.228293271e-07f};
__device__ const float RF32_LO[16] = {6.420638243e-09f, -2.302696700e-09f, -3.597993847e-10f, 9.086624508e-11f, 2.087540557e-10f, -4.944578774e-11f, -2.775752544e-11f, -7.822671330e-12f, -6.755001072e-12f, 1.969154007e-12f, -3.416928741e-13f, -2.712567042e-13f, 1.318804142e-13f, 9.029300745e-14f, 1.098673646e-14f, -2.017673985e-14f};
constexpr int DM = 2048, DFF = 8192, DEPTH = 4, PLED = 256;
constexpr int NTOK = 65536, NPROMPT = 32768, SEQ_P = 4096, SEQ_S = 8192;
constexpr int CT = 32768, NCH = NTOK / CT;
constexpr float EPS = 1e-6f;
constexpr int NWAVES = 8;
enum { I_XP = 0, I_XS, I_PP, I_PS, I_NMIX, I_NMLP, I_WIN, I_WOUT, I_WPLE, I_PLEG, I_GATEG, I_WGATE,
       I_AQKV, I_AQG, I_AKG, I_AO, I_BDQ, I_BCQG, I_BCKVG, I_BUQ, I_BUKV, I_BQG, I_BKG, I_BO, I_CQKV, I_CQG, I_CKG, I_CO, N_IN };
constexpr size_t SZ_IN = (size_t)DFF * DM, SZ_OUT = (size_t)DM * DFF, SZ_PLE = (size_t)DM * PLED, SZ_GATE = (size_t)DM * DM;
constexpr size_t SZ_AQKV = (size_t)3072 * DM, SZ_AO = (size_t)DM * DM;
constexpr size_t SZ_BDQ = (size_t)1280 * DM, SZ_BUQ = (size_t)3072 * 512, SZ_BUKV = (size_t)4096 * 512, SZ_BO = (size_t)DM * DM;
constexpr size_t SZ_CQKV = (size_t)9216 * DM, SZ_CO = (size_t)DM * 1024;
constexpr size_t OFF_IN = 0, OFF_OUT = OFF_IN + 4 * SZ_IN, OFF_PLE = OFF_OUT + 4 * SZ_OUT, OFF_GATE = OFF_PLE + 4 * SZ_PLE;
constexpr size_t OFF_AQKV = OFF_GATE + 4 * SZ_GATE, OFF_AO = OFF_AQKV + 2 * SZ_AQKV;
constexpr size_t OFF_BDQ = OFF_AO + 2 * SZ_AO, OFF_BUQ = OFF_BDQ + SZ_BDQ, OFF_BUKV = OFF_BUQ + SZ_BUQ, OFF_BO = OFF_BUKV + SZ_BUKV;
constexpr size_t OFF_CQKV = OFF_BO + SZ_BO, OFF_CO = OFF_CQKV + SZ_CQKV, WT_TOTAL = OFF_CO + SZ_CO;
constexpr size_t MiB = 1u << 20;
constexpr size_t WS_CTL = 0, CTL_ZERO_BYTES = 1 * MiB;
constexpr size_t WS_T64 = 1 * MiB;
constexpr size_t WS_T32 = 3 * MiB;
constexpr size_t WS_RSTD = 4 * MiB;
constexpr size_t WS_LSE = 5 * MiB;
constexpr size_t WS_RS = 4 * MiB + 512 * 1024;
constexpr size_t WS_SSP = 8 * MiB;
constexpr size_t WS_SSPE = 12 * MiB;
constexpr size_t WS_WT = 16 * MiB;
constexpr size_t WS_H = WS_WT + ((WT_TOTAL * 2 + MiB - 1) / MiB) * MiB;
constexpr size_t WS_PB = WS_H + (size_t)CT * DM * 2;
constexpr size_t WS_E0 = WS_PB + (size_t)CT * PLED * 2;
constexpr size_t WS_BIG = WS_E0 + (size_t)CT * DM * 2;
constexpr size_t CTB = (size_t)CT * 2;
constexpr size_t B_HID = 0;
constexpr size_t A_QKV = 0, A_O = A_QKV + CTB * 3072;
constexpr size_t BB_LAT = 0, BB_CQ = BB_LAT + CTB * 1280, BB_CKV = BB_CQ + CTB * 512, BB_QB = BB_CKV + CTB * 512, BB_KVB = BB_QB + CTB * 3072, BB_KF = BB_KVB + CTB * 4096, BB_END = BB_KF + CTB * 3072;
constexpr size_t BB_O = 0;
static_assert(CTB * 2048 <= BB_QB, "O overlay");
constexpr size_t C_QKV = 0, C_OG = C_QKV + CTB * 9216, C_END = C_OG + 3 * CTB * 1024;
constexpr size_t BIG_BYTES = BB_END > CTB * 8192 ? (BB_END > C_END ? BB_END : C_END) : (CTB * 8192 > C_END ? CTB * 8192 : C_END);
constexpr size_t WS_END = WS_BIG + BIG_BYTES;

constexpr int CW_BAR = 4096;
constexpr int RING_BYTES = 131072, LDSCTL_OFF = RING_BYTES, MISC_OFF = LDSCTL_OFF + 320, LDS_BYTES = 147456;
constexpr int QKP_OFF = RING_BYTES + 1024;
static_assert(QKP_OFF + 8192 <= LDS_BYTES && MISC_OFF + 128 <= QKP_OFF, "LDS map");

#define GAS __attribute__((address_space(1)))
#define LAS __attribute__((address_space(3)))
typedef unsigned short bf16;
typedef unsigned v4u __attribute__((ext_vector_type(4)));
typedef unsigned v2u __attribute__((ext_vector_type(2)));
typedef float f32x4 __attribute__((ext_vector_type(4)));
typedef float f32x2 __attribute__((ext_vector_type(2)));
#define LDS_WAIT() asm volatile("s_waitcnt lgkmcnt(0)" ::: "memory")
#define VM_WAIT() asm volatile("s_waitcnt vmcnt(0)" ::: "memory")
__device__ __forceinline__ unsigned pk2(float lo, float hi) { unsigned r; asm volatile("v_cvt_pk_bf16_f32 %0, %1, %2" : "=v"(r) : "v"(lo), "v"(hi)); return r; }
__device__ __forceinline__ float bflo(unsigned w) { return __uint_as_float(w << 16); }
__device__ __forceinline__ float bfhi(unsigned w) { return __uint_as_float(w & 0xffff0000u); }

#define XB_TMO      128
#define XB_XCNT(j)  (256  + 64 * (j))
#define XB_XSUB(j)  (1280 + 64 * (j))
#define XB_XGEN(j)  (2304 + 64 * (j))
#define XB_TOP      3328
#define XB_TOPGEN   3392
#define XCD_BAR_WORDS 3456
#define XB_SPIN_CAP (1u << 18)
__device__ __forceinline__ unsigned xb_ld(unsigned* p)              { return __hip_atomic_load(p, __ATOMIC_RELAXED, __HIP_MEMORY_SCOPE_AGENT); }
__device__ __forceinline__ unsigned xb_add(unsigned* p, unsigned v) { return __hip_atomic_fetch_add(p, v, __ATOMIC_RELAXED, __HIP_MEMORY_SCOPE_AGENT); }
__device__ __forceinline__ unsigned xb_xcc_id() { return (unsigned)__builtin_amdgcn_s_getreg((3 << 11) | 20) & 0xFu; }
#define XB_SPIN(cond, bar) do { unsigned _sp = 0; while (cond) { __builtin_amdgcn_s_sleep(1); \
    if ((++_sp & 255u) == 0u) { if (xb_ld(&(bar)[XB_TMO])) break; if (_sp > XB_SPIN_CAP) { atomicAdd(&(bar)[XB_TMO], 1u); break; } } } } while (0)
struct XcdBarrier { unsigned* bar; unsigned x; volatile LAS unsigned* st; };
__device__ __forceinline__ XcdBarrier xcd_barrier_post(unsigned* bar, volatile LAS unsigned* st) {
    XcdBarrier b; b.bar = bar; b.x = xb_xcc_id(); b.st = st;
    if (threadIdx.x == 0) (void)xb_add(&bar[XB_XCNT(b.x)], 1u);
    return b;
}
__device__ __forceinline__ void xcd_barrier_complete(unsigned* bar, unsigned x, unsigned& nloc, unsigned& nx) {
    const unsigned G = gridDim.x * gridDim.y * gridDim.z;
    unsigned sum, cnt, mine, sp = 0u;
    for (;;) {
        sum = 0u; cnt = 0u; mine = 0u;
#pragma unroll
        for (unsigned j = 0; j < 16; ++j) { const unsigned c = xb_ld(&bar[XB_XCNT(j)]); sum += c; cnt += (c > 0u) ? 1u : 0u; mine = (j == x) ? c : mine; }
        if (sum == G) break;
        __builtin_amdgcn_s_sleep(1);
        if ((++sp & 255u) == 0u) { if (xb_ld(&bar[XB_TMO])) break; if (sp > XB_SPIN_CAP) { atomicAdd(&bar[XB_TMO], 1u); break; } }
    }
    nloc = mine > 0u ? mine : 1u; nx = cnt > 0u ? cnt : 1u;
}
__device__ __forceinline__ void xcd_barrier(const XcdBarrier& b) {
    asm volatile("s_waitcnt vmcnt(0)" ::: "memory");
    __syncthreads();
    if (threadIdx.x == 0) {
        unsigned* bar = b.bar; asm volatile("" : "+s"(bar));
        __builtin_amdgcn_s_waitcnt(0);
        unsigned bx_ = xb_xcc_id(); asm volatile("" : "+s"(bx_));
        unsigned nloc = b.st[0], nx = b.st[1];
        if (nloc == 0u) { xcd_barrier_complete(bar, bx_, nloc, nx); b.st[0] = nloc; b.st[1] = nx; }
        const unsigned old = xb_add(&bar[XB_XSUB(bx_)], 1u);
        const unsigned gen = old / nloc;
        if (old + 1u == (gen + 1u) * nloc) {
            __builtin_amdgcn_fence(__ATOMIC_RELEASE, "agent");
            asm volatile("s_waitcnt vmcnt(0)" ::: "memory");
            const unsigned og = xb_add(&bar[XB_TOP], 1u);
            const unsigned tg = og / nx;
            if (og + 1u == (tg + 1u) * nx) xb_add(&bar[XB_TOPGEN], 1u);
            else XB_SPIN(xb_ld(&bar[XB_TOPGEN]) == tg, bar);
            __builtin_amdgcn_fence(__ATOMIC_ACQUIRE, "agent");
            xb_add(&bar[XB_XGEN(bx_)], 1u);
            asm volatile("s_waitcnt vmcnt(0)" ::: "memory");
        } else {
            XB_SPIN(xb_ld(&bar[XB_XGEN(bx_)]) == gen, bar);
            __builtin_amdgcn_fence(__ATOMIC_ACQUIRE, "agent");
            asm volatile("s_waitcnt vmcnt(0)" ::: "memory");
        }
    }
    __syncthreads();
}

__device__ __forceinline__ float shx(float v, int lane, int o) { return __int_as_float(__builtin_amdgcn_ds_bpermute((lane ^ o) << 2, __float_as_int(v))); }
__device__ __forceinline__ float wave_sum(float v, int lane) {
#pragma unroll
    for (int o = 1; o < 64; o <<= 1) v += shx(v, lane, o);
    return v;
}
__device__ __forceinline__ float sum16(float v, int lane) {
#pragma unroll
    for (int o = 1; o < 16; o <<= 1) v += shx(v, lane, o);
    return v;
}
__device__ __forceinline__ void unpack8(const v4u w, float (&f)[8]) { f[0] = bflo(w.x); f[1] = bfhi(w.x); f[2] = bflo(w.y); f[3] = bfhi(w.y); f[4] = bflo(w.z); f[5] = bfhi(w.z); f[6] = bflo(w.w); f[7] = bfhi(w.w); }
__device__ __forceinline__ v4u pack8(const float (&f)[8]) { v4u w; w.x = pk2(f[0], f[1]); w.y = pk2(f[2], f[3]); w.z = pk2(f[4], f[5]); w.w = pk2(f[6], f[7]); return w; }

__device__ __forceinline__ int qk_phys_col(int c, int pmode) {
    if (pmode == 1 && c < 2560) { const int d = c & 127, half = d >> 6, r = d & 63, member = r >> 5, j = r & 31, w = half * 2 + (j >> 4), jj = j & 15; return (c & ~127) + w * 32 + (jj >> 2) * 8 + (jj & 3) * 2 + member; }
    if (pmode == 2 && c < 6144) { const int d = c & 127; if (d < 32) { const int member = d >> 4, j = d & 15; return (c & ~127) + (j >> 2) * 8 + (j & 3) * 2 + member; } }
    return c;
}
__device__ __forceinline__ void p0_transpose_item(const float* W, const float* gk, int K, int N, bf16* WT, LAS float* scr, int item, int lane, int pmode) {
    const int nblk = N / 32, kb = item / nblk, nb = item % nblk, k0 = 64 * kb, n0 = 32 * nb;
    const float* wp = W + (size_t)(k0 + (lane >> 5)) * N + n0 + (lane & 31);
    float wv[32];
#pragma unroll
    for (int i = 0; i < 32; ++i) wv[i] = wp[(size_t)(2 * i) * N];
#pragma unroll
    for (int i = 0; i < 32; ++i) scr[(2 * i + (lane >> 5)) * 33 + (lane & 31)] = wv[i];
    LDS_WAIT(); asm volatile("" ::: "memory");
    const int c = lane & 7;
    f32x4 g0 = {1.f, 1.f, 1.f, 1.f}, g1 = {1.f, 1.f, 1.f, 1.f};
    if (gk) { g0 = *(const f32x4*)(gk + k0 + 8 * c); g1 = *(const f32x4*)(gk + k0 + 8 * c + 4); }
#pragma unroll
    for (int j = 0; j < 4; ++j) { const int n = (lane >> 3) + 8 * j; const LAS float* s = scr + (8 * c) * 33 + n;
        v4u o; o.x = pk2(s[0 * 33] * g0[0], s[1 * 33] * g0[1]); o.y = pk2(s[2 * 33] * g0[2], s[3 * 33] * g0[3]); o.z = pk2(s[4 * 33] * g1[0], s[5 * 33] * g1[1]); o.w = pk2(s[6 * 33] * g1[2], s[7 * 33] * g1[3]);
        *(GAS v4u*)(WT + (size_t)qk_phys_col(n0 + n, pmode) * K + k0 + 8 * c) = o; }
    LDS_WAIT(); asm volatile("" ::: "memory");
}

__device__ __forceinline__ void norm_rows(const float* __restrict__ src, float* __restrict__ cpy, bf16* __restrict__ H, const float* __restrict__ g,
                                          const bf16* __restrict__ e0, float* __restrict__ rs_out, int nrows, int gw, int NGW, int lane) {
    f32x4 gv[8];
#pragma unroll
    for (int j = 0; j < 8; ++j) gv[j] = ((const f32x4*)g)[lane + 64 * j];
    for (int m = gw; m < nrows; m += NGW) {
        const f32x4* xr = (const f32x4*)(src + (size_t)m * DM) + lane;
        f32x4 v[8]; float s = 0.f;
#pragma unroll
        for (int j = 0; j < 8; ++j) { v[j] = xr[64 * j]; s += (v[j].x * v[j].x + v[j].y * v[j].y) + (v[j].z * v[j].z + v[j].w * v[j].w); }
        if (cpy) { f32x4* cr = (f32x4*)(cpy + (size_t)m * DM) + lane;
#pragma unroll
            for (int j = 0; j < 8; ++j) cr[64 * j] = v[j]; }
        const float rstd = __builtin_amdgcn_rsqf(wave_sum(s, lane) * (1.f / DM) + EPS);
        v2u* o8 = (v2u*)(H + (size_t)m * DM) + lane;
#pragma unroll
        for (int j = 0; j < 8; ++j) { const f32x4 y = v[j] * rstd * gv[j]; v2u w; w.x = pk2(y.x, y.y); w.y = pk2(y.z, y.w); o8[64 * j] = w; }
        if (e0) {
            const v4u* er = (const v4u*)(e0 + (size_t)m * DM) + lane; float q = 0.f;
#pragma unroll
            for (int j = 0; j < 4; ++j) { float f[8]; unpack8(er[64 * j], f);
#pragma unroll
                for (int t = 0; t < 8; ++t) q += f[t] * f[t]; }
            q = wave_sum(q, lane);
            if (lane == 0) rs_out[m] = __builtin_amdgcn_rsqf(q * (1.f / DM) + EPS);
        }
    }
}

__device__ __forceinline__ void init_rows(const float* __restrict__ src, bf16* __restrict__ XB, float* __restrict__ ssp, int nrows, int gw, int NGW, int lane) {
    for (int m = gw; m < nrows; m += NGW) {
        const f32x4* xr = (const f32x4*)(src + (size_t)m * DM) + lane; v2u* o8 = (v2u*)(XB + (size_t)m * DM) + lane;
        f32x4 v[8]; float s = 0.f;
#pragma unroll
        for (int j = 0; j < 8; ++j) v[j] = xr[64 * j];
#pragma unroll
        for (int j = 0; j < 8; ++j) { s += (v[j].x * v[j].x + v[j].y * v[j].y) + (v[j].z * v[j].z + v[j].w * v[j].w); v2u w; w.x = pk2(v[j].x, v[j].y); w.y = pk2(v[j].z, v[j].w); o8[64 * j] = w; }
        s = wave_sum(s, lane);
        if (lane < 32) ssp[(size_t)m * 32 + lane] = lane == 0 ? s : 0.f;
    }
}
__device__ __forceinline__ void rs_rows(const float* __restrict__ ssp, float* __restrict__ rs, const float* __restrict__ ssp2, float* __restrict__ rs2, int nrows, int gw, int NGW, int lane) {
    constexpr int NB = 8;
    for (int p0 = gw; p0 < nrows / 2; p0 += NGW * NB) {
        float v[NB], w[NB];
#pragma unroll
        for (int b = 0; b < NB; ++b) { const int p = p0 + b * NGW; v[b] = 0.f; w[b] = 0.f; if (p < nrows / 2) { const size_t o = (size_t)(2 * p + (lane >> 5)) * 32 + (lane & 31); v[b] = ssp[o]; if (ssp2) w[b] = ssp2[o]; } }
#pragma unroll
        for (int b = 0; b < NB; ++b) { const int p = p0 + b * NGW; if (p < nrows / 2) { const int row = 2 * p + (lane >> 5); float a = v[b], c = w[b];
#pragma unroll
            for (int o = 1; o < 32; o <<= 1) { a += shx(a, lane, o); if (ssp2) c += shx(c, lane, o); }
            if ((lane & 31) == 0) { rs[row] = __builtin_amdgcn_rsqf(a * (1.f / DM) + EPS); if (ssp2) rs2[row] = __builtin_amdgcn_rsqf(c * (1.f / DM) + EPS); } } }
    }
}
constexpr int RB = 4;
__device__ __forceinline__ void a_qknorm_rope(bf16* __restrict__ qkv, const float* __restrict__ qg, const float* __restrict__ kg, const f32x2* __restrict__ T64, int seqmask, int gw, int NGW, int lane) {
    const int q16 = lane & 15, sub = lane >> 4; const bool first = (q16 & 4) == 0;
    const f32x4 gq0 = *(const f32x4*)(qg + q16 * 8), gq1 = *(const f32x4*)(qg + q16 * 8 + 4), gk0 = *(const f32x4*)(kg + q16 * 8), gk1 = *(const f32x4*)(kg + q16 * 8 + 4);
    for (int it0 = gw; it0 < CT * 5; it0 += NGW * RB) {
        v4u raw[RB]; f32x4 cs[RB][4]; bf16* p[RB]; bool isq[RB];
#pragma unroll
        for (int b = 0; b < RB; ++b) { const int it = it0 + b * NGW; if (it < CT * 5) { const int tl = it / 5, quad = it % 5, hv = quad * 4 + sub; isq[b] = hv < 16;
            p[b] = qkv + (size_t)tl * 3072 + (hv < 16 ? hv * 128 : 2048 + (hv - 16) * 128) + q16 * 8; raw[b] = *(const v4u*)p[b];
            const int t = tl & seqmask, pos = (q16 < 8) ? (t >> 6) : (t & 63); const f32x4* c4 = (const f32x4*)(T64 + (size_t)pos * 32 + (q16 & 3) * 8);
#pragma unroll
            for (int e = 0; e < 4; ++e) cs[b][e] = c4[e]; } }
#pragma unroll
        for (int b = 0; b < RB; ++b) { const int it = it0 + b * NGW; if (it < CT * 5) {
            float f[8]; unpack8(raw[b], f); float s = 0.f;
#pragma unroll
            for (int t = 0; t < 8; ++t) s += f[t] * f[t];
            const float rstd = __builtin_amdgcn_rsqf(sum16(s, lane) * (1.f / 128.f) + EPS);
            const f32x4 g0 = isq[b] ? gq0 : gk0, g1 = isq[b] ? gq1 : gk1; float y[8], o[8];
#pragma unroll
            for (int t = 0; t < 4; ++t) { y[t] = f[t] * rstd * g0[t]; y[4 + t] = f[4 + t] * rstd * g1[t]; }
#pragma unroll
            for (int e = 0; e < 8; ++e) { const float other = shx(y[e], lane, 4); const float c = cs[b][e >> 1][(e & 1) * 2], sn = cs[b][e >> 1][(e & 1) * 2 + 1];
                o[e] = first ? (y[e] * c - other * sn) : (y[e] * c + other * sn); }
            *(v4u*)p[b] = pack8(o); } }
    }
}
__device__ __forceinline__ void b_latnorm(const bf16* __restrict__ lat, bf16* __restrict__ cq, bf16* __restrict__ ckv, const float* __restrict__ cqg, const float* __restrict__ ckvg, int gw, int NGW, int lane) {
    const f32x4 ga0 = *(const f32x4*)(cqg + lane * 8), ga1 = *(const f32x4*)(cqg + lane * 8 + 4), gb0 = *(const f32x4*)(ckvg + lane * 8), gb1 = *(const f32x4*)(ckvg + lane * 8 + 4);
    for (int it0 = gw; it0 < CT * 2; it0 += NGW * RB) {
        v4u raw[RB];
#pragma unroll
        for (int b = 0; b < RB; ++b) { const int it = it0 + b * NGW; if (it < CT * 2) raw[b] = *(const v4u*)(lat + (size_t)(it >> 1) * 1280 + (it & 1) * 512 + lane * 8); }
#pragma unroll
        for (int b = 0; b < RB; ++b) { const int it = it0 + b * NGW; if (it < CT * 2) { const int tl = it >> 1, which = it & 1;
            float f[8]; unpack8(raw[b], f); float s = 0.f;
#pragma unroll
            for (int t = 0; t < 8; ++t) s += f[t] * f[t];
            const float rstd = __builtin_amdgcn_rsqf(wave_sum(s, lane) * (1.f / 512.f) + EPS);
            const f32x4 g0 = which ? gb0 : ga0, g1 = which ? gb1 : ga1; float y[8];
#pragma unroll
            for (int t = 0; t < 4; ++t) { y[t] = f[t] * rstd * g0[t]; y[4 + t] = f[4 + t] * rstd * g1[t]; }
            *(v4u*)((which ? ckv : cq) + (size_t)tl * 512 + lane * 8) = pack8(y); } }
    }
}
__device__ __forceinline__ void b_qknorm_rope(bf16* __restrict__ qb, const bf16* __restrict__ kvb, const bf16* __restrict__ lat, bf16* __restrict__ kf, const float* __restrict__ qg, const float* __restrict__ kg,
                                              const f32x2* __restrict__ T64, int seqmask, int gw, int NGW, int lane) {
    const int q16 = lane & 15, sub = lane >> 4; const bool first = (q16 & 8) == 0;
    const f32x4 gq0 = *(const f32x4*)(qg + q16 * 8), gq1 = *(const f32x4*)(qg + q16 * 8 + 4), gq2 = *(const f32x4*)(qg + 128 + q16 * 4);
    const f32x4 gk0 = *(const f32x4*)(kg + q16 * 8), gk1 = *(const f32x4*)(kg + q16 * 8 + 4), gk2 = *(const f32x4*)(kg + 128 + q16 * 4);
    for (int it0 = gw; it0 < CT * 8; it0 += NGW * RB) {
        v4u rawn[RB]; v2u rawr[RB]; f32x4 cs[RB][2];
#pragma unroll
        for (int b = 0; b < RB; ++b) { const int it = it0 + b * NGW; if (it < CT * 8) { const int tl = it >> 3, isk = (it >> 2) & 1, h = (it & 3) * 4 + sub;
            rawn[b] = *(const v4u*)(isk ? (kvb + (size_t)tl * 4096 + h * 256 + q16 * 8) : (qb + (size_t)tl * 3072 + h * 192 + q16 * 8));
            rawr[b] = *(const v2u*)(isk ? (lat + (size_t)tl * 1280 + 1024 + q16 * 4) : (qb + (size_t)tl * 3072 + h * 192 + 128 + q16 * 4));
            const f32x4* c4 = (const f32x4*)(T64 + (size_t)(tl & seqmask) * 32 + (q16 & 7) * 4); cs[b][0] = c4[0]; cs[b][1] = c4[1]; } }
#pragma unroll
        for (int b = 0; b < RB; ++b) { const int it = it0 + b * NGW; if (it < CT * 8) { const int tl = it >> 3, isk = (it >> 2) & 1, h = (it & 3) * 4 + sub;
            bf16* on = (isk ? kf : qb) + (size_t)tl * 3072 + h * 192 + q16 * 8; bf16* orp = (isk ? kf : qb) + (size_t)tl * 3072 + h * 192 + 128 + q16 * 4;
            float f[8]; unpack8(rawn[b], f); float r[4] = {bflo(rawr[b].x), bfhi(rawr[b].x), bflo(rawr[b].y), bfhi(rawr[b].y)};
            float s = 0.f;
#pragma unroll
            for (int t = 0; t < 8; ++t) s += f[t] * f[t];
#pragma unroll
            for (int t = 0; t < 4; ++t) s += r[t] * r[t];
            const float rstd = __builtin_amdgcn_rsqf(sum16(s, lane) * (1.f / 192.f) + EPS);
            const f32x4 g0 = isk ? gk0 : gq0, g1 = isk ? gk1 : gq1, g2 = isk ? gk2 : gq2; float y[8], yr[4], o[4];
#pragma unroll
            for (int t = 0; t < 4; ++t) { y[t] = f[t] * rstd * g0[t]; y[4 + t] = f[4 + t] * rstd * g1[t]; yr[t] = r[t] * rstd * g2[t]; }
#pragma unroll
            for (int e = 0; e < 4; ++e) { const float other = shx(yr[e], lane, 8); const float c = cs[b][e >> 1][(e & 1) * 2], sn = cs[b][e >> 1][(e & 1) * 2 + 1];
                o[e] = first ? (yr[e] * c - other * sn) : (yr[e] * c + other * sn); }
            *(v4u*)on = pack8(y); v2u ow; ow.x = pk2(o[0], o[1]); ow.y = pk2(o[2], o[3]); *(v2u*)orp = ow; } }
    }
}
__device__ __forceinline__ void c_qknorm_rope(bf16* __restrict__ qkv, const float* __restrict__ qg, const float* __restrict__ kg, const f32x2* __restrict__ T32, int seqmask, int gw, int NGW, int lane) {
    const int q16 = lane & 15, sub = lane >> 4; const bool first = (q16 & 2) == 0, roped = q16 < 4;
    const f32x4 gq0 = *(const f32x4*)(qg + q16 * 8), gq1 = *(const f32x4*)(qg + q16 * 8 + 4), gk0 = *(const f32x4*)(kg + q16 * 8), gk1 = *(const f32x4*)(kg + q16 * 8 + 4);
    for (int it0 = gw; it0 < CT * 12; it0 += NGW * RB) {
        v4u raw[RB]; f32x4 cs[RB][4]; bf16* p[RB]; bool isq[RB];
#pragma unroll
        for (int b = 0; b < RB; ++b) { const int it = it0 + b * NGW; if (it < CT * 12) { const int tl = it / 12, quad = it % 12, hv = quad * 4 + sub; isq[b] = hv < 24;
            p[b] = qkv + (size_t)tl * 9216 + hv * 128 + q16 * 8; raw[b] = *(const v4u*)p[b];
            const f32x4* c4 = (const f32x4*)(T32 + (size_t)(tl & seqmask) * 16 + (q16 & 1) * 8);
#pragma unroll
            for (int e = 0; e < 4; ++e) cs[b][e] = c4[e]; } }
#pragma unroll
        for (int b = 0; b < RB; ++b) { const int it = it0 + b * NGW; if (it < CT * 12) {
            float f[8]; unpack8(raw[b], f); float s = 0.f;
#pragma unroll
            for (int t = 0; t < 8; ++t) s += f[t] * f[t];
            const float rstd = __builtin_amdgcn_rsqf(sum16(s, lane) * (1.f / 128.f) + EPS);
            const f32x4 g0 = isq[b] ? gq0 : gk0, g1 = isq[b] ? gq1 : gk1; float y[8], o[8];
#pragma unroll
            for (int t = 0; t < 4; ++t) { y[t] = f[t] * rstd * g0[t]; y[4 + t] = f[4 + t] * rstd * g1[t]; }
#pragma unroll
            for (int e = 0; e < 8; ++e) { const float other = shx(y[e], lane, 2); const float c = cs[b][e >> 1][(e & 1) * 2], sn = cs[b][e >> 1][(e & 1) * 2 + 1];
                const float rv = first ? (y[e] * c - other * sn) : (y[e] * c + other * sn); o[e] = roped ? rv : y[e]; }
            *(v4u*)p[b] = pack8(o); } }
    }
}
__device__ __forceinline__ void c_merge(const bf16* __restrict__ og, const float* __restrict__ lse, bf16* __restrict__ mrg, int gw, int NGW, int lane) {
    const int q16 = lane & 15, sub = lane >> 4;
    for (int it0 = gw; it0 < CT * 2; it0 += NGW * RB) {
        v4u ra[RB], rb[RB], rc[RB]; float l0[RB], l1[RB], l2[RB];
#pragma unroll
        for (int b = 0; b < RB; ++b) { const int it = it0 + b * NGW; if (it < CT * 2) { const int tl = it >> 1, h = (it & 1) * 4 + sub; const size_t off = (size_t)tl * 1024 + h * 128 + q16 * 8;
            l0[b] = lse[(size_t)tl * 8 + h]; l1[b] = lse[(size_t)CT * 8 + (size_t)tl * 8 + h]; l2[b] = lse[(size_t)2 * CT * 8 + (size_t)tl * 8 + h];
            ra[b] = *(const v4u*)(og + off); rb[b] = *(const v4u*)(og + (size_t)CT * 1024 + off); rc[b] = *(const v4u*)(og + (size_t)2 * CT * 1024 + off); } }
#pragma unroll
        for (int b = 0; b < RB; ++b) { const int it = it0 + b * NGW; if (it < CT * 2) { const int tl = it >> 1, h = (it & 1) * 4 + sub; const size_t off = (size_t)tl * 1024 + h * 128 + q16 * 8;
            const float mx = fmaxf(l0[b], fmaxf(l1[b], l2[b]));
            float w0 = __expf(l0[b] - mx), w1 = __expf(l1[b] - mx), w2 = __expf(l2[b] - mx); const float inv = 1.f / (w0 + w1 + w2); w0 *= inv; w1 *= inv; w2 *= inv;
            float a[8], bb[8], c[8], o[8]; unpack8(ra[b], a); unpack8(rb[b], bb); unpack8(rc[b], c);
#pragma unroll
            for (int e = 0; e < 8; ++e) o[e] = w0 * a[e] + w1 * bb[e] + w2 * c[e];
            *(v4u*)(mrg + off) = pack8(o); } }
    }
}
#ifndef ONLY
#define ONLY -1
#endif
#define PH(k) (ONLY < 0 || ONLY == (k))
#ifndef QKFUSE
#define QKFUSE 1
#endif
#ifndef ATT_PRIO
#define ATT_PRIO 1
#endif
#ifndef TS_MASK
#define TS_MASK 0u
#endif
#ifndef TS_FACTOR
#define TS_FACTOR 1
#endif
__device__ __forceinline__ bool ts_thread0(int wave_u) { int l_; asm volatile("v_mbcnt_lo_u32_b32 %0, -1, 0\n\tv_mbcnt_hi_u32_b32 %0, -1, %0" : "=v"(l_)); return wave_u == 0 && l_ == 0; }
#ifndef REP_ATTA
#define REP_ATTA 1
#endif
#ifndef REP_ATTB
#define REP_ATTB 1
#endif
#ifndef REP_MLPIN
#define REP_MLPIN 1
#endif
#ifndef REP_NORM
#define REP_NORM 1
#endif
#ifndef REP_PRO
#define REP_PRO 1
#endif
#ifndef REP_ATTC
#define REP_ATTC 1
#endif
#ifndef REP_INIT
#define REP_INIT 1
#endif
#ifndef REP_PROJ
#define REP_PROJ 1
#endif
#ifndef REP_MLPOUTK
#define REP_MLPOUTK 1
#endif
struct Args { const float* in[N_IN]; float* out; unsigned char* ws; };
typedef att::Cfg<128, 2, 0> CfgA;
typedef att::Cfg<192, 1, 1> CfgB;
typedef att::Cfg<128, 2, 0> CfgC;
static_assert(CfgA::LDS_BYTES <= RING_BYTES && CfgB::QX_END <= RING_BYTES && (CfgB::WS_OFF == CfgB::QX_END || CfgB::WS_OFF >= QKP_OFF) && CfgB::LDS_BYTES <= LDS_BYTES && CfgA::LDS3_BYTES <= RING_BYTES, "attention LDS (the words between RING_BYTES and QKP_OFF are the kernel's barrier / control words)");
#ifndef ATT_A_FN
#define ATT_A_FN att::attn_unit
#endif
#ifndef ATT_C_FN
#define ATT_C_FN att::attn_unit
#endif

__device__ __forceinline__ void weight_desc(const Args& a, bf16* WT, int mi, const float*& src, const float*& gk, int& K, int& N, bf16*& dst, int& pmode) {
    gk = nullptr; pmode = 0;
    if (mi < 16) { const int l = mi >> 2, t = mi & 3;
        if (t == 0)      { src = a.in[I_WIN] + (size_t)l * SZ_IN;    K = DM;   N = DFF; dst = WT + OFF_IN + (size_t)l * SZ_IN; gk = a.in[I_NMLP] + l * DM; }
        else if (t == 1) { src = a.in[I_WOUT] + (size_t)l * SZ_OUT;  K = DFF;  N = DM;  dst = WT + OFF_OUT + (size_t)l * SZ_OUT; }
        else if (t == 2) { src = a.in[I_WPLE] + (size_t)l * SZ_PLE;  K = PLED; N = DM;  dst = WT + OFF_PLE + (size_t)l * SZ_PLE; }
        else             { src = a.in[I_WGATE] + (size_t)l * SZ_GATE; K = DM;  N = DM;  dst = WT + OFF_GATE + (size_t)l * SZ_GATE; gk = a.in[I_GATEG] + l * DM; }
    } else if (mi < 20) { const int j = (mi - 16) >> 1, t = mi & 1;
        if (t == 0) { src = a.in[I_AQKV] + (size_t)j * SZ_AQKV; K = DM; N = 3072; dst = WT + OFF_AQKV + (size_t)j * SZ_AQKV; gk = a.in[I_NMIX] + (3 * j) * DM; pmode = QKFUSE ? 1 : 0; }
        else        { src = a.in[I_AO] + (size_t)j * SZ_AO;     K = DM; N = DM;   dst = WT + OFF_AO + (size_t)j * SZ_AO; }
    } else if (mi == 20) { src = a.in[I_BDQ];  K = DM;   N = 1088; dst = WT + OFF_BDQ; gk = a.in[I_NMIX] + 1 * DM; }
    else if (mi == 21)   { src = a.in[I_BUQ];  K = 512;  N = 3072; dst = WT + OFF_BUQ; }
    else if (mi == 22)   { src = a.in[I_BUKV]; K = 512;  N = 4096; dst = WT + OFF_BUKV; }
    else if (mi == 23)   { src = a.in[I_BO];   K = DM;   N = DM;   dst = WT + OFF_BO; }
    else if (mi == 24)   { src = a.in[I_CQKV]; K = DM;   N = 9216; dst = WT + OFF_CQKV; gk = a.in[I_NMIX] + 2 * DM; pmode = QKFUSE ? 2 : 0; }
    else                 { src = a.in[I_CO];   K = 1024; N = DM;   dst = WT + OFF_CO; }
}
__device__ __forceinline__ void rope_entry(float pos, float fh, float fl, f32x2* out) {
    const float hi = pos * fh, err = fmaf(pos, fh, -hi);
    const float fr = (hi - rintf(hi)) + (err + pos * fl);
    f32x2 r; r.x = __builtin_amdgcn_cosf(fr); r.y = __builtin_amdgcn_sinf(fr); *out = r;
}

#define PHASE_VARS() int tid, zi = 0; asm volatile("v_mbcnt_lo_u32_b32 %0, -1, 0\n\tv_mbcnt_hi_u32_b32 %0, -1, %0" : "=v"(tid), "+s"(zi)); tid += wave_u * 64; \
    const int lane = tid & 63, wave = __builtin_amdgcn_readfirstlane(tid >> 6); \
    const int G = (int)gridDim.x + zi, bx = (int)blockIdx.x + zi; const bool g8 = (G % 8) == 0; \
    const int x8 = g8 ? bx % 8 : 0, r8 = g8 ? bx / 8 : bx, G8 = g8 ? G / 8 : G; const int vcu = g8 ? x8 * G8 + r8 : bx; \
    const int gw = vcu * NWAVES + wave, NGW = G * NWAVES; unsigned char* const ws = args.ws + zi; \
    (void)lane; (void)gw; (void)NGW; (void)x8; (void)r8; (void)G8; (void)ws
#define INP(i) (args.in[(i) + zi])
#ifndef STAG_TICKS
#define STAG_TICKS 0
#endif
#ifndef STAG2_TICKS
#define STAG2_TICKS 0
#endif
#define STAGGER2(ticks) do { if ((ticks) > 0 && (x8 & 4)) { const unsigned long long t0_ = __builtin_amdgcn_s_memrealtime(); while (__builtin_amdgcn_s_memrealtime() - t0_ < (unsigned long long)(ticks)) __builtin_amdgcn_s_sleep(16); } } while (0)
#define STAGGER(ticks) do { if ((ticks) > 0) { const unsigned long long t0_ = __builtin_amdgcn_s_memrealtime(), tw_ = (unsigned long long)(x8 * (ticks)); while (__builtin_amdgcn_s_memrealtime() - t0_ < tw_) __builtin_amdgcn_s_sleep(16); } } while (0)
#define GEMM_PHASE(EPI, Aptr, Wptr, Mv, Nv, Kv, ...) do { pg8::Gemm g_{(Aptr), (Wptr), (Mv), (Nv), (Kv)}; pg8::StaticOrder S_; S_.init((Mv), (Nv), G, bx); \
    EPI E_{__VA_ARGS__}; pg8::gemm_phase<EPI, pg8::StaticOrder, true, true>(lds, g_, S_, E_, tid); } while (0)

__global__ void __launch_bounds__(NWAVES * 64, 2) mk_fwd(Args args) {
    extern __shared__ __attribute__((aligned(16))) unsigned char lds_raw[];
    LAS unsigned char* const lds = (LAS unsigned char*)lds_raw;
    const int wave_u = __builtin_amdgcn_readfirstlane((int)threadIdx.x >> 6);
    volatile LAS unsigned* MISC = (volatile LAS unsigned*)(lds + MISC_OFF);
    for (int u = threadIdx.x; u < (LDS_BYTES - LDSCTL_OFF) / 4; u += NWAVES * 64) ((LAS unsigned*)(lds + LDSCTL_OFF))[u] = 0u;
    __syncthreads();
    XcdBarrier bar = xcd_barrier_post((unsigned*)(args.ws + WS_CTL) + CW_BAR, MISC + 8);
    if (TS_MASK != 0u && ts_thread0(wave_u)) { const unsigned long long now_ = __builtin_amdgcn_s_memrealtime(); MISC[16] = (unsigned)now_; MISC[17] = (unsigned)(now_ >> 32); }
#define GRID_BAR(id) do { xcd_barrier(bar); if (TS_MASK != 0u && ts_thread0(wave_u)) { const unsigned long long now_ = __builtin_amdgcn_s_memrealtime(); \
    const unsigned long long last_ = ((unsigned long long)MISC[17] << 32) | MISC[16]; if ((TS_MASK >> (id)) & 1u) { const unsigned long long a_ = (((unsigned long long)MISC[19] << 32) | MISC[18]) + (now_ - last_); MISC[18] = (unsigned)a_; MISC[19] = (unsigned)(a_ >> 32); } \
    MISC[16] = (unsigned)now_; MISC[17] = (unsigned)(now_ >> 32); } } while (0)

    for (int rep_ = 0; rep_ < REP_PRO; ++rep_)
    {
        PHASE_VARS();
        bf16* const WT = (bf16*)(ws + WS_WT); f32x2* const T64 = (f32x2*)(ws + WS_T64); f32x2* const T32 = (f32x2*)(ws + WS_T32);
        LAS float* scr = (LAS float*)(lds + wave * 16384);
        int gbase = 0;
        for (int mi = 0; mi < 26; ++mi) {
            const float* src; const float* gk; int K, N, pmode; bf16* dst; weight_desc(args, WT, mi, src, gk, K, N, dst, pmode);
            const int items = (K / 64) * (N / 32); int first = (gw - gbase) % NGW; if (first < 0) first += NGW;
            for (int it = first; it < items; it += NGW) p0_transpose_item(src, gk, K, N, dst, scr, it, lane, pmode);
            gbase = (gbase + items) % NGW;
        }
        { v4u* z = (v4u*)(WT + OFF_BDQ + (size_t)1088 * DM); const int n16 = 192 * DM * 2 / 16; const v4u zero = {0u, 0u, 0u, 0u};
          for (int i = vcu * 512 + tid; i < n16; i += G * 512) z[i] = zero; }
        for (int i = vcu * 512 + tid; i < 8192 * 32; i += G * 512) { const int pos = i >> 5, j = i & 31; rope_entry((float)pos, RF64_HI[j], RF64_LO[j], T64 + i); }
        for (int i = vcu * 512 + tid; i < 8192 * 16; i += G * 512) { const int pos = i >> 4, j = i & 15; rope_entry((float)pos, RF32_HI[j], RF32_LO[j], T32 + i); }
    }
    GRID_BAR(0);

    typedef pg8::EpiBf16<0, true, false> EpiProj; typedef pg8::EpiBf16<0, false, false> EpiPlain; typedef pg8::EpiBf16<1, true, false> EpiMlp; typedef pg8::EpiBf16<0, false, true> EpiPle;
    typedef pg8::EpiResidT<false, false> EpiRes; typedef pg8::EpiResidT<true, false> EpiGate; typedef pg8::EpiResidT<true, true> EpiGateF;
    for (int c_ = 0; c_ < NCH; ++c_) {
#define CHUNK_VARS() const int c = c_ + zi; const size_t tok0 = (size_t)c * CT; const bool prompt = tok0 < (size_t)NPROMPT; \
    const int SEQ = prompt ? SEQ_P : SEQ_S, NQB = SEQ / 256; float* const X = args.out + tok0 * DM + zi; bf16* const WT = (bf16*)(ws + WS_WT); bf16* const XB = (bf16*)(ws + WS_H); \
    unsigned char* const BIG = ws + WS_BIG; bf16* const XBP = (bf16*)(ws + WS_E0); (void)XBP;     float* const SSP = (float*)(ws + WS_SSP); float* const RS = (float*)(ws + WS_RS); \
    (void)SEQ; (void)NQB; (void)X; (void)WT; (void)XB; (void)BIG; (void)prompt; (void)SSP; (void)RS
#define LAYER_VARS() const int layer = layer_ + zi; const int lj = layer / 3; (void)lj
        for (int rep_ = 0; rep_ < REP_INIT; ++rep_)
        { PHASE_VARS(); CHUNK_VARS();
          init_rows(prompt ? INP(I_XP) + tok0 * DM : INP(I_XS) + (tok0 - NPROMPT) * DM, XBP, SSP, CT, gw, NGW, lane); }
        GRID_BAR(1);
        for (int layer_ = 0; layer_ < DEPTH; ++layer_) {
            { PHASE_VARS(); CHUNK_VARS(); rs_rows(SSP, RS, nullptr, nullptr, CT, gw, NGW, lane); }
            GRID_BAR(2);
            const int kind = layer_ % 3;
            if (kind == 0) {
#if QKFUSE
                { PHASE_VARS(); CHUNK_VARS(); LAYER_VARS(); GEMM_PHASE(pg8::EpiQK<1>, XBP, WT + OFF_AQKV + (size_t)lj * SZ_AQKV, CT, 3072, DM, (bf16*)(BIG + A_QKV), 3072, RS, INP(I_AQG) + lj * 128, INP(I_AKG) + lj * 128, (const f32x2*)(ws + WS_T64), SEQ - 1, (LAS float*)(lds + QKP_OFF), 8, 10); }
#else
                { PHASE_VARS(); CHUNK_VARS(); LAYER_VARS(); GEMM_PHASE(EpiProj, XBP, WT + OFF_AQKV + (size_t)lj * SZ_AQKV, CT, 3072, DM, (bf16*)(BIG + A_QKV), 3072, RS, nullptr); }
#endif
                GRID_BAR(3);
#if !QKFUSE
                { PHASE_VARS(); CHUNK_VARS(); LAYER_VARS(); a_qknorm_rope((bf16*)(BIG + A_QKV), INP(I_AQG) + lj * 128, INP(I_AKG) + lj * 128, (const f32x2*)(ws + WS_T64), SEQ - 1, gw, NGW, lane); }
                GRID_BAR(4);
#endif
                if (ATT_PRIO && wave_u >= 4) __builtin_amdgcn_s_setprio(2);
                for (int rep_ = 0; rep_ < REP_ATTA; ++rep_)
                { const int nu = ((CT / 256) * 16 + (int)gridDim.x - 1) / (int)gridDim.x;
                  for (int i = 0; i < nu; ++i) { PHASE_VARS(); CHUNK_VARS(); bf16* const QKV = (bf16*)(BIG + A_QKV); bf16* const OB = (bf16*)(BIG + A_O);
                      const int U8 = g8 ? (CT / 256) * 16 / 8 : (CT / 256) * 16, UPG = 4 * NQB; if (r8 + G8 * i >= U8) break;
                      const int u = x8 * U8 + r8 + G8 * i, grp = u / UPG, w = u % UPG, s = grp >> 2, kvh = grp & 3, h = kvh * 4 + w / NQB, qb = w % NQB;
                      const size_t t0 = (size_t)s * SEQ, tq = t0 + (size_t)qb * 256;
                      att::Unit un; un.Q = QKV + tq * 3072 + h * 128; un.K = QKV + t0 * 3072 + 2048 + kvh * 128; un.V = un.K + 512; un.O = OB + tq * DM + h * 128; un.LSE = nullptr;
                      un.ldq = 3072; un.ldk = 3072; un.ldv = 3072; un.ldo = DM; un.ldl = 0; un.nt = SEQ / 64; un.qoff = 0;
                      ATT_A_FN<CfgA, false, false, 3072, 3072, 3072, DM>(un, (char*)lds_raw, tid); } }
                if (ATT_PRIO) __builtin_amdgcn_s_setprio(0);
                GRID_BAR(5);
                { PHASE_VARS(); CHUNK_VARS(); LAYER_VARS(); STAGGER2(STAG2_TICKS); GEMM_PHASE(EpiRes, (bf16*)(BIG + A_O), WT + OFF_AO + (size_t)lj * SZ_AO, CT, DM, DM, XBP, nullptr, XB, SSP, DM, nullptr, nullptr, nullptr, nullptr); }
                GRID_BAR(6);
            } else if (kind == 1) {
#ifdef PROBE_PROJ
                { PHASE_VARS(); CHUNK_VARS(); GEMM_PHASE(EpiProj, XBP, WT + OFF_BDQ, CT, 1280, DM, (bf16*)(BIG + BB_LAT), 1280, RS, nullptr); }
#endif
                { PHASE_VARS(); CHUNK_VARS(); GEMM_PHASE(EpiProj, XBP, WT + OFF_BDQ, CT, 1280, DM, (bf16*)(BIG + BB_LAT), 1280, RS, nullptr); }
                GRID_BAR(3);
                { PHASE_VARS(); CHUNK_VARS(); b_latnorm((bf16*)(BIG + BB_LAT), (bf16*)(BIG + BB_CQ), (bf16*)(BIG + BB_CKV), INP(I_BCQG), INP(I_BCKVG), gw, NGW, lane); }
                GRID_BAR(4);
#ifdef PROBE_PROJ
                { PHASE_VARS(); CHUNK_VARS(); GEMM_PHASE(EpiPlain, (bf16*)(BIG + BB_CQ), WT + OFF_BUQ, CT, 3072, 512, (bf16*)(BIG + BB_QB), 3072, nullptr, nullptr); }
#endif
                { PHASE_VARS(); CHUNK_VARS(); GEMM_PHASE(EpiPlain, (bf16*)(BIG + BB_CQ), WT + OFF_BUQ, CT, 3072, 512, (bf16*)(BIG + BB_QB), 3072, nullptr, nullptr); }
#ifdef PROBE_PROJ
                { PHASE_VARS(); CHUNK_VARS(); GEMM_PHASE(EpiPlain, (bf16*)(BIG + BB_CKV), WT + OFF_BUKV, CT, 4096, 512, (bf16*)(BIG + BB_KVB), 4096, nullptr, nullptr); }
#endif
                { PHASE_VARS(); CHUNK_VARS(); GEMM_PHASE(EpiPlain, (bf16*)(BIG + BB_CKV), WT + OFF_BUKV, CT, 4096, 512, (bf16*)(BIG + BB_KVB), 4096, nullptr, nullptr); }
                GRID_BAR(11);
                { PHASE_VARS(); CHUNK_VARS(); b_qknorm_rope((bf16*)(BIG + BB_QB), (bf16*)(BIG + BB_KVB), (bf16*)(BIG + BB_LAT), (bf16*)(BIG + BB_KF), INP(I_BQG), INP(I_BKG), (const f32x2*)(ws + WS_T64), SEQ - 1, gw, NGW, lane); }
                GRID_BAR(4);
                if (ATT_PRIO && wave_u >= 4) __builtin_amdgcn_s_setprio(2);
                for (int rep_ = 0; rep_ < REP_ATTB; ++rep_)
                { const int nu = ((CT / 256) * 16 + (int)gridDim.x - 1) / (int)gridDim.x;
                  for (int i = 0; i < nu; ++i) { PHASE_VARS(); CHUNK_VARS(); bf16* const QB = (bf16*)(BIG + BB_QB); bf16* const KVB = (bf16*)(BIG + BB_KVB); bf16* const KF = (bf16*)(BIG + BB_KF); bf16* const OB = (bf16*)(BIG + BB_O);
                      const int U8 = g8 ? (CT / 256) * 16 / 8 : (CT / 256) * 16; if (r8 + G8 * i >= U8) break;
                      const int u = x8 * U8 + r8 + G8 * i, grp = u / NQB, qb = u % NQB, s = grp >> 4, h = grp & 15;
                      const size_t t0 = (size_t)s * SEQ, tq = t0 + (size_t)qb * 256;
                      att::Unit un; un.Q = QB + tq * 3072 + h * 192; un.K = KF + t0 * 3072 + h * 192; un.V = KVB + t0 * 4096 + h * 256 + 128; un.O = OB + tq * DM + h * 128; un.LSE = nullptr;
                      un.ldq = 3072; un.ldk = 3072; un.ldv = 4096; un.ldo = DM; un.ldl = 0; un.nt = SEQ / 64; un.qoff = 0;
                      att::attn_unit<CfgB, false, false, 3072, 3072, 4096, DM>(un, (char*)lds_raw, tid); } }
                if (ATT_PRIO) __builtin_amdgcn_s_setprio(0);
                GRID_BAR(5);
                { PHASE_VARS(); CHUNK_VARS(); STAGGER2(STAG2_TICKS); GEMM_PHASE(EpiRes, (bf16*)(BIG + BB_O), WT + OFF_BO, CT, DM, DM, XBP, nullptr, XB, SSP, DM, nullptr, nullptr, nullptr, nullptr); }
                GRID_BAR(6);
            } else {
#if QKFUSE
                { PHASE_VARS(); CHUNK_VARS(); GEMM_PHASE(pg8::EpiQK<2>, XBP, WT + OFF_CQKV, CT, 9216, DM, (bf16*)(BIG + C_QKV), 9216, RS, INP(I_CQG), INP(I_CKG), (const f32x2*)(ws + WS_T32), SEQ - 1, (LAS float*)(lds + QKP_OFF), 12, 24); }
#else
                { PHASE_VARS(); CHUNK_VARS(); GEMM_PHASE(EpiProj, XBP, WT + OFF_CQKV, CT, 9216, DM, (bf16*)(BIG + C_QKV), 9216, RS, nullptr); }
#endif
                GRID_BAR(3);
#if !QKFUSE
                { PHASE_VARS(); CHUNK_VARS(); c_qknorm_rope((bf16*)(BIG + C_QKV), INP(I_CQG), INP(I_CKG), (const f32x2*)(ws + WS_T32), SEQ - 1, gw, NGW, lane); }
                GRID_BAR(4);
#endif
                for (int rep_ = 0; rep_ < REP_ATTC; ++rep_)
                { const int nu = ((CT / 256) * 24 + (int)gridDim.x - 1) / (int)gridDim.x;
                  for (int i = 0; i < nu; ++i) { PHASE_VARS(); CHUNK_VARS(); bf16* const QKV = (bf16*)(BIG + C_QKV); bf16* const OG = (bf16*)(BIG + C_OG); float* const LSE = (float*)(ws + WS_LSE);
                      const int U8 = g8 ? (CT / 256) * 24 / 8 : (CT / 256) * 24; if (r8 + G8 * i >= U8) break;
                      const int u = x8 * U8 + r8 + G8 * i, grp = u / NQB, blk = u % NQB, s = grp / 24, gh = grp % 24, gi = gh >> 3, h = gh & 7;
                      const int dsh = 2 * gi, d = 1 << dsh, L = SEQ >> dsh, NB = L / 256, res = blk / NB, l0 = (blk % NB) * 256;
                      const int nt = L / 64 < 6 ? L / 64 : 6; int kw0 = l0 - 64; if (kw0 < 0) kw0 = 0; if (kw0 > L - 64 * nt) kw0 = L - 64 * nt;
                      const size_t t0 = (size_t)s * SEQ + res, tq = t0 + (size_t)d * l0, tk = t0 + (size_t)d * kw0;
                      att::Unit un; un.Q = QKV + tq * 9216 + gh * 128; un.K = QKV + tk * 9216 + 3072 + gh * 128; un.V = un.K + 3072; un.O = OG + (size_t)gi * CT * 1024 + tq * 1024 + h * 128;
                      un.LSE = LSE + (size_t)gi * CT * 8 + tq * 8 + h;
                      un.ldq = d * 9216; un.ldk = d * 9216; un.ldv = d * 9216; un.ldo = d * 1024; un.ldl = d * 8; un.nt = nt; un.qoff = l0 - kw0;
                      ATT_C_FN<CfgC, true, true>(un, (char*)lds_raw, tid); } }
                GRID_BAR(5);
                { PHASE_VARS(); CHUNK_VARS(); c_merge((bf16*)(BIG + C_OG), (float*)(ws + WS_LSE), (bf16*)(BIG + C_QKV), gw, NGW, lane); }
                GRID_BAR(4);
                { PHASE_VARS(); CHUNK_VARS(); STAGGER2(STAG2_TICKS); GEMM_PHASE(EpiRes, (bf16*)(BIG + C_QKV), WT + OFF_CO, CT, DM, 1024, XBP, nullptr, XB, SSP, DM, nullptr, nullptr, nullptr, nullptr); }
                GRID_BAR(6);
            }
            { PHASE_VARS(); CHUNK_VARS(); LAYER_VARS();
              rs_rows(SSP, RS, nullptr, nullptr, CT, gw, NGW, lane);
              const float* P = (prompt ? INP(I_PP) + ((size_t)layer * NPROMPT + tok0) * PLED : INP(I_PS) + ((size_t)layer * NPROMPT + (tok0 - NPROMPT)) * PLED); bf16* const PB = (bf16*)(ws + WS_PB);
              for (int i = vcu * 512 + tid; i < CT * PLED / 8; i += G * 512) { const f32x4 a0 = ((const f32x4*)P)[2 * i], a1 = ((const f32x4*)P)[2 * i + 1];
                  v4u w; w.x = pk2(a0.x, a0.y); w.y = pk2(a0.z, a0.w); w.z = pk2(a1.x, a1.y); w.w = pk2(a1.z, a1.w); ((v4u*)PB)[i] = w; } }
            GRID_BAR(7);
            for (int rep_ = 0; rep_ < REP_MLPIN; ++rep_)
            { PHASE_VARS(); CHUNK_VARS(); LAYER_VARS(); GEMM_PHASE(EpiMlp, XB, WT + OFF_IN + (size_t)layer * SZ_IN, CT, DFF, DM, (bf16*)(BIG + B_HID), DFF, RS, nullptr); }
#ifdef PROBE_PROJ
            { PHASE_VARS(); CHUNK_VARS(); LAYER_VARS(); GEMM_PHASE(EpiPle, (bf16*)(ws + WS_PB), WT + OFF_PLE + (size_t)layer * SZ_PLE, CT, DM, PLED, (bf16*)(ws + WS_E0), DM, nullptr, (float*)(ws + WS_SSPE)); }
#endif
            { PHASE_VARS(); CHUNK_VARS(); LAYER_VARS(); GEMM_PHASE(EpiPle, (bf16*)(ws + WS_PB), WT + OFF_PLE + (size_t)layer * SZ_PLE, CT, DM, PLED, (bf16*)(ws + WS_E0), DM, nullptr, (float*)(ws + WS_SSPE)); }
            GRID_BAR(8);
            { PHASE_VARS(); CHUNK_VARS(); LAYER_VARS(); STAGGER2(STAG2_TICKS); GEMM_PHASE(EpiRes, (bf16*)(BIG + B_HID), WT + OFF_OUT + (size_t)layer * SZ_OUT, CT, DM, DFF, XB, nullptr, XB, SSP, DM, nullptr, nullptr, nullptr, nullptr); }
            GRID_BAR(9);
            { PHASE_VARS(); CHUNK_VARS(); rs_rows(SSP, RS, (float*)(ws + WS_SSPE), (float*)(ws + WS_RSTD), CT, gw, NGW, lane); }
            GRID_BAR(2);
            if (layer_ < DEPTH - 1) { PHASE_VARS(); CHUNK_VARS(); LAYER_VARS(); STAGGER2(STAG2_TICKS); GEMM_PHASE(EpiGate, XB, WT + OFF_GATE + (size_t)layer * SZ_GATE, CT, DM, DM, XB, nullptr, XBP, SSP, DM, (bf16*)(ws + WS_E0), RS, (float*)(ws + WS_RSTD), INP(I_PLEG) + layer * DM); }
            else { PHASE_VARS(); CHUNK_VARS(); LAYER_VARS(); STAGGER2(STAG2_TICKS); GEMM_PHASE(EpiGateF, XB, WT + OFF_GATE + (size_t)layer * SZ_GATE, CT, DM, DM, XB, X, XBP, SSP, DM, (bf16*)(ws + WS_E0), RS, (float*)(ws + WS_RSTD), INP(I_PLEG) + layer * DM); }
            GRID_BAR(10);
        }
    }
    if (TS_MASK != 0u && blockIdx.x == 0 && ts_thread0(wave_u)) { const unsigned long long a_ = (((unsigned long long)MISC[19] << 32) | MISC[18]) * TS_FACTOR, t0_ = __builtin_amdgcn_s_memrealtime(); while (__builtin_amdgcn_s_memrealtime() - t0_ < a_) __builtin_amdgcn_s_sleep(32); }
#undef GRID_BAR
}

extern "C" void kernel_launch(void* const* d_in, const int* in_sizes, int n_in, void* d_out, int out_size, void* d_ws, size_t ws_size, hipStream_t stream) {
    static int grid = 0;
    if (grid == 0) {
        if (n_in != N_IN || out_size != NTOK * DM || ws_size < WS_END) { fprintf(stderr, "kernel_launch: shape mismatch: n_in %d out %d ws %zu (need %zu)\n", n_in, out_size, ws_size, (size_t)WS_END); grid = -1; return; }
        int dev = 0, cus = 0, per_cu = 0;
        if (hipGetDevice(&dev) != hipSuccess || hipDeviceGetAttribute(&cus, hipDeviceAttributeMultiprocessorCount, dev) != hipSuccess) { grid = -1; return; }
        if (hipFuncSetAttribute((const void*)mk_fwd, hipFuncAttributeMaxDynamicSharedMemorySize, LDS_BYTES) != hipSuccess) { fprintf(stderr, "kernel_launch: hipFuncSetAttribute failed\n"); grid = -1; return; }
        if (hipOccupancyMaxActiveBlocksPerMultiprocessor(&per_cu, (const void*)mk_fwd, NWAVES * 64, LDS_BYTES) != hipSuccess || per_cu < 1) { fprintf(stderr, "kernel_launch: occupancy query says %d\n", per_cu); }
        (void)hipGetLastError();
        grid = cus;
    }
    if (grid < 0) return;
    if (hipMemsetAsync((char*)d_ws + WS_CTL, 0, CTL_ZERO_BYTES, stream) != hipSuccess) return;
    Args a{};
    for (int i = 0; i < N_IN; ++i) a.in[i] = (const float*)d_in[i];
    a.out = (float*)d_out; a.ws = (unsigned char*)d_ws;
    hipLaunchKernelGGL(mk_fwd, dim3(grid), dim3(NWAVES * 64), LDS_BYTES, stream, a);
    const hipError_t le = hipPeekAtLastError();
    if (le != hipSuccess) fprintf(stderr, "kernel_launch: launch failed: %s\n", hipGetErrorName(le));
}
```
